# Optimizing an MI355X kernel written in HIP

```python
import math
import jax
import jax.numpy as jnp
from jax import lax
import numpy as np


D_MODEL = 1024
BATCH = 4
SEQ = 4096
DEPTH = 4

GRID_W = 64
CTX_LEN = 256
N_BRANCH = 3
BR_W = D_MODEL // 2
A_GROUPS = 4
A_GW = BR_W // A_GROUPS
A_CHUNK = 128
B_HD = 64
B_VD = 2 * B_HD
B_HEADS = BR_W // (2 * B_HD)
ATTN_BLOCK = 128
ROPE_BASE = 10000.0
C_HD = 64
C_HEADS = BR_W // C_HD
N_DIR = 2
W_LORA = 64
A_LORA = 64
NORM_EPS = 1e-6
LN_EPS = 1e-5
GN_EPS = 64e-5
STATE_SIZES = (BR_W, BR_W, BR_W, BR_W, N_DIR * W_LORA, N_DIR * A_LORA)
OUT_SIZES = (BR_W,) * 7 + (N_BRANCH * D_MODEL,)
STATE_COLS = 4 * BR_W + N_DIR * (W_LORA + A_LORA)
OUT_COLS = 7 * BR_W + N_BRANCH * D_MODEL
IN_COLS = STATE_COLS + OUT_COLS

kernel_name = 'hybrid_gmlp_diffattn_rwkv7_flow_block'


def rms_norm(x, g):
    xf = x.astype(jnp.float32)
    y = xf * lax.rsqrt(jnp.mean(xf * xf, axis=-1, keepdims=True) + NORM_EPS)
    return (y * g).astype(x.dtype)


def layer_norm(x, g, b):
    xf = x.astype(jnp.float32)
    mu = jnp.mean(xf, axis=-1, keepdims=True)
    var = jnp.mean(jnp.square(xf - mu), axis=-1, keepdims=True)
    return ((xf - mu) * lax.rsqrt(var + LN_EPS) * g + b).astype(x.dtype)


def split_cols(t, sizes):
    return jnp.split(t, np.cumsum(sizes)[:-1].tolist(), axis=-1)


def rope_table(pos):
    nf = B_HD // 4
    inv = ROPE_BASE ** (-jnp.arange(nf, dtype=jnp.float32) / nf)
    ang = pos.astype(jnp.float32)[:, None] * inv[None, :]
    return jnp.cos(ang)[:, None, None, :], jnp.sin(ang)[:, None, None, :]


def rotate(x, cos, sin):
    x1, x2 = jnp.split(x, 2, axis=-1)
    cos = cos.astype(x.dtype)
    sin = sin.astype(x.dtype)
    return jnp.concatenate([x1 * cos - x2 * sin, x1 * sin + x2 * cos], axis=-1)


def axial_rope(x, rope):
    (rc, rs), (cc, cs) = rope
    x_row, x_col = jnp.split(x, 2, axis=-1)
    return jnp.concatenate([rotate(x_row, rc, rs), rotate(x_col, cc, cs)], axis=-1)


def token_shift(x, taps):
    xp = jnp.pad(x, ((0, 0), (1, 1), (0, 0)))
    return xp[:, :-2] * taps[0] + xp[:, 1:-1] * taps[1] + xp[:, 2:] * taps[2]


def dir_stack(t):
    t = jnp.moveaxis(t, 2, 0)
    return jnp.stack([t[0], jnp.flip(t[1], axis=1)])


def dir_share(t):
    return jnp.stack([t, jnp.flip(t, axis=1)])


def state_side(ps, p, rope):
    b_, t_ = ps.shape[:2]
    dk, dv, kr, vr, wl, al = split_cols(ps, STATE_SIZES)
    k_att = rms_norm(dk.reshape(b_, t_, B_HEADS, 2, B_HD), p['d_knorm'])
    if rope is not None:
        k_att = axial_rope(k_att, rope)
    v_att = dv.reshape(b_, t_, B_HEADS, B_VD)
    k = token_shift(kr, p['r_conv'][1])
    v = token_shift(vr, p['r_conv'][2])
    wl = wl.reshape(b_, t_, N_DIR, W_LORA)
    al = al.reshape(b_, t_, N_DIR, A_LORA)
    w_log = (p['r_w0'] + jnp.einsum('btdr,drc->btdc', jnp.tanh(wl), p['r_w2'])).astype(jnp.float32)
    decay = jnp.exp(-jnp.exp(-jax.nn.softplus(-w_log) - 0.5))
    a = jax.nn.sigmoid(p['r_a0'] + jnp.einsum('btdr,drc->btdc', al, p['r_a2']))
    kk = (k * p['r_kk']).reshape(b_, t_, C_HEADS, C_HD).astype(jnp.float32)
    kk = kk / jnp.maximum(jnp.sqrt(jnp.sum(kk * kk, axis=-1, keepdims=True)), 1e-12)
    k_dir = k[:, :, None, :] * (1.0 + (a - 1.0) * p['r_ka'])
    heads = lambda z: z.reshape(b_, t_, N_DIR, C_HEADS, C_HD)
    k_h = k.reshape(b_, t_, C_HEADS, C_HD)
    v_h = v.reshape(b_, t_, C_HEADS, C_HD)
    return dict(k_att=k_att, v_att=v_att, k_h=k_h, v_h=v_h,
                kk=dir_share(kk), a=dir_stack(heads(a)), w=dir_stack(heads(decay)),
                k=dir_stack(heads(k_dir)), v=dir_share(v_h))


def out_side(po, p, rope):
    b_, t_ = po.shape[:2]
    dq, r, u, va, za, zb, zc, gl = split_cols(po, OUT_SIZES)
    q = rms_norm(dq.reshape(b_, t_, B_HEADS, 2, B_HD), p['d_qnorm'])
    if rope is not None:
        q = axial_rope(q, rope)
    r_h = token_shift(r, p['r_conv'][0]).reshape(b_, t_, C_HEADS, C_HD)
    return dict(q=q, r_h=r_h, u=jax.nn.gelu(u), va=jax.nn.gelu(va), za=za, zb=zb, zc=zc, gl=gl)


def chunk_gmlp(u, v, p):
    b_, t_, _ = v.shape
    v = layer_norm(v, p['a_ln_g'], p['a_ln_b'])
    vc = v.reshape(b_, t_ // A_CHUNK, A_CHUNK, A_GROUPS, A_GW)
    s = jnp.einsum('gpq,bnqgc->bnpgc', p['a_ws'], vc) + jnp.swapaxes(p['a_bs'], 0, 1)[None, None, :, :, None]
    return u * s.reshape(b_, t_, BR_W)


def diff_lambda(lam_p, lam_init):
    lp = lam_p.astype(jnp.float32)
    return jnp.exp(jnp.sum(lp[0] * lp[1])) - jnp.exp(jnp.sum(lp[2] * lp[3])) + lam_init


def diff_attention(q, k, v, lam):
    b_, t_ = q.shape[:2]
    nb = t_ // ATTN_BLOCK
    qb = jnp.moveaxis(q.reshape(b_, nb, ATTN_BLOCK, B_HEADS, 2, B_HD), 1, 0)
    scale = B_HD ** -0.5

    def one_block(qi):
        s = jnp.einsum('bqhjd,bkhjd->bhjqk', qi, k).astype(jnp.float32) * scale
        pr = jax.nn.softmax(s, axis=-1)
        pd = pr[:, :, 0] - lam * pr[:, :, 1]
        return jnp.einsum('bhqk,bkhe->bqhe', pd.astype(v.dtype), v)

    out = lax.map(one_block, qb)
    return jnp.moveaxis(out, 0, 1).reshape(b_, t_, B_HEADS, B_VD)


def rwkv_update(s, kk, a, w, k, v):
    sa = jnp.einsum('dbhvk,dbhk->dbhv', s, -kk)
    return s * w[..., None, :] + sa[..., :, None] * (kk * a)[..., None, :] + v[..., :, None] * k[..., None, :]


def rwkv_scan(s0, st, r=None):
    xs = tuple(jnp.moveaxis(st[n].astype(jnp.float32), 2, 0) for n in ('kk', 'a', 'w', 'k', 'v'))
    if r is None:
        def step_state(s, inp):
            return rwkv_update(s, *inp), None
        s_fin, _ = lax.scan(step_state, s0, xs)
        return s_fin, None

    def step(s, inp):
        s = rwkv_update(s, *inp[:5])
        return s, jnp.einsum('dbhvk,dbhk->dbhv', s, inp[5])

    s_fin, ys = lax.scan(step, s0, xs + (jnp.moveaxis(r.astype(jnp.float32), 2, 0),))
    return s_fin, jnp.moveaxis(ys, 0, 2)


def rwkv_readout(yd, r_h, k_h, v_h, p):
    b_, t_ = r_h.shape[:2]
    y = yd[0] + jnp.flip(yd[1], axis=1)
    mu = jnp.mean(y, axis=-1, keepdims=True)
    var = jnp.mean(jnp.square(y - mu), axis=-1, keepdims=True)
    y = ((y - mu) * lax.rsqrt(var + GN_EPS)).reshape(b_, t_, BR_W) * p['r_ln_g'] + p['r_ln_b']
    bonus = jnp.sum(r_h * k_h * p['r_rk'], axis=-1, keepdims=True) * v_h
    return (y + bonus.reshape(b_, t_, BR_W).astype(jnp.float32)).astype(r_h.dtype)


def merge(ya, yb, yc, gl, w_br, w_out):
    b_, t_ = ya.shape[:2]
    ys = jnp.stack([ya, yb, yc], axis=2)
    up = jnp.einsum('btic,icd->btid', ys, w_br)
    g = jax.nn.sigmoid(gl.reshape(b_, t_, N_BRANCH, D_MODEL))
    return jnp.einsum('btd,de->bte', jnp.sum(g * up, axis=2), w_out)


def mixer_out(so, st, k_all, v_all, s0, lam, lam_init, p):
    b_, t_ = so['u'].shape[:2]
    ya = chunk_gmlp(so['u'], so['va'], p) * jax.nn.silu(so['za'])
    att = diff_attention(so['q'], k_all, v_all, lam)
    att = rms_norm(att, p['d_subln_g']) * (1.0 - lam_init)
    yb = att.reshape(b_, t_, BR_W) * jax.nn.silu(so['zb'])
    s_fin, yd = rwkv_scan(s0, st, dir_share(so['r_h']))
    yc = rwkv_readout(yd, so['r_h'], st['k_h'], st['v_h'], p) * jax.nn.silu(so['zc'])
    return merge(ya, yb, yc, so['gl'], p['w_br'], p['w_out']), s_fin


def hybrid_layer(x, xc, c_act, cc_act, rope, lam_init, p, update_ctx):
    d = D_MODEL
    shift, scale, gate = jnp.split((c_act @ p['w_mod'] + p['b_mod'])[:, None, :], 3, axis=-1)
    n_mod_c = 3 if update_ctx else 2
    mod_c = cc_act @ p['w_mod'][:, :n_mod_c * d] + p['b_mod'][:n_mod_c * d]
    h = rms_norm(x, p['norm_g']) * (1.0 + scale) + shift
    hc = rms_norm(xc, p['norm_g']) * (1.0 + mod_c[d:2 * d]) + mod_c[:d]
    lam = diff_lambda(p['d_lam'], lam_init)
    s_zero = jnp.zeros((N_DIR, xc.shape[0], C_HEADS, C_HD, C_HD), jnp.float32)

    if update_ctx:
        pc = hc @ p['w_in']
        st_c = state_side(pc[..., :STATE_COLS], p, None)
        so_c = out_side(pc[..., STATE_COLS:], p, None)
        out_c, s_ctx = mixer_out(so_c, st_c, st_c['k_att'], st_c['v_att'], s_zero, lam, lam_init, p)
        xc_next = xc + mod_c[2 * d:] * out_c
    else:
        st_c = state_side(hc @ p['w_in'][:, :STATE_COLS], p, None)
        s_ctx, _ = rwkv_scan(s_zero, st_c)
        xc_next = None

    pl = h @ p['w_in']
    st = state_side(pl[..., :STATE_COLS], p, rope)
    so = out_side(pl[..., STATE_COLS:], p, rope)
    k_all = jnp.concatenate([st['k_att'], st_c['k_att']], axis=1)
    v_all = jnp.concatenate([st['v_att'], st_c['v_att']], axis=1)
    out, _ = mixer_out(so, st, k_all, v_all, s_ctx, lam, lam_init, p)
    return x + gate * out, xc_next


def setup_inputs(seed: int = 0) -> dict:
    key = jax.random.key(seed)
    keys = jax.random.split(key, 28)
    nrm = lambda i, shape, s=1.0: jax.random.normal(keys[i], shape, jnp.float32) * s
    L, D = DEPTH, D_MODEL
    taps = jnp.array([0.2, 0.6, 0.2], jnp.float32)[None, None, :, None]
    return {
        'x': nrm(0, (BATCH, SEQ, D)),
        'c': nrm(1, (BATCH, D)),
        'ctx': nrm(2, (BATCH, CTX_LEN, D)),
        'c_ctx': nrm(3, (D,)),
        'w_mod': nrm(4, (L, D, 3 * D), 0.5 * D ** -0.5),
        'b_mod': nrm(5, (L, 3 * D), 0.02),
        'norm_g': 1.0 + nrm(6, (L, D), 0.02),
        'w_in': nrm(7, (L, D, IN_COLS), D ** -0.5),
        'a_ln_g': 1.0 + nrm(8, (L, BR_W), 0.02),
        'a_ln_b': nrm(9, (L, BR_W), 0.02),
        'a_ws': nrm(10, (L, A_GROUPS, A_CHUNK, A_CHUNK), A_CHUNK ** -0.5),
        'a_bs': 1.0 + nrm(11, (L, A_GROUPS, A_CHUNK), 0.02),
        'd_qnorm': 1.0 + nrm(12, (L, B_HD), 0.02),
        'd_knorm': 1.0 + nrm(13, (L, B_HD), 0.02),
        'd_lam': nrm(14, (L, 4, B_HD), 0.1),
        'd_subln_g': 1.0 + nrm(15, (L, B_VD), 0.02),
        'r_conv': taps + nrm(16, (L, 3, 3, BR_W), 0.05),
        'r_w0': jnp.linspace(-6.0, -1.0, BR_W, dtype=jnp.float32) + nrm(17, (L, N_DIR, BR_W), 0.1),
        'r_w2': nrm(18, (L, N_DIR, W_LORA, BR_W), 0.3 * W_LORA ** -0.5),
        'r_a0': nrm(19, (L, N_DIR, BR_W), 0.1),
        'r_a2': nrm(20, (L, N_DIR, A_LORA, BR_W), 0.3 * A_LORA ** -0.5),
        'r_kk': 0.85 + nrm(21, (L, BR_W), 0.02),
        'r_ka': 1.0 + nrm(22, (L, BR_W), 0.02),
        'r_rk': nrm(23, (L, C_HEADS, C_HD), 0.1),
        'r_ln_g': 1.0 + nrm(24, (L, BR_W), 0.02),
        'r_ln_b': nrm(25, (L, BR_W), 0.02),
        'w_br': nrm(26, (L, N_BRANCH, BR_W, D), BR_W ** -0.5),
        'w_out': nrm(27, (L, D, D), D ** -0.5),
    }


def reference(x, c, ctx, c_ctx, w_mod, b_mod, norm_g, w_in, a_ln_g, a_ln_b, a_ws, a_bs,
              d_qnorm, d_knorm, d_lam, d_subln_g, r_conv, r_w0, r_w2, r_a0, r_a2,
              r_kk, r_ka, r_rk, r_ln_g, r_ln_b, w_br, w_out):
    n_tok = x.shape[1]
    rows = n_tok // GRID_W
    row = jnp.broadcast_to(jnp.arange(rows)[:, None], (rows, GRID_W)).reshape(-1)
    col = jnp.broadcast_to(jnp.arange(GRID_W)[None, :], (rows, GRID_W)).reshape(-1)
    rope = (rope_table(row), rope_table(col))
    c_act = jax.nn.silu(c)
    cc_act = jax.nn.silu(c_ctx)
    xc = ctx
    for l in range(DEPTH):
        p = dict(w_mod=w_mod[l], b_mod=b_mod[l], norm_g=norm_g[l], w_in=w_in[l],
                 a_ln_g=a_ln_g[l], a_ln_b=a_ln_b[l], a_ws=a_ws[l], a_bs=a_bs[l],
                 d_qnorm=d_qnorm[l], d_knorm=d_knorm[l], d_lam=d_lam[l], d_subln_g=d_subln_g[l],
                 r_conv=r_conv[l], r_w0=r_w0[l], r_w2=r_w2[l], r_a0=r_a0[l], r_a2=r_a2[l],
                 r_kk=r_kk[l], r_ka=r_ka[l], r_rk=r_rk[l], r_ln_g=r_ln_g[l], r_ln_b=r_ln_b[l],
                 w_br=w_br[l], w_out=w_out[l])
        lam_init = 0.8 - 0.6 * math.exp(-0.3 * l)
        x, xc = hybrid_layer(x, xc, c_act, cc_act, rope, lam_init, p, l < DEPTH - 1)
    return x
```

```cpp
#include <hip/hip_runtime.h>
#include <hip/hip_cooperative_groups.h>
#include <cstdint>
#include <cstdio>
namespace cg = cooperative_groups;

#ifndef MK_ONE_LAUNCH
#define MK_ONE_LAUNCH 1
#endif

#define LAS __attribute__((address_space(3)))
#define GAS __attribute__((address_space(1)))
typedef unsigned short bf16_t;
typedef short bf16x8 __attribute__((ext_vector_type(8)));
typedef short s16x4 __attribute__((ext_vector_type(4)));
typedef float f32x2 __attribute__((ext_vector_type(2)));
typedef float f32x4 __attribute__((ext_vector_type(4)));
typedef float f32x16 __attribute__((ext_vector_type(16)));
typedef unsigned u32x2 __attribute__((ext_vector_type(2)));
typedef unsigned u32x4 __attribute__((ext_vector_type(4)));

constexpr int DM = 1024, NB = 4, SEQ = 4096, NL = 4, CTX = 256;
constexpr int ML = NB * SEQ;
constexpr int MC = NB * CTX;
constexpr int MT = ML + MC;
constexpr int INC = 8960;
constexpr float NORM_EPS = 1e-6f, LN_EPS = 1e-5f, GN_EPS = 64e-5f;
constexpr float LOG2E = 1.4426950408889634f;
constexpr float QSCALE = 0.125f * LOG2E;

constexpr size_t MiB = 1u << 20;
constexpr size_t WS_MODB = 1 * MiB;
constexpr size_t WS_ROPE = WS_MODB + 256 * 1024;
constexpr size_t WS_SCAL = WS_ROPE + 16 * 1024;
constexpr size_t WS_WIN  = 2 * MiB;
constexpr size_t WS_WBR  = 20 * MiB;
constexpr size_t WS_WOUT = 23 * MiB;
constexpr size_t WS_WLORA = 25 * MiB;
constexpr size_t WS_XC   = 26 * MiB;
constexpr size_t WS_H    = 30 * MiB;
constexpr size_t WS_KB   = 64 * MiB;
constexpr size_t WS_QB   = 81 * MiB;
constexpr size_t WS_VB   = 98 * MiB;
constexpr size_t WS_RW   = 115 * MiB;
constexpr size_t WS_GU   = 166 * MiB;
constexpr size_t WS_VA   = 183 * MiB;
constexpr size_t WS_Z    = 200 * MiB;
constexpr size_t WS_G    = 251 * MiB;
constexpr size_t WS_WA   = 353 * MiB;
constexpr size_t WS_RWP  = 421 * MiB;
constexpr size_t WS_YD   = 489 * MiB;
constexpr size_t WS_WSET2 = 521 * MiB;
constexpr size_t WS_END  = 547 * MiB;

constexpr int LDS_BYTES = 147456;

__device__ __forceinline__ float bf2f(unsigned short h) { return __uint_as_float(((unsigned)h) << 16); }
typedef __bf16 bf16x2_t __attribute__((ext_vector_type(2)));
__device__ __forceinline__ unsigned cvt_pk_bf16(float lo, float hi) { f32x2 v = {lo, hi}; bf16x2_t b = __builtin_convertvector(v, bf16x2_t); return __builtin_bit_cast(unsigned, b); }
__device__ __forceinline__ float fast_sig(float z) { return __builtin_amdgcn_rcpf(1.0f + __builtin_amdgcn_exp2f(-z * LOG2E)); }
__device__ __forceinline__ float wave_sum(float v) {
#pragma unroll
    for (int o = 1; o < 64; o <<= 1) v += __shfl_xor(v, o);
    return v;
}
__device__ __forceinline__ void unpack8(const u32x4 w, float (&f)[8]) {
    f[0] = __uint_as_float(w.x << 16); f[1] = __uint_as_float(w.x & 0xffff0000u);
    f[2] = __uint_as_float(w.y << 16); f[3] = __uint_as_float(w.y & 0xffff0000u);
    f[4] = __uint_as_float(w.z << 16); f[5] = __uint_as_float(w.z & 0xffff0000u);
    f[6] = __uint_as_float(w.w << 16); f[7] = __uint_as_float(w.w & 0xffff0000u);
}
__device__ __forceinline__ u32x4 pack8(const float (&f)[8]) {
    u32x4 w; w.x = cvt_pk_bf16(f[0], f[1]); w.y = cvt_pk_bf16(f[2], f[3]); w.z = cvt_pk_bf16(f[4], f[5]); w.w = cvt_pk_bf16(f[6], f[7]); return w;
}

struct Args {
    const float* in[28];
    float* out; unsigned char* ws;
    int ph_lo, ph_hi;
};
typedef const __attribute__((address_space(4))) Args* ArgP;

namespace pg8 {
constexpr int BM = 256, BK = 64, HALF = 128, HTB = HALF * BK * 2, STAGE_BYTES = 8 * HTB, NXCD = 8, WGM = 8;
__host__ __device__ __forceinline__ int lds_byte(int r, int c) { const int st = (r >> 4) * 2 + (c >> 5), rr = r & 15, cc = c & 31, ob = rr * 64 + cc * 2; return st * 1024 + (ob ^ (((ob >> 9) & 1) << 5)); }
__host__ __device__ __forceinline__ void stage_rc(int b, int& R, int& C) { const int st = b / 1024, sb = b % 1024, swz = sb ^ (((sb >> 9) & 1) << 5); R = (st >> 1) * 16 + swz / 64; C = (st & 1) * 32 + (swz % 64) / 2; }
__host__ __device__ __forceinline__ int perm32(int rho) { const int n = rho >> 4, i = rho & 15; return 8 * (i >> 2) + 4 * n + (i & 3); }

struct Unit { int pm, pn, pz; };
struct Gemm { const bf16_t* A; const bf16_t* Bt; int lda, ldb, K; size_t zA, zB; };

struct Sched {
    int nM, nN, nZ, nwg, G, c, nM2, nN2;
    __device__ void init(int nM_, int nN_, int nZ_, int G_, int c_, int nM2_ = 0, int nN2_ = 0) { nM = nM_; nN = nN_; nZ = nZ_; nwg = nM * nN; G = G_; c = c_; nM2 = nM2_; nN2 = nN2_; }
    __device__ bool next(int i, Unit& u) const {
        const int ti = i / nZ, z = i - ti * nZ;
        const long L = (long)ti * G + c;
        if (L >= nwg) { const int e = (int)(L - nwg); if (e >= nM2 * nN2) return false; u.pm = nM + e % nM2; u.pn = e / nM2; u.pz = 0; return true; }
        int wgid = (int)L; { const int q = nwg / NXCD, r = nwg % NXCD, xcd = wgid % NXCD, off = wgid / NXCD; wgid = (xcd < r ? xcd * (q + 1) : r * (q + 1) + (xcd - r) * q) + off; }
        const int nig = WGM * nN, gid = wgid / nig, fm = gid * WGM, gsz = (nM - fm) < WGM ? (nM - fm) : WGM;
        u.pm = fm + ((wgid % nig) % gsz); u.pn = (wgid % nig) / gsz; u.pz = z; return true;
    }
};

template <class Epi>
__device__ __forceinline__ void gemm_phase(LAS unsigned char* lds, const Gemm g, const Sched& S, const Epi& E, const int tid) {
    const int wid = __builtin_amdgcn_readfirstlane(tid >> 6), lane = tid & 63, wr = wid >> 2, wc = wid & 3, fr = lane & 15, fq = lane >> 4;
    int Kl = g.K; asm volatile("" : "+s"(Kl));
    const int K = Kl, nt = K / BK;
    unsigned voffA[2], voffB[2];
#pragma unroll
    for (int i = 0; i < 2; ++i) { int R, C; stage_rc(tid * 16 + i * 8192, R, C); const int Rb = Epi::PERM ? ((R & ~31) + perm32(R & 31)) : R;
        voffA[i] = (unsigned)(R * g.lda + C) * 2u; voffB[i] = (unsigned)(Rb * g.ldb + C) * 2u; }
    const size_t kstep = (size_t)(BK * 2);
    const size_t hstepA = (size_t)HALF * g.lda * 2, hstepB = (size_t)HALF * g.ldb * 2;
    const size_t tstepA = 2 * hstepA, tstepB = 2 * hstepB;
    const unsigned ldsw = (unsigned)wid * 1024u;
    const int aoff = lds_byte(wr * 64 + fr, fq * 8), boff = lds_byte(wc * 32 + fr, fq * 8);
#define PG8_SA(b, h) (((b) * 2 + (h)) * HTB)
#define PG8_SB(b, h) ((4 + (b) * 2 + (h)) * HTB)
#define PG8_STAGE(bufoff, gbase, voff) do { _Pragma("unroll") for (int _i = 0; _i < 2; ++_i) \
        __builtin_amdgcn_global_load_lds((const unsigned*)((const char*)(gbase) + (voff)[_i]), (LAS unsigned*)(lds + (bufoff) + ldsw + _i * 8192), 16, 0, 0); } while (0)
#define PG8_LDA(dst, b, h) do { _Pragma("unroll") for (int m = 0; m < 4; ++m) _Pragma("unroll") for (int k = 0; k < 2; ++k) dst[m][k] = *(const LAS bf16x8*)(lds + PG8_SA(b, h) + aoff + m * 2048 + k * 1024); } while (0)
#define PG8_LDB(dst, b, h) do { _Pragma("unroll") for (int n = 0; n < 2; ++n) _Pragma("unroll") for (int k = 0; k < 2; ++k) dst[n][k] = *(const LAS bf16x8*)(lds + PG8_SB(b, h) + boff + n * 2048 + k * 1024); } while (0)
#define PG8_MMA(ai, bj, At, Bt) do { __builtin_amdgcn_s_setprio(1); _Pragma("unroll") for (int m = 0; m < 4; ++m) _Pragma("unroll") for (int n = 0; n < 2; ++n) _Pragma("unroll") for (int k = 0; k < 2; ++k) \
        acc[ai][bj][m][n] = __builtin_amdgcn_mfma_f32_16x16x32_bf16(Bt[n][k], At[m][k], acc[ai][bj][m][n], 0, 0, 0); __builtin_amdgcn_s_setprio(0); } while (0)
#define PG8_WAIT_V(n) asm volatile("s_waitcnt vmcnt(" #n ")" ::: "memory")
#define PG8_WAIT_L(n) asm volatile("s_waitcnt lgkmcnt(" #n ")" ::: "memory")
#define PG8_BAR __builtin_amdgcn_s_barrier()
#define PG8_SCHED __builtin_amdgcn_sched_barrier(0)
    Unit cur, nxt; int ui = 0;
    if (!S.next(0, cur)) return;
    f32x4 acc[2][2][4][2];
#pragma unroll
    for (int a = 0; a < 2; ++a)
#pragma unroll
        for (int b = 0; b < 2; ++b)
#pragma unroll
            for (int m = 0; m < 4; ++m)
#pragma unroll
                for (int n = 0; n < 2; ++n) acc[a][b][m][n] = (f32x4){0.f, 0.f, 0.f, 0.f};
    bf16x8 At[4][2], B0[2][2], B1[2][2];
    const char* cA = (const char*)g.A + (size_t)cur.pm * tstepA + (size_t)cur.pz * g.zA; const char* cB = (const char*)g.Bt + (size_t)cur.pn * tstepB + (size_t)cur.pz * g.zB;
    PG8_STAGE(PG8_SB(0, 0), cB, voffB); PG8_STAGE(PG8_SB(0, 1), cB + hstepB, voffB); PG8_STAGE(PG8_SA(0, 0), cA, voffA); PG8_STAGE(PG8_SA(0, 1), cA + hstepA, voffA);
    if (wr == 1) PG8_BAR;
    PG8_WAIT_V(2); PG8_BAR;
    PG8_STAGE(PG8_SB(1, 0), cB + kstep, voffB); PG8_STAGE(PG8_SA(1, 0), cA + kstep, voffA); PG8_STAGE(PG8_SB(1, 1), cB + hstepB + kstep, voffB);
    PG8_WAIT_V(6); PG8_BAR;
    for (;;) {
        const bool has_next = S.next(ui + 1, nxt);
        const char* nA = has_next ? (const char*)g.A + (size_t)nxt.pm * tstepA + (size_t)nxt.pz * g.zA : cA;
        const char* nB = has_next ? (const char*)g.Bt + (size_t)nxt.pn * tstepB + (size_t)nxt.pz * g.zB : cB;
        for (int t = 0; t < nt; t += 2) {
            const bool last = (t == nt - 2);
            const char* a1 = cA + (size_t)(t + 1) * kstep;
            const char* a2 = last ? nA : cA + (size_t)(t + 2) * kstep; const char* b2 = last ? nB : cB + (size_t)(t + 2) * kstep;
            const char* a3 = a2 + kstep; const char* b3 = b2 + kstep;
            PG8_LDB(B0, 0, 0); PG8_LDB(B1, 0, 1); PG8_SCHED; PG8_LDA(At, 0, 0); PG8_STAGE(PG8_SA(1, 1), a1 + hstepA, voffA);
            PG8_WAIT_V(8); PG8_WAIT_L(0); PG8_BAR; PG8_MMA(0, 0, At, B0); PG8_MMA(0, 1, At, B1); PG8_BAR; PG8_SCHED;
            PG8_LDA(At, 0, 1); PG8_STAGE(PG8_SB(0, 0), b2, voffB); PG8_STAGE(PG8_SB(0, 1), b2 + hstepB, voffB); PG8_STAGE(PG8_SA(0, 0), a2, voffA);
            PG8_WAIT_V(8); PG8_WAIT_L(0); PG8_BAR; PG8_MMA(1, 0, At, B0); PG8_MMA(1, 1, At, B1); PG8_BAR; PG8_SCHED;
            PG8_LDB(B0, 1, 0); PG8_LDB(B1, 1, 1); PG8_SCHED; PG8_LDA(At, 1, 0); PG8_STAGE(PG8_SA(0, 1), a2 + hstepA, voffA);
            PG8_WAIT_V(8); PG8_WAIT_L(0); PG8_BAR; PG8_MMA(0, 0, At, B0); PG8_MMA(0, 1, At, B1); PG8_BAR; PG8_SCHED;
            PG8_LDA(At, 1, 1); PG8_STAGE(PG8_SB(1, 0), b3, voffB); PG8_STAGE(PG8_SB(1, 1), b3 + hstepB, voffB); PG8_STAGE(PG8_SA(1, 0), a3, voffA);
            PG8_WAIT_V(8); PG8_WAIT_L(0); PG8_BAR; PG8_MMA(1, 0, At, B0); PG8_MMA(1, 1, At, B1); PG8_BAR; PG8_SCHED;
        }
        if (wr == 0) PG8_BAR;
        E(acc, cur, wr, wc, fr, fq);
        if (!has_next) break;
#pragma unroll
        for (int a = 0; a < 2; ++a)
#pragma unroll
            for (int b = 0; b < 2; ++b)
#pragma unroll
                for (int m = 0; m < 4; ++m)
#pragma unroll
                    for (int n = 0; n < 2; ++n) acc[a][b][m][n] = (f32x4){0.f, 0.f, 0.f, 0.f};
        cur = nxt; cA = nA; cB = nB; ++ui;
        if (wr == 1) PG8_BAR;
    }
    PG8_WAIT_V(0);
    PG8_BAR;
#undef PG8_SA
#undef PG8_SB
#undef PG8_STAGE
#undef PG8_LDA
#undef PG8_LDB
#undef PG8_MMA
#undef PG8_WAIT_V
#undef PG8_WAIT_L
#undef PG8_BAR
#undef PG8_SCHED
}

template <int ACT> __device__ __forceinline__ float act_f(float x) {
    if (ACT == 0) return x;
    if (ACT == 1) { const float z = x * (1.5957691216f + 0.0713548163f * x * x); return x * fast_sig(z); }
    if (ACT == 2) return x * fast_sig(x);
    if (ACT == 3) return fast_sig(x);
    return 2.0f * fast_sig(2.0f * x) - 1.0f;
}
template <int ACT0, int ACT1> __device__ __forceinline__ void epi_store_bf16(const f32x4 (&acc)[2][2][4][2], bf16_t* base, int ld, int row0, int col0) {
#pragma unroll
    for (int ai = 0; ai < 2; ++ai)
#pragma unroll
        for (int m = 0; m < 4; ++m) { bf16_t* rowp = base + (size_t)(row0 + ai * HALF + m * 16) * ld + col0;
#pragma unroll
            for (int bj = 0; bj < 2; ++bj) { const f32x4 v0 = acc[ai][bj][m][0], v1 = acc[ai][bj][m][1];
                float o[8];
                if (bj == 0) { o[0] = act_f<ACT0>(v0[0]); o[1] = act_f<ACT0>(v0[1]); o[2] = act_f<ACT0>(v0[2]); o[3] = act_f<ACT0>(v0[3]); o[4] = act_f<ACT0>(v1[0]); o[5] = act_f<ACT0>(v1[1]); o[6] = act_f<ACT0>(v1[2]); o[7] = act_f<ACT0>(v1[3]); }
                else         { o[0] = act_f<ACT1>(v0[0]); o[1] = act_f<ACT1>(v0[1]); o[2] = act_f<ACT1>(v0[2]); o[3] = act_f<ACT1>(v0[3]); o[4] = act_f<ACT1>(v1[0]); o[5] = act_f<ACT1>(v1[1]); o[6] = act_f<ACT1>(v1[2]); o[7] = act_f<ACT1>(v1[3]); }
                *(u32x4*)(rowp + bj * HALF) = pack8(o); } __builtin_amdgcn_sched_barrier(0); }
}
struct Epi1 {
    static constexpr bool PERM = true;
    bf16_t *Kb, *Vb, *RW, *LA, *Qb, *GU, *VA, *Z, *G;
    __device__ __forceinline__ void operator()(const f32x4 (&acc)[2][2][4][2], const Unit& u, int wr, int wc, int fr, int fq) const {
        const int pn = u.pn; bf16_t* base; int ld, colt, act;
        if (pn < 2)       { base = Kb; ld = 512;  colt = pn * 256;               act = 0; }
        else if (pn < 4)  { base = Vb; ld = 512;  colt = (pn - 2) * 256;         act = 0; }
        else if (pn < 8)  { base = RW; ld = 1536; colt = (pn - 4) * 256;         act = 0; }
        else if (pn == 8) { base = LA; ld = 256;  colt = 0;                      act = 4; }
        else if (pn < 11) { base = Qb; ld = 512;  colt = (pn - 9) * 256;         act = 0; }
        else if (pn < 13) { base = RW; ld = 1536; colt = 1024 + (pn - 11) * 256; act = 0; }
        else if (pn < 15) { base = GU; ld = 512;  colt = (pn - 13) * 256;        act = 1; }
        else if (pn < 17) { base = VA; ld = 512;  colt = (pn - 15) * 256;        act = 1; }
        else if (pn < 23) { base = Z;  ld = 1536; colt = (pn - 17) * 256;        act = 2; }
        else              { base = G;  ld = 3072; colt = (pn - 23) * 256;        act = 3; }
        const int row0 = u.pm * BM + wr * 64 + fr, col0 = colt + wc * 32 + 8 * fq;
        if (act == 0) epi_store_bf16<0, 0>(acc, base, ld, row0, col0);
        else if (act == 1) epi_store_bf16<1, 1>(acc, base, ld, row0, col0);
        else if (act == 2) epi_store_bf16<2, 2>(acc, base, ld, row0, col0);
        else if (act == 3) epi_store_bf16<3, 3>(acc, base, ld, row0, col0);
        else epi_store_bf16<4, 0>(acc, base, ld, row0, col0);
    }
};
template <bool ISW> __device__ __forceinline__ void epi_lora_store(const f32x4 (&acc)[2][2][4][2], bf16_t* WA, const float* bias, int row0, int col0) {
#pragma unroll
    for (int bj = 0; bj < 2; ++bj) {
        const f32x4 bv0 = *(const f32x4*)(bias + bj * HALF), bv1 = *(const f32x4*)(bias + bj * HALF + 4);
#pragma unroll
        for (int ai = 0; ai < 2; ++ai)
#pragma unroll
            for (int m = 0; m < 4; ++m) { bf16_t* rowp = WA + (size_t)(row0 + ai * HALF + m * 16) * 2048 + col0 + bj * HALF; float o[8];
#pragma unroll
                for (int e = 0; e < 4; ++e) { const float s0 = fast_sig(acc[ai][bj][m][0][e] + bv0[e]), s1 = fast_sig(acc[ai][bj][m][1][e] + bv1[e]);
                    o[e] = ISW ? (1.0f - __builtin_amdgcn_exp2f(-0.60653065971f * LOG2E * s0)) : s0;
                    o[4 + e] = ISW ? (1.0f - __builtin_amdgcn_exp2f(-0.60653065971f * LOG2E * s1)) : s1; }
                *(u32x4*)rowp = pack8(o); __builtin_amdgcn_sched_barrier(0); }
        asm volatile("" ::: "memory");
    }
}
struct EpiLora {
    static constexpr bool PERM = true;
    bf16_t* WA; const float* w0; const float* a0;
    __device__ __forceinline__ void operator()(const f32x4 (&acc)[2][2][4][2], const Unit& u, int wr, int wc, int fr, int fq) const {
        const int row0 = u.pm * BM + wr * 64 + fr, col0 = u.pn * BM + wc * 32 + 8 * fq;
        if (u.pn < 4) epi_lora_store<true>(acc, WA, w0 + col0, row0, col0);
        else epi_lora_store<false>(acc, WA, a0 + col0 - 1024, row0, col0);
    }
};
struct EpiMerge {
    static constexpr bool PERM = true;
    const bf16_t* G; bf16_t* MB; int z0; bool first;
    __device__ __forceinline__ void operator()(const f32x4 (&acc)[2][2][4][2], const Unit& u, int wr, int wc, int fr, int fq) const {
        const int row0 = u.pm * BM + wr * 64 + fr, col0 = u.pn * BM + wc * 32 + 8 * fq, z = z0; const bool accu = !first;
        u32x4 gc[2], gn[2], pc[2], pn_[2];
#define MLOAD(dg, dp, g_) do { const size_t row_ = (size_t)(row0 + ((g_) >> 2) * HALF + ((g_) & 3) * 16); \
        _Pragma("unroll") for (int bj = 0; bj < 2; ++bj) { const int c_ = col0 + bj * HALF; dg[bj] = *(const u32x4*)(G + row_ * 3072 + z * 1024 + c_); \
            if (accu) dp[bj] = *(const u32x4*)(MB + row_ * 1024 + c_); } } while (0)
        MLOAD(gc, pc, 0);
#pragma unroll
        for (int g = 0; g < 8; ++g) { const int ai = g >> 2, m = g & 3; const size_t row = (size_t)(row0 + ai * HALF + m * 16);
            if (g + 1 < 8) MLOAD(gn, pn_, g + 1);
#pragma unroll
            for (int bj = 0; bj < 2; ++bj) { const int c = col0 + bj * HALF; float gf[8]; unpack8(gc[bj], gf); float o[8];
#pragma unroll
                for (int n = 0; n < 2; ++n)
#pragma unroll
                    for (int e = 0; e < 4; ++e) o[n * 4 + e] = acc[ai][bj][m][n][e] * gf[n * 4 + e];
                if (accu) { float pf[8]; unpack8(pc[bj], pf);
#pragma unroll
                    for (int e = 0; e < 8; ++e) o[e] += pf[e]; }
                *(u32x4*)(MB + row * 1024 + c) = pack8(o); }
#pragma unroll
            for (int bj = 0; bj < 2; ++bj) { gc[bj] = gn[bj]; pc[bj] = pn_[bj]; } }
#undef MLOAD
    }
};
struct EpiOut {
    static constexpr bool PERM = false;
    const float* xin; float* xout; const float* xcin; float* xcout; const float* modl;
    __device__ __forceinline__ void operator()(const f32x4 (&acc)[2][2][4][2], const Unit& u, int wr, int wc, int fr, int fq) const {
        const bool lat = u.pm < (ML / BM);
        const int b = lat ? (u.pm >> 4) : 4;
        const float* src = lat ? xin : xcin; float* dst = lat ? xout : xcout;
        const int row0 = (lat ? u.pm * BM : u.pm * BM - ML) + wr * 64 + fr, col0 = u.pn * BM + wc * 32 + 4 * fq;
        const float* gate = modl + b * 3072 + 2048 + col0;
        f32x4 gv[2][2];
#pragma unroll
        for (int bj = 0; bj < 2; ++bj)
#pragma unroll
            for (int n = 0; n < 2; ++n) gv[bj][n] = *(const f32x4*)(gate + bj * HALF + n * 16);
        f32x4 xc[2][2], xn[2][2];
#define XLOAD(dst, g_) do { const size_t off_ = (size_t)(row0 + ((g_) >> 2) * HALF + ((g_) & 3) * 16) * 1024 + col0; \
        _Pragma("unroll") for (int bj = 0; bj < 2; ++bj) _Pragma("unroll") for (int n = 0; n < 2; ++n) dst[bj][n] = *(const f32x4*)(src + off_ + bj * HALF + n * 16); } while (0)
        XLOAD(xc, 0);
#pragma unroll
        for (int g = 0; g < 8; ++g) { const int ai = g >> 2, m = g & 3; const size_t off = (size_t)(row0 + ai * HALF + m * 16) * 1024 + col0;
            if (g + 1 < 8) XLOAD(xn, g + 1);
#pragma unroll
            for (int bj = 0; bj < 2; ++bj)
#pragma unroll
                for (int n = 0; n < 2; ++n) *(f32x4*)(dst + off + bj * HALF + n * 16) = xc[bj][n] + gv[bj][n] * acc[ai][bj][m][n];
#pragma unroll
            for (int bj = 0; bj < 2; ++bj)
#pragma unroll
                for (int n = 0; n < 2; ++n) xc[bj][n] = xn[bj][n]; }
#undef XLOAD
    }
};
}

__device__ __forceinline__ void phase_A(ArgP a, LAS unsigned char* lds, int tid, int wave, int lane, int bid, int G) {
    float* MODB = (float*)(a->ws + WS_MODB); f32x2* ROPE = (f32x2*)(a->ws + WS_ROPE); float* SCAL = (float*)(a->ws + WS_SCAL);
    for (int u = bid; u < 194; u += G) {
        if (u < 192) {
            const int l = u / 48, n0 = (u % 48) * 64;
            LAS float* act = (LAS float*)lds;
            for (int i = tid; i < 5120; i += 512) { const int b = i >> 10, k = i & 1023; const float v = b < 4 ? a->in[1][b * 1024 + k] : a->in[3][k]; act[i] = v / (1.0f + __expf(-v)); }
            __syncthreads();
            float acc[5] = {0.f, 0.f, 0.f, 0.f, 0.f};
            const float* W = a->in[4] + ((size_t)l * 1024 + wave * 128) * 3072 + n0 + lane;
#pragma unroll 16
            for (int k = 0; k < 128; ++k) { const float w = W[(size_t)k * 3072];
#pragma unroll
                for (int b = 0; b < 5; ++b) acc[b] += act[b * 1024 + wave * 128 + k] * w; }
            LAS float* part = (LAS float*)(lds + 20480);
#pragma unroll
            for (int b = 0; b < 5; ++b) part[(wave * 5 + b) * 64 + lane] = acc[b];
            __syncthreads();
            if (tid < 320) { const int b = tid >> 6, ln = tid & 63; float s = a->in[5][l * 3072 + n0 + ln];
#pragma unroll
                for (int w = 0; w < 8; ++w) s += part[(w * 5 + b) * 64 + ln];
                MODB[(size_t)(l * 5 + b) * 3072 + n0 + ln] = s; }
            __syncthreads();
        } else if (u == 192) {
            for (int i = tid; i < 1024; i += 512) { const int pos = i >> 4, f = i & 15;
                const float inv = exp2f(-(float)f * (13.287712379549449f / 16.0f)); const float ang = (float)pos * inv;
                ROPE[i] = (f32x2){cosf(ang), sinf(ang)}; }
        } else {
            if (tid < NL) { const int l = tid; const float* lp = a->in[14] + l * 256;
                float s1 = 0.f, s2 = 0.f; for (int i = 0; i < 64; ++i) { s1 += lp[i] * lp[64 + i]; s2 += lp[128 + i] * lp[192 + i]; }
                const float li = l == 0 ? 0.2f : l == 1 ? 0.35550907f : l == 2 ? 0.47071302f : 0.55605819f;
                float gq = 0.f, gk = 0.f; for (int i = 0; i < 64; ++i) { gq = fmaxf(gq, fabsf(a->in[12][l * 64 + i])); gk = fmaxf(gk, fabsf(a->in[13][l * 64 + i])); }
                SCAL[l * 8 + 0] = expf(s1) - expf(s2) + li;
                SCAL[l * 8 + 1] = -(64.0f * QSCALE * gq * gk * 1.001f);
                SCAL[l * 8 + 2] = 1.0f - li; }
        }
    }
}

__device__ __forceinline__ void transpose_item(const float* W, int K, int N, bf16_t* WT, LAS float* scr, int item, int lane) {
    const int nblk = N / 32, kb = item / nblk, nb = item % nblk, k0 = 64 * kb, n0 = 32 * nb;
#pragma unroll 8
    for (int i = 0; i < 32; ++i) { const int kk = 2 * i + (lane >> 5); scr[kk * 33 + (lane & 31)] = W[(size_t)(k0 + kk) * N + n0 + (lane & 31)]; }
    asm volatile("s_waitcnt lgkmcnt(0)" ::: "memory");
    const int c = lane & 7;
#pragma unroll
    for (int j = 0; j < 4; ++j) { const int n = (lane >> 3) + 8 * j; const LAS float* s = scr + (8 * c) * 33 + n;
        u32x4 o; o.x = cvt_pk_bf16(s[0 * 33], s[1 * 33]); o.y = cvt_pk_bf16(s[2 * 33], s[3 * 33]); o.z = cvt_pk_bf16(s[4 * 33], s[5 * 33]); o.w = cvt_pk_bf16(s[6 * 33], s[7 * 33]);
        *(u32x4*)(WT + (size_t)(n0 + n) * K + k0 + 8 * c) = o; }
    asm volatile("s_waitcnt lgkmcnt(0)" ::: "memory");
}
__device__ __forceinline__ void convert_weights(ArgP a, int l, LAS unsigned char* lds, int wave, int lane, int gw, int NGW) {
    LAS float* scr = (LAS float*)(lds + wave * 16384);
    unsigned char* wb = a->ws + (size_t)(l & 1) * WS_WSET2;
    bf16_t* WIN = (bf16_t*)(wb + WS_WIN); bf16_t* WBR = (bf16_t*)(wb + WS_WBR); bf16_t* WOUT = (bf16_t*)(wb + WS_WOUT); bf16_t* WLORA = (bf16_t*)(wb + WS_WLORA);
    constexpr int I_IN = (1024 / 64) * (INC / 32), I_BR = (512 / 64) * (1024 / 32), I_OUT = (1024 / 64) * (1024 / 32), I_LORA = 1024;
    constexpr int NITEMS = I_IN + 3 * I_BR + I_OUT + I_LORA;
    for (int it = gw; it < NITEMS; it += NGW) {
        int r = it;
        if (r < I_IN) { transpose_item(a->in[7] + (size_t)l * 1024 * INC, 1024, INC, WIN, scr, r, lane); continue; } r -= I_IN;
        if (r < 3 * I_BR) { const int i = r / I_BR; transpose_item(a->in[26] + ((size_t)l * 3 + i) * 512 * 1024, 512, 1024, WBR + (size_t)i * 1024 * 512, scr, r % I_BR, lane); continue; } r -= 3 * I_BR;
        if (r < I_OUT) { transpose_item(a->in[27] + (size_t)l * 1024 * 1024, 1024, 1024, WOUT, scr, r, lane); continue; } r -= I_OUT;
        {
            const int idx = r * 512 + lane * 8, n = idx >> 8, k = idx & 255, kb = k >> 6, rr = k & 63;
            const bool isw = n < 1024; const int nn = isw ? n : n - 1024, d = nn >> 9, c = nn & 511;
            const float* src = (isw ? a->in[18] : a->in[20]) + ((size_t)(l * 2 + d) * 64 + rr) * 512 + c;
            const bool nz = kb == (isw ? d : 2 + d);
            float f[8];
#pragma unroll
            for (int e = 0; e < 8; ++e) f[e] = nz ? src[(size_t)e * 512] : 0.f;
            *(u32x4*)(WLORA + idx) = pack8(f);
        }
    }
}
__device__ __forceinline__ void phase_B(ArgP a, int l, LAS unsigned char* lds, int tid, int wave, int lane, int bid, int G) {
    const int gw = bid * 8 + wave, NGW = G * 8;
    const float* xin = l == 0 ? a->in[0] : a->out; const float* xcin = l == 0 ? a->in[2] : (const float*)(a->ws + WS_XC);
    const float* modl = (const float*)(a->ws + WS_MODB) + (size_t)l * 5 * 3072; const float* ng = a->in[6] + l * 1024;
    bf16_t* H = (bf16_t*)(a->ws + WS_H);
    for (int m = gw; m < MT; m += NGW) {
        const bool lat = m < ML; const int b = lat ? (m >> 12) : 4;
        const f32x4* xr = (const f32x4*)(lat ? xin + (size_t)m * 1024 : xcin + (size_t)(m - ML) * 1024) + lane;
        f32x4 v[4]; float s = 0.f;
#pragma unroll
        for (int j = 0; j < 4; ++j) { v[j] = xr[64 * j]; s += (v[j].x * v[j].x + v[j].y * v[j].y) + (v[j].z * v[j].z + v[j].w * v[j].w); }
        const float rstd = 1.0f / sqrtf(wave_sum(s) * (1.0f / 1024.0f) + NORM_EPS);
        u32x2* o8 = (u32x2*)(H + (size_t)m * 1024) + lane;
#pragma unroll
        for (int j = 0; j < 4; ++j) { const int c = 4 * lane + 256 * j;
            const f32x4 g = *(const f32x4*)(ng + c), sh = *(const f32x4*)(modl + b * 3072 + c), sc = *(const f32x4*)(modl + b * 3072 + 1024 + c);
            const f32x4 h = v[j] * rstd * g * (1.0f + sc) + sh;
            o8[64 * j] = (u32x2){cvt_pk_bf16(h.x, h.y), cvt_pk_bf16(h.z, h.w)}; }
    }
}

__device__ __forceinline__ void qk_normrope(const u32x4 w, bf16_t* rowp, const float* gain, float oscale, bool rope, int ridx, int cidx, const f32x2* ROPE, int lane) {
    const int sub = lane & 7;
    float x[8]; unpack8(w, x);
    float ss = 0.f;
#pragma unroll
    for (int e = 0; e < 8; ++e) ss += x[e] * x[e];
    ss += __shfl_xor(ss, 1); ss += __shfl_xor(ss, 2); ss += __shfl_xor(ss, 4);
    const float rstd = 1.0f / sqrtf(ss * (1.0f / 64.0f) + NORM_EPS);
    const f32x4 g0 = *(const f32x4*)(gain + sub * 8), g1 = *(const f32x4*)(gain + sub * 8 + 4);
    x[0] *= rstd * g0.x; x[1] *= rstd * g0.y; x[2] *= rstd * g0.z; x[3] *= rstd * g0.w; x[4] *= rstd * g1.x; x[5] *= rstd * g1.y; x[6] *= rstd * g1.z; x[7] *= rstd * g1.w;
    float p[8];
#pragma unroll
    for (int e = 0; e < 8; ++e) p[e] = __shfl_xor(x[e], 2);
    if (rope) {
        const int pos = (sub < 4) ? ridx : cidx; const bool first = (sub & 2) == 0; const f32x4* tb = (const f32x4*)(ROPE + pos * 16 + 8 * (sub & 1));
#pragma unroll
        for (int e2 = 0; e2 < 4; ++e2) { const f32x4 cs = tb[e2];
            x[2 * e2] = first ? (x[2 * e2] * cs.x - p[2 * e2] * cs.y) : (p[2 * e2] * cs.y + x[2 * e2] * cs.x);
            x[2 * e2 + 1] = first ? (x[2 * e2 + 1] * cs.z - p[2 * e2 + 1] * cs.w) : (p[2 * e2 + 1] * cs.w + x[2 * e2 + 1] * cs.z); }
    }
#pragma unroll
    for (int e = 0; e < 8; ++e) x[e] *= oscale;
    *(u32x4*)(rowp + lane * 8) = pack8(x);
}
__device__ __forceinline__ void phase_prep(ArgP a, int l, int tid, int wave, int lane, int bid, int G) {
    const int gw = bid * 8 + wave, NGW = G * 8;
    bf16_t* Kb = (bf16_t*)(a->ws + WS_KB); bf16_t* Qb = (bf16_t*)(a->ws + WS_QB); bf16_t* VA = (bf16_t*)(a->ws + WS_VA);
    const bf16_t* RW = (const bf16_t*)(a->ws + WS_RW); bf16_t* RWP = (bf16_t*)(a->ws + WS_RWP);
    const f32x2* ROPE = (const f32x2*)(a->ws + WS_ROPE);
    const float* qg = a->in[12] + l * 64; const float* kg = a->in[13] + l * 64;
    const float* lng = a->in[8] + l * 512; const float* lnb = a->in[9] + l * 512;
    const float* conv = a->in[16] + (size_t)l * 9 * 512;
    const float* rkk = a->in[21] + l * 512;
    for (int m = gw; m < MT; m += NGW) {
        const bool lat = m < ML; const int t = lat ? (m & 4095) : ((m - ML) & 255); const int tlast = lat ? 4095 : 255;
        const bf16_t* r0 = RW + (size_t)m * 1536 + lane * 8; const bool hp = t > 0, hn = t < tlast;
        const u32x4 wk = *(const u32x4*)(Kb + (size_t)m * 512 + lane * 8), wq = *(const u32x4*)(Qb + (size_t)m * 512 + lane * 8), wva = *(const u32x4*)(VA + (size_t)m * 512 + lane * 8);
        u32x4 wc[3], wp[3], wn[3];
#pragma unroll
        for (int w = 0; w < 3; ++w) { wc[w] = *(const u32x4*)(r0 + w * 512); wp[w] = (u32x4){0u, 0u, 0u, 0u}; wn[w] = (u32x4){0u, 0u, 0u, 0u};
            if (hp) wp[w] = *(const u32x4*)(r0 + w * 512 - 1536);
            if (hn) wn[w] = *(const u32x4*)(r0 + w * 512 + 1536); }
        qk_normrope(wk, Kb + (size_t)m * 512, kg, 1.0f, lat, t >> 6, t & 63, ROPE, lane);
        qk_normrope(wq, Qb + (size_t)m * 512, qg, QSCALE, lat, t >> 6, t & 63, ROPE, lane);
        {   bf16_t* rp = VA + (size_t)m * 512 + lane * 8; float x[8]; unpack8(wva, x);
            float s = 0.f;
#pragma unroll
            for (int e = 0; e < 8; ++e) s += x[e];
            const float mu = wave_sum(s) * (1.0f / 512.0f); float q = 0.f;
#pragma unroll
            for (int e = 0; e < 8; ++e) { x[e] -= mu; q += x[e] * x[e]; }
            const float rstd = 1.0f / sqrtf(wave_sum(q) * (1.0f / 512.0f) + LN_EPS);
            const f32x4 g0 = *(const f32x4*)(lng + lane * 8), g1 = *(const f32x4*)(lng + lane * 8 + 4), b0 = *(const f32x4*)(lnb + lane * 8), b1 = *(const f32x4*)(lnb + lane * 8 + 4);
            x[0] = x[0] * rstd * g0.x + b0.x; x[1] = x[1] * rstd * g0.y + b0.y; x[2] = x[2] * rstd * g0.z + b0.z; x[3] = x[3] * rstd * g0.w + b0.w;
            x[4] = x[4] * rstd * g1.x + b1.x; x[5] = x[5] * rstd * g1.y + b1.y; x[6] = x[6] * rstd * g1.z + b1.z; x[7] = x[7] * rstd * g1.w + b1.w;
            *(u32x4*)rp = pack8(x); }
        {   float o[3][8];
#pragma unroll
            for (int w = 0; w < 3; ++w) {
                const int ci = (w == 0) ? 1 : (w == 1) ? 2 : 0; const float* tp = conv + (size_t)ci * 3 * 512 + lane * 8;
                float xc[8], xp[8], xn[8]; unpack8(wc[w], xc); unpack8(wp[w], xp); unpack8(wn[w], xn);
                const f32x4 t0a = *(const f32x4*)tp, t0b = *(const f32x4*)(tp + 4), t1a = *(const f32x4*)(tp + 512), t1b = *(const f32x4*)(tp + 516), t2a = *(const f32x4*)(tp + 1024), t2b = *(const f32x4*)(tp + 1028);
#pragma unroll
                for (int e = 0; e < 4; ++e) { o[w][e] = xp[e] * t0a[e] + xc[e] * t1a[e] + xn[e] * t2a[e]; o[w][4 + e] = xp[4 + e] * t0b[e] + xc[4 + e] * t1b[e] + xn[4 + e] * t2b[e]; } }
            float kq[8], ss = 0.f; const f32x4 rk0 = *(const f32x4*)(rkk + lane * 8), rk1 = *(const f32x4*)(rkk + lane * 8 + 4);
#pragma unroll
            for (int e = 0; e < 8; ++e) { kq[e] = o[0][e] * ((e < 4) ? rk0[e & 3] : rk1[e & 3]); ss += kq[e] * kq[e]; }
            ss += __shfl_xor(ss, 1); ss += __shfl_xor(ss, 2); ss += __shfl_xor(ss, 4);
            const float inv = 1.0f / fmaxf(sqrtf(ss), 1e-12f);
#pragma unroll
            for (int e = 0; e < 8; ++e) kq[e] *= inv;
            bf16_t* op = RWP + (size_t)m * 2048 + lane * 8;
            *(u32x4*)(op) = pack8(kq); *(u32x4*)(op + 512) = pack8(o[0]); *(u32x4*)(op + 1024) = pack8(o[1]); *(u32x4*)(op + 1536) = pack8(o[2]); }
    }
}

#define SBAR() __builtin_amdgcn_sched_barrier(0)
__device__ __forceinline__ int crow(int r, int hi) { return (r & 3) + 8 * (r >> 2) + 4 * hi; }
__device__ __forceinline__ int v_st(int k, int c) { const int kk = (k & ~0xC) | ((k & 4) << 1) | ((k & 8) >> 1); return ((kk >> 3) * 4 + (c >> 5)) * 512 + ((kk & 7) * 32 + (c & 31)) * 2; }
__device__ __forceinline__ int v_rd_base(int lane) { return ((lane & 3) << 3) | (((lane >> 2) & 3) << 6) | (((lane >> 4) & 1) << 5) | (((lane >> 5) & 1) << 8); }
constexpr int v_rd_off(int d0, int ks, int half) { return d0 * 512 + ks * 4096 + half * 2048; }
template <int OFF> __device__ __forceinline__ s16x4 tr_read(int vb) {
    s16x4 r; asm volatile("ds_read_b64_tr_b16 %0, %1 offset:%2" : "=&v"(r) : "v"(vb), "i"(OFF) : "memory"); return r;
}
template <int D0> __device__ __forceinline__ void pv_one(f32x16& od, int vb, bf16x8 pa0, bf16x8 pa1, bf16x8 pa2, bf16x8 pa3) {
    const s16x4 l0 = tr_read<v_rd_off(D0, 0, 0)>(vb), h0 = tr_read<v_rd_off(D0, 0, 1)>(vb), l1 = tr_read<v_rd_off(D0, 1, 0)>(vb), h1 = tr_read<v_rd_off(D0, 1, 1)>(vb);
    const s16x4 l2 = tr_read<v_rd_off(D0, 2, 0)>(vb), h2 = tr_read<v_rd_off(D0, 2, 1)>(vb), l3 = tr_read<v_rd_off(D0, 3, 0)>(vb), h3 = tr_read<v_rd_off(D0, 3, 1)>(vb);
    asm volatile("s_waitcnt lgkmcnt(0)" ::: "memory"); SBAR();
#define PK(L, H) (bf16x8){L[0], L[1], L[2], L[3], H[0], H[1], H[2], H[3]}
    od = __builtin_amdgcn_mfma_f32_32x32x16_bf16(pa0, PK(l0, h0), od, 0, 0, 0);
    od = __builtin_amdgcn_mfma_f32_32x32x16_bf16(pa1, PK(l1, h1), od, 0, 0, 0);
    od = __builtin_amdgcn_mfma_f32_32x32x16_bf16(pa2, PK(l2, h2), od, 0, 0, 0);
    od = __builtin_amdgcn_mfma_f32_32x32x16_bf16(pa3, PK(l3, h3), od, 0, 0, 0);
#undef PK
}

namespace att {
constexpr int SHM_V = 16384, SHM_K = 9216, OFF_K = 4 * SHM_V, OFF_WS = OFF_K + 2 * SHM_K;
#define KSWZ(row, colB) ((row) * 144 + (colB))
__device__ __forceinline__ void qkt(f32x16& p0, f32x16& p1, const char* Ks, const bf16x8* qr, int r32, int hi) {
    p0 = f32x16{}; p1 = f32x16{};
#pragma unroll
    for (int d0 = 0; d0 < 4; ++d0) { const int cb = (d0 * 16 + hi * 8) * 2;
        const bf16x8 b0 = *reinterpret_cast<const bf16x8*>(Ks + KSWZ(r32, cb));
        const bf16x8 b1 = *reinterpret_cast<const bf16x8*>(Ks + KSWZ(32 + r32, cb));
        p0 = __builtin_amdgcn_mfma_f32_32x32x16_bf16(b0, qr[d0], p0, 0, 0, 0);
        p1 = __builtin_amdgcn_mfma_f32_32x32x16_bf16(b1, qr[d0], p1, 0, 0, 0); }
}
__device__ __forceinline__ void partialSM(f32x16& p0) {
#pragma unroll
    for (int r = 0; r < 16; ++r) p0[r] = __builtin_amdgcn_exp2f(p0[r]);
}
__device__ __forceinline__ void finishSM(f32x16& p0, f32x16& p1, float& l_reg, bf16x8& pa0, bf16x8& pa1, bf16x8& pa2, bf16x8& pa3) {
#pragma unroll
    for (int r = 0; r < 16; ++r) p1[r] = __builtin_amdgcn_exp2f(p1[r]);
    float ps = 0.f;
#pragma unroll
    for (int r = 0; r < 16; ++r) ps += p0[r];
#pragma unroll
    for (int r = 0; r < 16; ++r) ps += p1[r];
    l_reg += ps;
#define PK4(P, BASE, OUT) do { unsigned a0 = cvt_pk_bf16(P[BASE + 0], P[BASE + 1]), a1 = cvt_pk_bf16(P[BASE + 2], P[BASE + 3]);   \
    unsigned b0 = cvt_pk_bf16(P[BASE + 4], P[BASE + 5]), b1 = cvt_pk_bf16(P[BASE + 6], P[BASE + 7]);                              \
    auto r0 = __builtin_amdgcn_permlane32_swap(a0, b0, false, false); auto r1 = __builtin_amdgcn_permlane32_swap(a1, b1, false, false); \
    u32x4 w = {r0[0], r1[0], r0[1], r1[1]}; OUT = *reinterpret_cast<bf16x8*>(&w); } while (0)
    PK4(p0, 0, pa0); PK4(p0, 8, pa1); PK4(p1, 0, pa2); PK4(p1, 8, pa3);
#undef PK4
}
__device__ __forceinline__ void pv_d0(f32x16* o, int vb, bf16x8 pa0, bf16x8 pa1, bf16x8 pa2, bf16x8 pa3) {
    pv_one<0>(o[0], vb, pa0, pa1, pa2, pa3); pv_one<1>(o[1], vb, pa0, pa1, pa2, pa3); pv_one<2>(o[2], vb, pa0, pa1, pa2, pa3); pv_one<3>(o[3], vb, pa0, pa1, pa2, pa3);
}
template <int D0> __device__ __forceinline__ void tr8(int vb, s16x4 (&r)[8]) {
    r[0] = tr_read<v_rd_off(D0, 0, 0)>(vb); r[1] = tr_read<v_rd_off(D0, 0, 1)>(vb); r[2] = tr_read<v_rd_off(D0, 1, 0)>(vb); r[3] = tr_read<v_rd_off(D0, 1, 1)>(vb);
    r[4] = tr_read<v_rd_off(D0, 2, 0)>(vb); r[5] = tr_read<v_rd_off(D0, 2, 1)>(vb); r[6] = tr_read<v_rd_off(D0, 3, 0)>(vb); r[7] = tr_read<v_rd_off(D0, 3, 1)>(vb);
}
__device__ __forceinline__ void mfma4(f32x16& od, const s16x4 (&r)[8], bf16x8 pa0, bf16x8 pa1, bf16x8 pa2, bf16x8 pa3) {
#define PK(L, H) (bf16x8){L[0], L[1], L[2], L[3], H[0], H[1], H[2], H[3]}
    od = __builtin_amdgcn_mfma_f32_32x32x16_bf16(pa0, PK(r[0], r[1]), od, 0, 0, 0); od = __builtin_amdgcn_mfma_f32_32x32x16_bf16(pa1, PK(r[2], r[3]), od, 0, 0, 0);
    od = __builtin_amdgcn_mfma_f32_32x32x16_bf16(pa2, PK(r[4], r[5]), od, 0, 0, 0); od = __builtin_amdgcn_mfma_f32_32x32x16_bf16(pa3, PK(r[6], r[7]), od, 0, 0, 0);
#undef PK
}
#define EXPCH(P, B) do { _Pragma("unroll") for (int r_ = 0; r_ < 8; ++r_) P[(B) + r_] = __builtin_amdgcn_exp2f(P[(B) + r_]); \
    l_reg += ((P[(B)] + P[(B) + 1]) + (P[(B) + 2] + P[(B) + 3])) + ((P[(B) + 4] + P[(B) + 5]) + (P[(B) + 6] + P[(B) + 7])); } while (0)
#define PK4(P, BASE, OUT) do { unsigned a0 = cvt_pk_bf16(P[BASE + 0], P[BASE + 1]), a1 = cvt_pk_bf16(P[BASE + 2], P[BASE + 3]);   \
    unsigned b0 = cvt_pk_bf16(P[BASE + 4], P[BASE + 5]), b1 = cvt_pk_bf16(P[BASE + 6], P[BASE + 7]);                              \
    auto r0 = __builtin_amdgcn_permlane32_swap(a0, b0, false, false); auto r1 = __builtin_amdgcn_permlane32_swap(a1, b1, false, false); \
    u32x4 w = {r0[0], r1[0], r0[1], r1[1]}; OUT = *reinterpret_cast<bf16x8*>(&w); } while (0)
__device__ __forceinline__ void attn_pass(f32x16* o, float& l_reg, const bf16_t* Qb, const bf16_t* Kb, const bf16_t* Vb, int b, int qrow0, int qcol, int vcol, int t0, int NT, char* lds, const int tid) {
    const int wid = tid >> 6, lane = tid & 63, r32 = lane & 31, hi = lane >> 5;
    char* V_lds = lds; char* K_lds = lds + OFF_K;
    bf16x8 qr[4];
    const bf16_t* Qw = Qb + (size_t)(qrow0 + wid * 32 + r32) * 512 + qcol + hi * 8;
#pragma unroll
    for (int d0 = 0; d0 < 4; ++d0) qr[d0] = *reinterpret_cast<const bf16x8*>(Qw + d0 * 16);
    const int kr = tid >> 3, kc = (tid & 7) * 8;
    const int sr = tid >> 4, sc = (tid & 15) * 8, vst0 = v_st(sr, sc), vst1 = v_st(32 + sr, sc);
    const int vb0 = (int)(uintptr_t)V_lds + v_rd_base(lane);
    const int kst = KSWZ(kr, kc * 2);
    bf16x8 s_v0, s_v1, s_k;
#define TROW(t) ((t) < 64 ? (size_t)b * 4096 + (size_t)(t) * 64 : (size_t)ML + (size_t)b * 256 + (size_t)((t) - 64) * 64)
    const unsigned voff_ = (unsigned)(sr * 512 + vcol + sc) * 2u, koff_ = (unsigned)(kr * 512 + qcol + kc) * 2u;
#define SLOAD(t) do { const size_t r0_ = TROW(t) * 1024; const char* vt_ = (const char*)Vb + r0_; const char* kt_ = (const char*)Kb + r0_; \
    s_v0 = *reinterpret_cast<const bf16x8*>(vt_ + voff_); s_v1 = *reinterpret_cast<const bf16x8*>(vt_ + 32768 + voff_); s_k = *reinterpret_cast<const bf16x8*>(kt_ + koff_); } while (0)
#define SWRITE(jt) do { *(bf16x8*)(V_lds + ((jt) & 3) * SHM_V + vst0) = s_v0; *(bf16x8*)(V_lds + ((jt) & 3) * SHM_V + vst1) = s_v1; *(bf16x8*)(K_lds + ((jt) & 1) * SHM_K + kst) = s_k; } while (0)
    SLOAD(t0); SWRITE(0); SLOAD(t0 + 1); SWRITE(1); if (2 < NT) SLOAD(t0 + 2);
    __syncthreads();
    f32x16 p0, p1; bf16x8 pa0, pa1, pa2, pa3, pb0, pb1, pb2, pb3;
    qkt(p0, p1, K_lds, qr, r32, hi);
    __syncthreads();
    EXPCH(p0, 0); EXPCH(p0, 8); EXPCH(p1, 0); EXPCH(p1, 8); PK4(p0, 0, pa0); PK4(p0, 8, pa1); PK4(p1, 0, pa2); PK4(p1, 8, pa3);
    if (2 < NT) { SWRITE(2); if (3 < NT) SLOAD(t0 + 3); }
    SBAR(); { int ko_ = SHM_K; asm volatile("" : "+s"(ko_)); qkt(p0, p1, K_lds + ko_, qr, r32, hi); } SBAR();
    __syncthreads();
#define ATT_ITER(j, A0, A1, A2, A3, N0, N1, N2, N3) do { \
        SBAR(); \
        {   int vo_ = (((j) - 1) & 3) * SHM_V; asm volatile("" : "+s"(vo_)); const int vb_ = vb0 + vo_; s16x4 ra[8]; \
            tr8<0>(vb_, ra); \
            asm volatile("s_waitcnt lgkmcnt(0)" ::: "memory"); SBAR(); mfma4(o[0], ra, A0, A1, A2, A3); tr8<1>(vb_, ra); EXPCH(p0, 0); PK4(p0, 0, N0); \
            asm volatile("s_waitcnt lgkmcnt(0)" ::: "memory"); SBAR(); mfma4(o[1], ra, A0, A1, A2, A3); tr8<2>(vb_, ra); EXPCH(p0, 8); PK4(p0, 8, N1); \
            asm volatile("s_waitcnt lgkmcnt(0)" ::: "memory"); SBAR(); mfma4(o[2], ra, A0, A1, A2, A3); tr8<3>(vb_, ra); EXPCH(p1, 0); PK4(p1, 0, N2); \
            asm volatile("s_waitcnt lgkmcnt(0)" ::: "memory"); SBAR(); mfma4(o[3], ra, A0, A1, A2, A3); EXPCH(p1, 8); PK4(p1, 8, N3); SBAR(); } \
        if ((j) + 2 < NT) { SWRITE((j) + 2); if ((j) + 3 < NT) SLOAD(t0 + (j) + 3); } \
        SBAR(); \
        if ((j) + 1 < NT) { int ko_ = (((j) + 1) & 1) * SHM_K; asm volatile("" : "+s"(ko_)); qkt(p0, p1, K_lds + ko_, qr, r32, hi); } \
        SBAR(); \
        __syncthreads(); } while (0)
#pragma nounroll
    for (int j = 1; j < NT; j += 2) { ATT_ITER(j, pa0, pa1, pa2, pa3, pb0, pb1, pb2, pb3); if (j + 1 < NT) ATT_ITER(j + 1, pb0, pb1, pb2, pb3, pa0, pa1, pa2, pa3); }
#undef ATT_ITER
    pv_d0(o, vb0 + ((NT - 1) & 3) * SHM_V, pb0, pb1, pb2, pb3);
    __syncthreads();
#undef TROW
#undef SLOAD
#undef SWRITE
}
#undef EXPCH
#undef PK4
__device__ __forceinline__ void attn_unit(ArgP a, int l, int unit, char* lds, const int tid, const int bid) {
    const int wid = tid >> 6, lane = tid & 63, r32 = lane & 31, hi = lane >> 5;
    const bf16_t* Kb = (const bf16_t*)(a->ws + WS_KB); const bf16_t* Qb = (const bf16_t*)(a->ws + WS_QB); const bf16_t* Vb = (const bf16_t*)(a->ws + WS_VB);
    const bf16_t* Z = (const bf16_t*)(a->ws + WS_Z); bf16_t* Y = (bf16_t*)(a->ws + WS_RW);
    float* scr = (float*)(a->ws + WS_H) + (size_t)bid * 32768 + wid * 4096;
    const float* SCAL = (const float*)(a->ws + WS_SCAL) + l * 8;
    const float lam = SCAL[0], oml = SCAL[2];
    int b, h, qrow0, t0, NT;
    if (unit < 256) { b = unit >> 6; h = (unit >> 4) & 3; qrow0 = b * 4096 + (unit & 15) * 256; t0 = 0; NT = 68; }
    else { const int cu = unit - 256; b = cu >> 2; h = cu & 3; qrow0 = ML + b * 256; t0 = 64; NT = 4; }
    float* li_l = (float*)(lds + att::OFF_WS) + wid * 64;
    const float* sg = a->in[15] + l * 128;
#pragma nounroll
    for (int j = 0; j < 2; ++j) {
        f32x16 o[4] = {}; float l_reg = 0.f;
        { int tp = tid; asm volatile("" : "+v"(tp));
          attn_pass(o, l_reg, Qb, Kb, Vb, b, qrow0, h * 128 + j * 64, h * 128, t0, NT, lds, tp); }
        { auto rr = __builtin_amdgcn_permlane32_swap(__float_as_uint(l_reg), __float_as_uint(l_reg), false, false); l_reg = __uint_as_float(rr[0]) + __uint_as_float(rr[1]); }
        GAS float* scr_ = (GAS float*)scr; const GAS bf16_t* Z_ = (const GAS bf16_t*)Z; GAS bf16_t* Y_ = (GAS bf16_t*)Y; asm volatile("" : "+v"(scr_), "+v"(Z_), "+v"(Y_));
        if (hi == 0) li_l[r32] = l_reg; asm volatile("s_waitcnt lgkmcnt(0)" ::: "memory");
        float rli[16];
#pragma unroll
        for (int r = 0; r < 16; ++r) rli[r] = __builtin_amdgcn_rcpf(li_l[crow(r, hi)]);
        if (j == 0) {
#pragma unroll
            for (int d0 = 0; d0 < 4; ++d0) {
#pragma unroll
                for (int r = 0; r < 16; ++r) scr_[(d0 * 16 + r) * 64 + lane] = o[d0][r] * rli[r];
                asm volatile("" ::: "memory"); }
        } else {
            float ss[16];
#pragma unroll
            for (int r = 0; r < 16; ++r) { ss[r] = 0.f; rli[r] *= lam; }
#pragma unroll
            for (int d0 = 0; d0 < 4; ++d0) {
#pragma unroll
                for (int r = 0; r < 16; ++r) { const float v = scr_[(d0 * 16 + r) * 64 + lane] - o[d0][r] * rli[r]; o[d0][r] = v; ss[r] += v * v; }
                asm volatile("" ::: "memory"); }
#pragma unroll
            for (int r = 0; r < 16; ++r) { float s = ss[r]; s += __shfl_xor(s, 1); s += __shfl_xor(s, 2); s += __shfl_xor(s, 4); s += __shfl_xor(s, 8); s += __shfl_xor(s, 16);
                ss[r] = oml / sqrtf(s * (1.0f / 128.0f) + NORM_EPS); }
#pragma unroll
            for (int d0 = 0; d0 < 4; ++d0) { const int col = h * 128 + d0 * 32 + r32; const float g = sg[d0 * 32 + r32];
                const size_t rb = (size_t)(qrow0 + wid * 32 + 4 * hi) * 1536 + 512 + col;
                unsigned short zq[16];
#pragma unroll
                for (int r = 0; r < 16; ++r) zq[r] = Z_[rb + (size_t)((r & 3) + 8 * (r >> 2)) * 1536];
#pragma unroll
                for (int r = 0; r < 16; ++r) { const size_t idx = rb + (size_t)((r & 3) + 8 * (r >> 2)) * 1536;
                    const float y = o[d0][r] * ss[r] * g * bf2f(zq[r]);
                    Y_[idx] = (bf16_t)(cvt_pk_bf16(y, 0.f) & 0xffffu); }
                asm volatile("" ::: "memory"); }
        }
        asm volatile("s_waitcnt vmcnt(0) lgkmcnt(0)" ::: "memory");
    }
}
}

__device__ __forceinline__ void gmlp_unit(ArgP a, int l, int unit, char* lds, const int tid) {
    const int wid = tid >> 6, lane = tid & 63, r32 = lane & 31, hi = lane >> 5;
    const int chunk = unit >> 2, g = unit & 3; const size_t row0 = (size_t)chunk * 128;
    const bf16_t* VA = (const bf16_t*)(a->ws + WS_VA); const bf16_t* GU = (const bf16_t*)(a->ws + WS_GU); const bf16_t* Z = (const bf16_t*)(a->ws + WS_Z); bf16_t* Y = (bf16_t*)(a->ws + WS_RW);
    const float* Ws = a->in[10] + ((size_t)l * 4 + g) * 128 * 128; const float* bs = a->in[11] + (l * 4 + g) * 128;
    const int sr = tid >> 4, sc = (tid & 15) * 8;
#pragma unroll
    for (int t = 0; t < 2; ++t) {
        const bf16x8 v0 = *reinterpret_cast<const bf16x8*>(VA + (row0 + t * 64 + sr) * 512 + g * 128 + sc);
        const bf16x8 v1 = *reinterpret_cast<const bf16x8*>(VA + (row0 + t * 64 + 32 + sr) * 512 + g * 128 + sc);
        *(bf16x8*)(lds + t * 16384 + v_st(sr, sc)) = v0; *(bf16x8*)(lds + t * 16384 + v_st(32 + sr, sc)) = v1; }
    __syncthreads();
    const int pb = (wid & 3) * 32, ch = wid >> 2;
    const int vb0 = (int)(uintptr_t)lds + v_rd_base(lane);
    f32x16 o0 = {}, o1 = {};
#pragma unroll
    for (int t = 0; t < 2; ++t) {
        bf16x8 pa[4];
#pragma unroll
        for (int ks = 0; ks < 4; ++ks) { const float* wp = Ws + (size_t)(pb + r32) * 128 + t * 64 + ks * 16 + hi * 8;
            const f32x4 w0 = *(const f32x4*)wp, w1 = *(const f32x4*)(wp + 4);
            u32x4 w = {cvt_pk_bf16(w0.x, w0.y), cvt_pk_bf16(w0.z, w0.w), cvt_pk_bf16(w1.x, w1.y), cvt_pk_bf16(w1.z, w1.w)}; pa[ks] = *reinterpret_cast<bf16x8*>(&w); }
        if (ch == 0) { pv_one<0>(o0, vb0 + t * 16384, pa[0], pa[1], pa[2], pa[3]); pv_one<1>(o1, vb0 + t * 16384, pa[0], pa[1], pa[2], pa[3]); }
        else         { pv_one<2>(o0, vb0 + t * 16384, pa[0], pa[1], pa[2], pa[3]); pv_one<3>(o1, vb0 + t * 16384, pa[0], pa[1], pa[2], pa[3]); }
    }
    {   unsigned short gq[32], zq[32]; float bq[16];
#pragma unroll
        for (int r = 0; r < 16; ++r) { const int p = pb + crow(r, hi); bq[r] = bs[p]; const size_t row = row0 + p;
#pragma unroll
            for (int d = 0; d < 2; ++d) { const int col = g * 128 + ch * 64 + d * 32 + r32; gq[2 * r + d] = GU[row * 512 + col]; zq[2 * r + d] = Z[row * 1536 + col]; } }
#pragma unroll
        for (int r = 0; r < 16; ++r) { const int p = pb + crow(r, hi); const size_t row = row0 + p;
#pragma unroll
            for (int d = 0; d < 2; ++d) { const int col = g * 128 + ch * 64 + d * 32 + r32;
                const float s = (d == 0 ? o0[r] : o1[r]) + bq[r];
                const float y = bf2f(gq[2 * r + d]) * s * bf2f(zq[2 * r + d]);
                Y[row * 1536 + col] = (bf16_t)(cvt_pk_bf16(y, 0.f) & 0xffffu); } } }
    __syncthreads();
}

template <int CTRL> __device__ __forceinline__ float dppf(float v) { return __builtin_bit_cast(float, __builtin_amdgcn_update_dpp(0, __builtin_bit_cast(int, v), CTRL, 0xF, 0xF, true)); }
__device__ __forceinline__ float allreduce16(float x) { x += dppf<0xB1>(x); x += dppf<0x4E>(x); x += dppf<0x141>(x); x += dppf<0x140>(x); return x; }
namespace scanc {
constexpr int CS = 16, NBLK = (256 + 4096) / CS;
constexpr int RS = 144;
constexpr int O_AK = 0, O_KHB = 32 * RS, O_V = 64 * RS, O_T = 80 * RS, O_X = O_T + 1024, O_BK = O_X + 1024, O_NBB = O_BK + 1024, O_GC = O_NBB + 1024, O_F = O_GC + 256, SLOT = O_F + 2048, NSLOT = 6;
constexpr int O_CTL = NSLOT * SLOT;
__device__ __forceinline__ int perm16(int m) { return 8 * ((m >> 2) & 1) + 4 * (m >> 3) + (m & 3); }
__device__ __forceinline__ bf16x8 pack_tile8(const f32x16& x, int base) {
    u32x4 w = {cvt_pk_bf16(x[base + 0], x[base + 1]), cvt_pk_bf16(x[base + 2], x[base + 3]), cvt_pk_bf16(x[base + 4], x[base + 5]), cvt_pk_bf16(x[base + 6], x[base + 7])};
    return __builtin_bit_cast(bf16x8, w);
}
__device__ __forceinline__ unsigned short f2bf_s(float f) { return (unsigned short)(cvt_pk_bf16(f, 0.f) & 0xffffu); }
constexpr int O_ID = O_CTL + 1024;
__device__ __forceinline__ void scan_unit(ArgP a, int l, int chain, LAS char* lds, const int tid) {
    const int wid = __builtin_amdgcn_readfirstlane(tid >> 6), lane = tid & 63, r32 = lane & 31, hi = lane >> 5;
    const int d = chain >> 5, b = (chain >> 3) & 3, h = chain & 7;
    const bf16_t* RWP = (const bf16_t*)(a->ws + WS_RWP); const bf16_t* WA = (const bf16_t*)(a->ws + WS_WA); bf16_t* YD = (bf16_t*)(a->ws + WS_YD) + (size_t)d * MT * 512;
    volatile LAS unsigned* ctl = (volatile LAS unsigned*)(lds + O_CTL);
    if (tid < 8) ctl[tid] = 0u;
    *(LAS float*)(lds + O_ID + (tid >> 5) * 128 + (tid & 31) * 4) = (tid >> 5) == (tid & 31) ? 1.0f : 0.f;
    __syncthreads();
#define ROWOF(s) ((s) < 256 ? (size_t)ML + (size_t)b * 256 + (size_t)(d ? 255 - (s) : (s)) : (size_t)b * 4096 + (size_t)(d ? 4095 - ((s) - 256) : (s) - 256))
    if (wid >= 2) {
        const int sw = wid - 2; LAS char* sl = lds + sw * SLOT;
        const int st = lane & 15, cq = lane >> 4, ps = perm16(st);
        const float* kap = a->in[22] + l * 512 + h * 64 + cq * 16;
        const f32x4 ka0 = *(const f32x4*)kap, ka1 = *(const f32x4*)(kap + 4), ka2 = *(const f32x4*)(kap + 8), ka3 = *(const f32x4*)(kap + 12);
        const int hig = lane >> 5, jj = (r32 & 15) - 4 * hig;
        const int goff = O_F + hig * 512 + r32 * 4;
        const int boff = (r32 < 16 ? O_BK + (r32 & 15) * 2 : O_NBB + perm16(r32 & 15) * 2) + hig * 128;
        const int sc_ = lane & 15; const bool isT = lane < 16;
        const int ooff = isT ? O_T + perm16(sc_) * 2 : O_X + sc_ * 2;
        u32x4 W[12];
#define LOADRAW(bb_) do { const size_t rw = ROWOF((bb_) * CS + st); const bf16_t* p = RWP + rw * 2048 + h * 64 + cq * 16; const bf16_t* q = WA + rw * 2048 + d * 512 + h * 64 + cq * 16; \
            W[0] = *(const u32x4*)p; W[1] = *(const u32x4*)(p + 8); W[2] = *(const u32x4*)(p + 512); W[3] = *(const u32x4*)(p + 520); W[4] = *(const u32x4*)(p + 1024); W[5] = *(const u32x4*)(p + 1032); \
            W[6] = *(const u32x4*)(p + 1536); W[7] = *(const u32x4*)(p + 1544); W[8] = *(const u32x4*)q; W[9] = *(const u32x4*)(q + 8); W[10] = *(const u32x4*)(q + 1024); W[11] = *(const u32x4*)(q + 1032); } while (0)
        LOADRAW(sw);
        for (int bi = sw; bi < NBLK; bi += NSLOT) {
            if (bi >= NSLOT) { const unsigned need = (unsigned)(bi - NSLOT + 1); while (ctl[6] < need || ctl[7] < need) __builtin_amdgcn_s_sleep(1); }
            asm volatile("" ::: "memory");
            {
                *(LAS u32x4*)(sl + O_V + st * RS + cq * 32) = W[4]; *(LAS u32x4*)(sl + O_V + st * RS + cq * 32 + 16) = W[5];
                float kk[16], kx[16], rr[16], om[16], aa[16];
                unpack8(W[0], *(float(*)[8])&kk[0]); unpack8(W[1], *(float(*)[8])&kk[8]); unpack8(W[2], *(float(*)[8])&kx[0]); unpack8(W[3], *(float(*)[8])&kx[8]);
                unpack8(W[6], *(float(*)[8])&rr[0]); unpack8(W[7], *(float(*)[8])&rr[8]);
                unpack8(W[8], *(float(*)[8])&om[0]); unpack8(W[9], *(float(*)[8])&om[8]); unpack8(W[10], *(float(*)[8])&aa[0]); unpack8(W[11], *(float(*)[8])&aa[8]);
                if (bi + NSLOT < NBLK) LOADRAW(bi + NSLOT);
                unsigned ktp[8], rtp[8], khp[8], bhp[8]; float G[16];
#pragma unroll
                for (int m = 0; m < 8; ++m) { float v4[8];
#pragma unroll
                    for (int e = 0; e < 2; ++e) { const int c = 2 * m + e; float g = 1.0f - om[c];
                        g *= __builtin_bit_cast(float, __builtin_amdgcn_update_dpp(0x3f800000, __builtin_bit_cast(int, g), 0x111, 0xF, 0xF, false));
                        g *= __builtin_bit_cast(float, __builtin_amdgcn_update_dpp(0x3f800000, __builtin_bit_cast(int, g), 0x112, 0xF, 0xF, false));
                        g *= __builtin_bit_cast(float, __builtin_amdgcn_update_dpp(0x3f800000, __builtin_bit_cast(int, g), 0x114, 0xF, 0xF, false));
                        g *= __builtin_bit_cast(float, __builtin_amdgcn_update_dpp(0x3f800000, __builtin_bit_cast(int, g), 0x118, 0xF, 0xF, false));
                        const float gp = __builtin_bit_cast(float, __builtin_amdgcn_update_dpp(0x3f800000, __builtin_bit_cast(int, g), 0x111, 0xF, 0xF, false));
                        const float ig = __builtin_amdgcn_rcpf(g);
                        const float kac = c < 4 ? ka0[c & 3] : c < 8 ? ka1[c & 3] : c < 12 ? ka2[c & 3] : ka3[c & 3];
                        const float kd = kx[c] * (1.0f + (aa[c] - 1.0f) * kac), be = kk[c] * aa[c];
                        G[c] = g; v4[e] = kk[c] * gp; v4[2 + e] = rr[c] * g; v4[4 + e] = kd * ig; v4[6 + e] = be * ig; }
                    ktp[m] = cvt_pk_bf16(v4[0], v4[1]); rtp[m] = cvt_pk_bf16(v4[2], v4[3]); khp[m] = cvt_pk_bf16(v4[4], v4[5]); bhp[m] = cvt_pk_bf16(v4[6], v4[7]); }
                *(LAS u32x4*)(sl + O_AK + st * RS + cq * 32) = (u32x4){ktp[0], ktp[1], ktp[4], ktp[5]}; *(LAS u32x4*)(sl + O_AK + st * RS + cq * 32 + 16) = (u32x4){ktp[2], ktp[3], ktp[6], ktp[7]};
                *(LAS u32x4*)(sl + O_AK + (16 + st) * RS + cq * 32) = (u32x4){rtp[0], rtp[1], rtp[4], rtp[5]}; *(LAS u32x4*)(sl + O_AK + (16 + st) * RS + cq * 32 + 16) = (u32x4){rtp[2], rtp[3], rtp[6], rtp[7]};
                *(LAS u32x4*)(sl + O_KHB + st * RS + cq * 32) = (u32x4){khp[0], khp[1], khp[2], khp[3]}; *(LAS u32x4*)(sl + O_KHB + st * RS + cq * 32 + 16) = (u32x4){khp[4], khp[5], khp[6], khp[7]};
                *(LAS u32x4*)(sl + O_KHB + (16 + st) * RS + cq * 32) = (u32x4){bhp[0] ^ 0x80008000u, bhp[1] ^ 0x80008000u, bhp[2] ^ 0x80008000u, bhp[3] ^ 0x80008000u};
                *(LAS u32x4*)(sl + O_KHB + (16 + st) * RS + cq * 32 + 16) = (u32x4){bhp[4] ^ 0x80008000u, bhp[5] ^ 0x80008000u, bhp[6] ^ 0x80008000u, bhp[7] ^ 0x80008000u};
                if (st == 15) {
                    *(LAS f32x4*)(sl + O_GC + cq * 64) = (f32x4){G[0], G[1], G[2], G[3]}; *(LAS f32x4*)(sl + O_GC + cq * 64 + 16) = (f32x4){G[4], G[5], G[6], G[7]};
                    *(LAS f32x4*)(sl + O_GC + cq * 64 + 32) = (f32x4){G[8], G[9], G[10], G[11]}; *(LAS f32x4*)(sl + O_GC + cq * 64 + 48) = (f32x4){G[12], G[13], G[14], G[15]}; }
            }
            asm volatile("s_waitcnt lgkmcnt(0)" ::: "memory");
            f32x16 gr = {};
            {   const LAS char* ga = sl + O_AK + r32 * RS + hig * 16; const LAS char* gb = sl + O_KHB + r32 * RS + hig * 8;
                bf16x8 fa[4]; u32x2 fl[4], fh[4];
#pragma unroll
                for (int q = 0; q < 4; ++q) { fa[q] = *(const LAS bf16x8*)(ga + q * 32); fl[q] = *(const LAS u32x2*)(gb + q * 32); fh[q] = *(const LAS u32x2*)(gb + q * 32 + 16); }
#pragma unroll
                for (int q = 0; q < 4; ++q) { const u32x4 fb = {fl[q][0], fl[q][1], fh[q][0], fh[q][1]};
                    gr = __builtin_amdgcn_mfma_f32_32x32x16_bf16(fa[q], __builtin_bit_cast(bf16x8, fb), gr, 0, 0, 0); } }
#pragma unroll
            for (int r = 0; r < 16; ++r) { const int cr = (r & 3) + 8 * (r >> 2);
                const bool keep = r < 8 ? (jj < cr) : (jj <= cr - 16); const float g = keep ? gr[r] : 0.f;
                if (r < 8) *(LAS float*)(sl + goff + cr * 128) = g;
                else *(LAS unsigned short*)(sl + boff + (cr - 16) * 32) = f2bf_s(g); }
            asm volatile("s_waitcnt lgkmcnt(0)" ::: "memory");
            if (lane < 32) { const LAS char* rhs = isT ? lds + O_ID + sc_ * 4 : sl + O_F + sc_ * 4; float t[CS];
#pragma unroll
                for (int i = 0; i < CS; ++i) t[i] = *(const LAS float*)(rhs + i * 128);
#pragma unroll
                for (int i = 1; i < CS; ++i) { const LAS float* ab = (const LAS float*)(sl + O_F + i * 128 + 64);
                    f32x2 acc2 = {t[i], 0.f};
#pragma unroll
                    for (int j = 0; j + 1 < i; j += 2) acc2 += (f32x2){ab[j], ab[j + 1]} * (f32x2){t[j], t[j + 1]};
                    float acc = acc2[0] + acc2[1];
                    if (i & 1) acc += ab[i - 1] * t[i - 1];
                    t[i] = acc; }
#pragma unroll
                for (int i = 0; i < CS; ++i) *(LAS unsigned short*)(sl + ooff + i * 32) = f2bf_s(t[i]); }
            asm volatile("s_waitcnt lgkmcnt(0)" ::: "memory");
            if (lane == 0) ctl[sw] = (unsigned)(bi + 1);
        }
    } else {
        f32x16 Z0 = {}, Z1 = {};
        const int rho = wid * 32 + r32;
        const int trb = (int)(uintptr_t)lds + ((lane >> 2) & 3) * RS + (16 * ((lane >> 4) & 1) + 4 * (lane & 3)) * 2;
        const int trk = trb + 8 * hi * RS, trn = trb + 4 * hi * RS;
        const unsigned yoff = (unsigned)(((d ? 15 - 4 * hi : 4 * hi) * 512 + h * 64 + rho) * 2);
        for (int bi = 0; bi < NBLK; ++bi) {
            const int sw = bi % NSLOT; const LAS char* sl = lds + sw * SLOT;
            while (ctl[sw] != (unsigned)(bi + 1)) __builtin_amdgcn_s_sleep(1);
            asm volatile("" ::: "memory");
            const LAS char* ra = sl + r32 * RS + hi * 16; const LAS char* rb = sl + r32 * 32 + hi * 16;
            const bf16x8 ak0 = *(const LAS bf16x8*)(ra + O_AK), ak1 = *(const LAS bf16x8*)(ra + O_AK + 32), ak2 = *(const LAS bf16x8*)(ra + O_AK + 64), ak3 = *(const LAS bf16x8*)(ra + O_AK + 96);
            const bf16x8 tq = *(const LAS bf16x8*)(rb + O_T), xq = *(const LAS bf16x8*)(rb + O_X), bkq = *(const LAS bf16x8*)(rb + O_BK), nbbq = *(const LAS bf16x8*)(rb + O_NBB);
            const int tk = trk + sw * SLOT, tn = trn + sw * SLOT;
            const s16x4 kb0l = tr_read<O_KHB>(tk), kb0h = tr_read<O_KHB + 4 * RS>(tk), kb1l = tr_read<O_KHB + 64>(tk), kb1h = tr_read<O_KHB + 4 * RS + 64>(tk);
            const s16x4 nb0l = tr_read<O_KHB + 16 * RS>(tn), nb0h = tr_read<O_KHB + 24 * RS>(tn), nb1l = tr_read<O_KHB + 16 * RS + 64>(tn), nb1h = tr_read<O_KHB + 24 * RS + 64>(tn);
            const s16x4 vfl = tr_read<O_V>(tk + wid * 64), vfh = tr_read<O_V + 4 * RS>(tk + wid * 64);
            f32x4 gc0[4], gc1[4];
            {   const LAS float* gc = (const LAS float*)(sl + O_GC) + 4 * hi;
#pragma unroll
                for (int g4 = 0; g4 < 4; ++g4) { gc0[g4] = *(const LAS f32x4*)(gc + 8 * g4); gc1[g4] = *(const LAS f32x4*)(gc + 32 + 8 * g4); } }
            asm volatile("s_waitcnt lgkmcnt(0)" ::: "memory"); SBAR();
#define PK(L, H) (bf16x8){L[0], L[1], L[2], L[3], H[0], H[1], H[2], H[3]}
            const bf16x8 kb0 = PK(kb0l, kb0h), kb1 = PK(kb1l, kb1h), nb0 = PK(nb0l, nb0h), nb1 = PK(nb1l, nb1h), vf = PK(vfl, vfh);
#undef PK
            f32x16 a1 = {};
            a1 = __builtin_amdgcn_mfma_f32_32x32x16_bf16(ak0, pack_tile8(Z0, 0), a1, 0, 0, 0);
            a1 = __builtin_amdgcn_mfma_f32_32x32x16_bf16(ak1, pack_tile8(Z0, 8), a1, 0, 0, 0);
            a1 = __builtin_amdgcn_mfma_f32_32x32x16_bf16(ak2, pack_tile8(Z1, 0), a1, 0, 0, 0);
            a1 = __builtin_amdgcn_mfma_f32_32x32x16_bf16(ak3, pack_tile8(Z1, 8), a1, 0, 0, 0);
            f32x16 a2 = {};
            a2 = __builtin_amdgcn_mfma_f32_32x32x16_bf16(xq, vf, a2, 0, 0, 0);
            a2 = __builtin_amdgcn_mfma_f32_32x32x16_bf16(tq, pack_tile8(a1, 0), a2, 0, 0, 0);
            f32x16 a3 = {};
            a3 = __builtin_amdgcn_mfma_f32_32x32x16_bf16(bkq, vf, a3, 0, 0, 0);
            Z0 = __builtin_amdgcn_mfma_f32_32x32x16_bf16(kb0, vf, Z0, 0, 0, 0);
            Z1 = __builtin_amdgcn_mfma_f32_32x32x16_bf16(kb1, vf, Z1, 0, 0, 0);
            const bf16x8 sf = pack_tile8(a2, 0);
            Z0 = __builtin_amdgcn_mfma_f32_32x32x16_bf16(nb0, sf, Z0, 0, 0, 0);
            Z1 = __builtin_amdgcn_mfma_f32_32x32x16_bf16(nb1, sf, Z1, 0, 0, 0);
            a3 = __builtin_amdgcn_mfma_f32_32x32x16_bf16(nbbq, sf, a3, 0, 0, 0);
            if (lane == 0) ctl[6 + wid] = (unsigned)(bi + 1);
#pragma unroll
            for (int g4 = 0; g4 < 4; ++g4) {
#pragma unroll
                for (int e = 0; e < 4; ++e) { Z0[4 * g4 + e] *= gc0[g4][e]; Z1[4 * g4 + e] *= gc1[g4][e]; } }
            {   const int s0 = bi * CS; const int rlo = s0 < 256 ? ML + b * 256 + (d ? 240 - s0 : s0) : b * 4096 + (d ? 4080 - (s0 - 256) : s0 - 256);
                const char* yb = (const char*)YD + (size_t)rlo * 1024;
#pragma unroll
                for (int r = 0; r < 8; ++r) { const int cr = (r & 3) + 8 * (r >> 2);
                    *(unsigned short*)(yb + (d ? -cr : cr) * 1024 + yoff) = f2bf_s(a3[r] + a1[8 + r]); } }
        }
    }
#undef ROWOF
#undef LOADRAW
    __syncthreads();
}
}

__device__ __forceinline__ void phase_readout(ArgP a, int l, int wave, int lane, int bid, int G) {
    const int gw = bid * 8 + wave, NGW = G * 8;
    const bf16_t* YD = (const bf16_t*)(a->ws + WS_YD); const bf16_t* RWP = (const bf16_t*)(a->ws + WS_RWP); const bf16_t* Z = (const bf16_t*)(a->ws + WS_Z); bf16_t* Y = (bf16_t*)(a->ws + WS_RW);
    const float* lng = a->in[24] + l * 512 + lane * 8; const float* lnb = a->in[25] + l * 512 + lane * 8; const float* rk = a->in[23] + l * 512 + lane * 8;
    for (int m = gw; m < (l == NL - 1 ? ML : MT); m += NGW) {
        float y0[8], y1[8], k[8], v[8], r[8], zc[8];
        unpack8(*(const u32x4*)(YD + (size_t)m * 512 + lane * 8), y0); unpack8(*(const u32x4*)(YD + ((size_t)MT + m) * 512 + lane * 8), y1);
        const bf16_t* rp = RWP + (size_t)m * 2048 + lane * 8;
        unpack8(*(const u32x4*)(rp + 512), k); unpack8(*(const u32x4*)(rp + 1024), v); unpack8(*(const u32x4*)(rp + 1536), r);
        unpack8(*(const u32x4*)(Z + (size_t)m * 1536 + 1024 + lane * 8), zc);
        float s = 0.f, rks = 0.f; const f32x4 rka = *(const f32x4*)rk, rkb = *(const f32x4*)(rk + 4);
#pragma unroll
        for (int e = 0; e < 8; ++e) { y0[e] += y1[e]; s += y0[e]; rks += r[e] * k[e] * ((e < 4) ? rka[e & 3] : rkb[e & 3]); }
        s += __shfl_xor(s, 1); s += __shfl_xor(s, 2); s += __shfl_xor(s, 4);
        rks += __shfl_xor(rks, 1); rks += __shfl_xor(rks, 2); rks += __shfl_xor(rks, 4);
        const float mu = s * (1.0f / 64.0f); float q = 0.f;
#pragma unroll
        for (int e = 0; e < 8; ++e) { y0[e] -= mu; q += y0[e] * y0[e]; }
        q += __shfl_xor(q, 1); q += __shfl_xor(q, 2); q += __shfl_xor(q, 4);
        const float rstd = 1.0f / sqrtf(q * (1.0f / 64.0f) + GN_EPS);
        float o[8]; const f32x4 g0 = *(const f32x4*)lng, g1 = *(const f32x4*)(lng + 4), b0 = *(const f32x4*)lnb, b1 = *(const f32x4*)(lnb + 4);
#pragma unroll
        for (int e = 0; e < 4; ++e) { o[e] = (y0[e] * rstd * g0[e] + b0[e] + rks * v[e]) * zc[e]; o[4 + e] = (y0[4 + e] * rstd * g1[e] + b1[e] + rks * v[4 + e]) * zc[4 + e]; }
        *(u32x4*)(Y + (size_t)m * 1536 + 1024 + lane * 8) = pack8(o);
    }
}


#define XB_TMO      128
#define XB_XCNT(j)  (256  + 64 * (j))
#define XB_XSUB(j)  (1280 + 64 * (j))
#define XB_XGEN(j)  (2304 + 64 * (j))
#define XB_TOP      3328
#define XB_TOPGEN   3392
#define XCD_BAR_WORDS 3456
#define XB_SPIN_CAP (1u << 22)
__device__ __forceinline__ unsigned xb_ld(unsigned* p)              { return __hip_atomic_load(p, __ATOMIC_RELAXED, __HIP_MEMORY_SCOPE_AGENT); }
__device__ __forceinline__ unsigned xb_add(unsigned* p, unsigned v) { return __hip_atomic_fetch_add(p, v, __ATOMIC_RELAXED, __HIP_MEMORY_SCOPE_AGENT); }
__device__ __forceinline__ unsigned xb_xcc_id() { return (unsigned)__builtin_amdgcn_s_getreg((3 << 11) | 20) & 0xFu; }
#define XB_SPIN(cond, bar) do { unsigned _sp = 0; while (cond) { __builtin_amdgcn_s_sleep(1); \
    if ((++_sp & 255u) == 0u) { if (xb_ld(&(bar)[XB_TMO])) break; if (_sp > XB_SPIN_CAP) { atomicAdd(&(bar)[XB_TMO], 1u); break; } } } } while (0)
struct XcdBarrier { unsigned* bar; unsigned x; volatile LAS unsigned* st; };
__device__ __forceinline__ XcdBarrier xcd_barrier_post(unsigned* bar, volatile LAS unsigned* st) {
    XcdBarrier b; b.bar = bar; b.x = xb_xcc_id(); b.st = st;
    if (threadIdx.x == 0) (void)xb_add(&bar[XB_XCNT(b.x)], 1u);
    return b;
}
__device__ __forceinline__ void xcd_barrier_complete(unsigned* bar, unsigned x, unsigned& nloc, unsigned& nx) {
    const unsigned G = gridDim.x * gridDim.y * gridDim.z;
    unsigned sum, cnt, mine, sp = 0u;
    for (;;) {
        sum = 0u; cnt = 0u; mine = 0u;
#pragma unroll
        for (unsigned j = 0; j < 16; ++j) { const unsigned c = xb_ld(&bar[XB_XCNT(j)]); sum += c; cnt += (c > 0u) ? 1u : 0u; mine = (j == x) ? c : mine; }
        if (sum == G) break;
        __builtin_amdgcn_s_sleep(1);
        if ((++sp & 255u) == 0u) { if (xb_ld(&bar[XB_TMO])) break; if (sp > XB_SPIN_CAP) { atomicAdd(&bar[XB_TMO], 1u); break; } }
    }
    nloc = mine > 0u ? mine : 1u; nx = cnt > 0u ? cnt : 1u;
}
__device__ __forceinline__ void xcd_barrier(const XcdBarrier& b) {
    asm volatile("s_waitcnt vmcnt(0)" ::: "memory");
    __syncthreads();
    if (threadIdx.x == 0) {
        unsigned* bar = b.bar;
        __builtin_amdgcn_s_waitcnt(0);
        unsigned nloc = b.st[0], nx = b.st[1];
        if (nloc == 0u) { xcd_barrier_complete(bar, b.x, nloc, nx); b.st[0] = nloc; b.st[1] = nx; }
        const unsigned old = xb_add(&bar[XB_XSUB(b.x)], 1u);
        const unsigned gen = old / nloc;
        if (old + 1u == (gen + 1u) * nloc) {
            __builtin_amdgcn_fence(__ATOMIC_RELEASE, "agent");
            asm volatile("s_waitcnt vmcnt(0)" ::: "memory");
            const unsigned og = xb_add(&bar[XB_TOP], 1u);
            const unsigned tg = og / nx;
            if (og + 1u == (tg + 1u) * nx) xb_add(&bar[XB_TOPGEN], 1u);
            else XB_SPIN(xb_ld(&bar[XB_TOPGEN]) == tg, bar);
            __builtin_amdgcn_fence(__ATOMIC_ACQUIRE, "agent");
            xb_add(&bar[XB_XGEN(b.x)], 1u);
            asm volatile("s_waitcnt vmcnt(0)" ::: "memory");
        } else {
            XB_SPIN(xb_ld(&bar[XB_XGEN(b.x)]) == gen, bar);
            __builtin_amdgcn_fence(__ATOMIC_ACQUIRE, "agent");
            asm volatile("s_waitcnt vmcnt(0)" ::: "memory");
        }
    }
    __syncthreads();
}
constexpr int LDS_MISC = 139264;
constexpr size_t WS_BAR = 4096;
constexpr size_t CTL_ZERO_BYTES = 65536;

__device__ __forceinline__ void group_barrier(unsigned* ctr, unsigned nblk) {
    asm volatile("s_waitcnt vmcnt(0)" ::: "memory");
    __syncthreads();
    if (threadIdx.x == 0) {
        __builtin_amdgcn_fence(__ATOMIC_RELEASE, "agent");
        asm volatile("s_waitcnt vmcnt(0)" ::: "memory");
        (void)xb_add(ctr, 1u);
        unsigned sp = 0u;
        while (xb_ld(ctr) < nblk) { __builtin_amdgcn_s_sleep(1); if (++sp > XB_SPIN_CAP) break; }
        __builtin_amdgcn_fence(__ATOMIC_ACQUIRE, "agent");
        asm volatile("s_waitcnt vmcnt(0)" ::: "memory");
    }
    __syncthreads();
}
constexpr size_t WS_GBAR = 32768;

constexpr int NPH_L = 8;
constexpr int NPHASES = 1 + NL * NPH_L;

template <int ONLY>
__global__ void __launch_bounds__(512, 2) mk_fwd(Args args) {
    extern __shared__ __attribute__((aligned(16))) unsigned char lds_raw[];
    LAS unsigned char* lds = (LAS unsigned char*)lds_raw;
    const int G = gridDim.x;
#if MK_ONE_LAUNCH
    if (threadIdx.x < 2) ((volatile LAS unsigned*)(lds + LDS_MISC))[threadIdx.x] = 0u;
    __syncthreads();
    XcdBarrier xbar = xcd_barrier_post((unsigned*)(args.ws + WS_BAR), (volatile LAS unsigned*)(lds + LDS_MISC));
    if (args.ph_hi > 100000) cg::this_grid().sync();
#endif
    for (int ph = args.ph_lo; ph < args.ph_hi; ++ph) {
        int tid = threadIdx.x; asm volatile("" : "+v"(tid));
        int bid = blockIdx.x; asm volatile("" : "+s"(bid));
        ArgP A = (ArgP)__builtin_amdgcn_kernarg_segment_ptr(); asm volatile("" : "+s"(A));
        const int lane = tid & 63, wave = __builtin_amdgcn_readfirstlane(tid >> 6);
        unsigned char* ws = A->ws;
        if (ph == 0) { if (ONLY == -1 || ONLY == 100) { phase_A(A, lds, tid, wave, lane, bid, G); __syncthreads(); convert_weights(A, 0, lds, wave, lane, bid * 8 + wave, G * 8); } }
        else {
            const int l = (ph - 1) / NPH_L; int sp = (int)((0x98764210ull >> (4 * ((ph - 1) % NPH_L))) & 15ull);
            if (ONLY >= 0) { if (ONLY == 100 || sp != ONLY) continue; sp = ONLY; }
            if (sp == 0) phase_B(A, l, lds, tid, wave, lane, bid, G);
            else if (sp == 1) {
                pg8::Gemm g{(const bf16_t*)(ws + WS_H), (const bf16_t*)(ws + (size_t)(l & 1) * WS_WSET2 + WS_WIN), 1024, 1024, 1024, 0, 0};
                pg8::Sched S; if (l == NL - 1) S.init(ML / 256, INC / 256, 1, G, bid, MC / 256, 9); else S.init(MT / 256, INC / 256, 1, G, bid);
                pg8::Epi1 E{(bf16_t*)(ws + WS_KB), (bf16_t*)(ws + WS_VB), (bf16_t*)(ws + WS_RW), (bf16_t*)(ws + WS_YD), (bf16_t*)(ws + WS_QB), (bf16_t*)(ws + WS_GU), (bf16_t*)(ws + WS_VA), (bf16_t*)(ws + WS_Z), (bf16_t*)(ws + WS_G)};
                pg8::gemm_phase<pg8::Epi1>(lds, g, S, E, tid);
            } else if (sp == 2) {
                pg8::Gemm g{(const bf16_t*)(ws + WS_YD), (const bf16_t*)(ws + (size_t)(l & 1) * WS_WSET2 + WS_WLORA), 256, 256, 256, 0, 0};
                pg8::Sched S; S.init(MT / 256, 2048 / 256, 1, G, bid);
                pg8::EpiLora E{(bf16_t*)(ws + WS_WA), A->in[17] + l * 1024, A->in[19] + l * 1024};
                pg8::gemm_phase<pg8::EpiLora>(lds, g, S, E, tid);
                phase_prep(A, l, tid, wave, lane, bid, G);
            }
            else if (sp == 4) { for (int u = bid; u < (l == NL - 1 ? 256 : 272); u += G) att::attn_unit(A, l, u, (char*)lds_raw, tid, bid); }
            else if (sp == 5) { for (int u = bid; u < (MT / 128) * 4; u += G) gmlp_unit(A, l, u, (char*)lds_raw, tid); }
            else if (sp == 6) {
                if (bid < 64) scanc::scan_unit(A, l, bid, (LAS char*)lds, tid);
                else { const int nb = G - 64, ob = bid - 64;
                    for (int u = ob; u < ((l == NL - 1 ? ML : MT) / 128) * 4; u += nb) gmlp_unit(A, l, u, (char*)lds_raw, tid);
                    __syncthreads();
                    const bf16_t* wbr = (const bf16_t*)(ws + (size_t)(l & 1) * WS_WSET2 + WS_WBR);
                    pg8::Sched S; S.init((l == NL - 1 ? ML : MT) / 256, 1024 / 256, 1, nb, ob);
                    {   pg8::Gemm g{(const bf16_t*)(ws + WS_RW) + 512, wbr + (size_t)1024 * 512, 1536, 512, 512, 0, 0};
                        pg8::EpiMerge E{(const bf16_t*)(ws + WS_G), (bf16_t*)(ws + WS_H), 1, true};
                        pg8::gemm_phase<pg8::EpiMerge>(lds, g, S, E, tid); }
                    __syncthreads();
                    if (l + 1 < NL) convert_weights(A, l + 1, lds, wave, lane, ob * 8 + wave, nb * 8);
                    group_barrier((unsigned*)(ws + WS_GBAR) + l * 64, (unsigned)nb);
                    {   pg8::Gemm g{(const bf16_t*)(ws + WS_RW), wbr, 1536, 512, 512, 0, 0};
                        pg8::EpiMerge E{(const bf16_t*)(ws + WS_G), (bf16_t*)(ws + WS_H), 0, false};
                        pg8::gemm_phase<pg8::EpiMerge>(lds, g, S, E, tid); } }
            }
            else if (sp == 7) phase_readout(A, l, wave, lane, bid, G);
            else if (sp == 8) {
                pg8::Gemm g{(const bf16_t*)(ws + WS_RW) + 1024, (const bf16_t*)(ws + (size_t)(l & 1) * WS_WSET2 + WS_WBR) + (size_t)2 * 1024 * 512, 1536, 512, 512, 0, 0};
                pg8::Sched S; S.init((l == NL - 1 ? ML : MT) / 256, 1024 / 256, 1, G, bid);
                pg8::EpiMerge E{(const bf16_t*)(ws + WS_G), (bf16_t*)(ws + WS_H), 2, false};
                pg8::gemm_phase<pg8::EpiMerge>(lds, g, S, E, tid);
            } else {
                pg8::Gemm g{(const bf16_t*)(ws + WS_H), (const bf16_t*)(ws + (size_t)(l & 1) * WS_WSET2 + WS_WOUT), 1024, 1024, 1024, 0, 0};
                pg8::Sched S; S.init((l == NL - 1 ? ML : MT) / 256, 1024 / 256, 1, G, bid);
                pg8::EpiOut E{l == 0 ? A->in[0] : A->out, A->out, l == 0 ? A->in[2] : (const float*)(ws + WS_XC), (float*)(ws + WS_XC), (const float*)(ws + WS_MODB) + (size_t)l * 5 * 3072};
                pg8::gemm_phase<pg8::EpiOut>(lds, g, S, E, tid);
            }
        }
#if MK_ONE_LAUNCH
        if (ph + 1 < args.ph_hi) xcd_barrier(xbar);
#endif
    }
}


extern "C" void kernel_launch(void* const* d_in, const int* in_sizes, int n_in, void* d_out, int out_size, void* d_ws, size_t ws_size, hipStream_t stream) {
    static int state = 0;
    if (state == 0) {
        if (n_in != 28 || out_size != ML * DM || ws_size < WS_END) { fprintf(stderr, "kernel_launch: unexpected shapes (n_in %d out %d ws %zu)\n", n_in, out_size, ws_size); state = -1; return; }
        state = 1;
    }
    if (state < 0) return;
    Args a{};
    for (int i = 0; i < 28; ++i) a.in[i] = (const float*)d_in[i];
    a.out = (float*)d_out; a.ws = (unsigned char*)d_ws;
#if MK_ONE_LAUNCH
    static int grid = 0;
    if (grid == 0) {
        if (hipFuncSetAttribute((const void*)mk_fwd<-1>, hipFuncAttributeMaxDynamicSharedMemorySize, LDS_BYTES) != hipSuccess) fprintf(stderr, "kernel_launch: hipFuncSetAttribute failed\n");
        int dev = 0, cus = 0, per_cu = 0;
        hipGetDevice(&dev); hipDeviceGetAttribute(&cus, hipDeviceAttributeMultiprocessorCount, dev);
        if (hipOccupancyMaxActiveBlocksPerMultiprocessor(&per_cu, (const void*)mk_fwd<-1>, 512, LDS_BYTES) != hipSuccess || per_cu < 1) { fprintf(stderr, "kernel_launch: occupancy query says %d blocks per CU\n", per_cu); per_cu = 1; }
        (void)hipGetLastError();
        grid = cus * (per_cu < 1 ? 1 : 1);
        if (grid > 256) grid = 256;
    }
    (void)hipMemsetAsync(d_ws, 0, CTL_ZERO_BYTES, stream);
    a.ph_lo = 0; a.ph_hi = NPHASES;
    void* kargs[] = {&a};
    hipError_t e = hipLaunchCooperativeKernel((const void*)mk_fwd<-1>, dim3(grid), dim3(512), kargs, LDS_BYTES, stream);
    if (e != hipSuccess) fprintf(stderr, "cooperative launch failed: %s\n", hipGetErrorString(e));
#endif
}
```

```cpp
#include <hip/hip_runtime.h>
#include <hip/hip_cooperative_groups.h>
#include <cstdint>
#include <cstdio>
namespace cg = cooperative_groups;

#ifndef MK_ONE_LAUNCH
#define MK_ONE_LAUNCH 1
#endif

#define LAS __attribute__((address_space(3)))
#define GAS __attribute__((address_space(1)))
typedef unsigned short bf16_t;
typedef short bf16x8 __attribute__((ext_vector_type(8)));
typedef short s16x4 __attribute__((ext_vector_type(4)));
typedef float f32x2 __attribute__((ext_vector_type(2)));
typedef float f32x4 __attribute__((ext_vector_type(4)));
typedef float f32x16 __attribute__((ext_vector_type(16)));
typedef unsigned u32x2 __attribute__((ext_vector_type(2)));
typedef unsigned u32x4 __attribute__((ext_vector_type(4)));

constexpr int DM = 1024, NB = 4, SEQ = 4096, NL = 4, CTX = 256;
constexpr int ML = NB * SEQ;
constexpr int MC = NB * CTX;
constexpr int MT = ML + MC;
constexpr int INC = 8960;
constexpr float NORM_EPS = 1e-6f, LN_EPS = 1e-5f, GN_EPS = 64e-5f;
constexpr float LOG2E = 1.4426950408889634f;
constexpr float QSCALE = 0.125f * LOG2E;

constexpr size_t MiB = 1u << 20;
constexpr size_t WS_MODB = 1 * MiB;
constexpr size_t WS_ROPE = WS_MODB + 256 * 1024;
constexpr size_t WS_SCAL = WS_ROPE + 16 * 1024;
constexpr size_t WS_WIN  = 2 * MiB;
constexpr size_t WS_WBR  = 20 * MiB;
constexpr size_t WS_WOUT = 23 * MiB;
constexpr size_t WS_WLORA = 25 * MiB;
constexpr size_t WS_XC   = 26 * MiB;
constexpr size_t WS_H    = 30 * MiB;
constexpr size_t WS_MB   = 30 * MiB;
constexpr size_t WS_KB   = 64 * MiB;
constexpr size_t WS_QB   = 81 * MiB;
constexpr size_t WS_VB   = 98 * MiB;
constexpr size_t WS_RW   = 115 * MiB;
constexpr size_t WS_GU   = 166 * MiB;
constexpr size_t WS_VA   = 183 * MiB;
constexpr size_t WS_Z    = 200 * MiB;
constexpr size_t WS_G    = 251 * MiB;
constexpr size_t WS_WA   = 353 * MiB;
constexpr size_t WS_RWP  = 421 * MiB;
constexpr size_t WS_YD   = 489 * MiB;
constexpr size_t WS_WSET2 = 521 * MiB;
constexpr size_t WS_END  = 547 * MiB;

constexpr int LDS_BYTES = 147456;

__device__ __forceinline__ float bf2f(unsigned short h) { return __uint_as_float(((unsigned)h) << 16); }
typedef __bf16 bf16x2_t __attribute__((ext_vector_type(2)));
__device__ __forceinline__ unsigned cvt_pk_bf16(float lo, float hi) { f32x2 v = {lo, hi}; bf16x2_t b = __builtin_convertvector(v, bf16x2_t); return __builtin_bit_cast(unsigned, b); }
__device__ __forceinline__ float fast_sig(float z) { return __builtin_amdgcn_rcpf(1.0f + __builtin_amdgcn_exp2f(-z * LOG2E)); }
__device__ __forceinline__ float wave_sum(float v) {
#pragma unroll
    for (int o = 1; o < 64; o <<= 1) v += __shfl_xor(v, o);
    return v;
}
__device__ __forceinline__ void unpack8(const u32x4 w, float (&f)[8]) {
    f[0] = __uint_as_float(w.x << 16); f[1] = __uint_as_float(w.x & 0xffff0000u);
    f[2] = __uint_as_float(w.y << 16); f[3] = __uint_as_float(w.y & 0xffff0000u);
    f[4] = __uint_as_float(w.z << 16); f[5] = __uint_as_float(w.z & 0xffff0000u);
    f[6] = __uint_as_float(w.w << 16); f[7] = __uint_as_float(w.w & 0xffff0000u);
}
__device__ __forceinline__ u32x4 pack8(const float (&f)[8]) {
    u32x4 w; w.x = cvt_pk_bf16(f[0], f[1]); w.y = cvt_pk_bf16(f[2], f[3]); w.z = cvt_pk_bf16(f[4], f[5]); w.w = cvt_pk_bf16(f[6], f[7]); return w;
}

struct Args {
    const float* in[28];
    float* out; unsigned char* ws;
    int ph_lo, ph_hi;
};
typedef const __attribute__((address_space(4))) Args* ArgP;

namespace pg8 {
constexpr int BM = 256, BK = 64, HALF = 128, HTB = HALF * BK * 2, STAGE_BYTES = 8 * HTB, NXCD = 8, WGM = 8;
__host__ __device__ __forceinline__ int lds_byte(int r, int c) { const int st = (r >> 4) * 2 + (c >> 5), rr = r & 15, cc = c & 31, ob = rr * 64 + cc * 2; return st * 1024 + (ob ^ (((ob >> 9) & 1) << 5)); }
__host__ __device__ __forceinline__ void stage_rc(int b, int& R, int& C) { const int st = b / 1024, sb = b % 1024, swz = sb ^ (((sb >> 9) & 1) << 5); R = (st >> 1) * 16 + swz / 64; C = (st & 1) * 32 + (swz % 64) / 2; }
__host__ __device__ __forceinline__ int perm32(int rho) { const int n = rho >> 4, i = rho & 15; return 8 * (i >> 2) + 4 * n + (i & 3); }

struct Unit { int pm, pn, pz; };
struct Gemm { const bf16_t* A; const bf16_t* Bt; int lda, ldb, K; size_t zA, zB; };

struct Sched {
    int nM, nN, nZ, nwg, G, c, nM2, nN2;
    int mode = 0, spm = 0, spn = 0;
    __device__ void init(int nM_, int nN_, int nZ_, int G_, int c_, int nM2_ = 0, int nN2_ = 0) { nM = nM_; nN = nN_; nZ = nZ_; nwg = nM * nN; G = G_; c = c_; nM2 = nM2_; nN2 = nN2_; }
    __device__ void init_gemm1_holes(int G_, int c_) { init(MT / 256, 33, 1, G_, c_); mode = 1; }
    __device__ void init_single(int pm_, int pn_) { init(1, 1, 1, 1, 0); mode = 2; spm = pm_; spn = pn_; }
    __device__ bool next(int i, Unit& u) const {
        if (mode == 2) { if (i > 0) return false; u.pm = spm; u.pn = spn; u.pz = 0; return true; }
        if (mode == 1) { const long L1 = (long)i * G + c;
            if (L1 >= nwg) { const int e = (int)(L1 - nwg); if (e >= 60) return false; if (e < 4) { u.pm = 64 + e; u.pn = 23; } else { u.pm = 12 + (e - 4); u.pn = 24; } u.pz = 0; return true; } }
        const int ti = i / nZ, z = i - ti * nZ;
        const long L = (long)ti * G + c;
        if (L >= nwg) { const int e = (int)(L - nwg); if (e >= nM2 * nN2) return false; u.pm = nM + e % nM2; u.pn = e / nM2; u.pz = 0; return true; }
        int wgid = (int)L; { const int q = nwg / NXCD, r = nwg % NXCD, xcd = wgid % NXCD, off = wgid / NXCD; wgid = (xcd < r ? xcd * (q + 1) : r * (q + 1) + (xcd - r) * q) + off; }
        const int nig = WGM * nN, gid = wgid / nig, fm = gid * WGM, gsz = (nM - fm) < WGM ? (nM - fm) : WGM;
        u.pm = fm + ((wgid % nig) % gsz); u.pn = (wgid % nig) / gsz; u.pz = z; if (mode == 1 && u.pn >= 23) u.pn += 2; return true;
    }
};

template <class Epi>
__device__ __forceinline__ void gemm_phase(LAS unsigned char* lds, const Gemm g, const Sched& S, const Epi& E, const int tid_) {
    int tid = tid_; asm volatile("" : "+v"(tid));
    const int wid = __builtin_amdgcn_readfirstlane(tid >> 6), lane = tid & 63, wr = wid >> 2, wc = wid & 3, fr = lane & 15, fq = lane >> 4;
    int Kl = g.K; asm volatile("" : "+s"(Kl));
    const int K = Kl, nt = K / BK;
    unsigned voffA[2], voffB[2];
#pragma unroll
    for (int i = 0; i < 2; ++i) { int R, C; stage_rc(tid * 16 + i * 8192, R, C); const int Rb = Epi::PERM ? ((R & ~31) + perm32(R & 31)) : R;
        voffA[i] = (unsigned)(R * g.lda + C) * 2u; voffB[i] = (unsigned)(Rb * g.ldb + C) * 2u; }
    const size_t kstep = (size_t)(BK * 2);
    const size_t hstepA = (size_t)HALF * g.lda * 2, hstepB = (size_t)HALF * g.ldb * 2;
    const size_t tstepA = 2 * hstepA, tstepB = 2 * hstepB;
    const unsigned ldsw = (unsigned)wid * 1024u;
    const int aoff = lds_byte(wr * 64 + fr, fq * 8), boff = lds_byte(wc * 32 + fr, fq * 8);
#define PG8_SA(b, h) (((b) * 2 + (h)) * HTB)
#define PG8_SB(b, h) ((4 + (b) * 2 + (h)) * HTB)
#define PG8_STAGE(bufoff, gbase, voff) do { _Pragma("unroll") for (int _i = 0; _i < 2; ++_i) \
        __builtin_amdgcn_global_load_lds((const unsigned*)((const char*)(gbase) + (voff)[_i]), (LAS unsigned*)(lds + (bufoff) + ldsw + _i * 8192), 16, 0, 0); } while (0)
#define PG8_LDA(dst, b, h) do { _Pragma("unroll") for (int m = 0; m < 4; ++m) _Pragma("unroll") for (int k = 0; k < 2; ++k) dst[m][k] = *(const LAS bf16x8*)(lds + PG8_SA(b, h) + aoff + m * 2048 + k * 1024); } while (0)
#define PG8_LDB(dst, b, h) do { _Pragma("unroll") for (int n = 0; n < 2; ++n) _Pragma("unroll") for (int k = 0; k < 2; ++k) dst[n][k] = *(const LAS bf16x8*)(lds + PG8_SB(b, h) + boff + n * 2048 + k * 1024); } while (0)
#define PG8_MMA(ai, bj, At, Bt) do { __builtin_amdgcn_s_setprio(1); _Pragma("unroll") for (int m = 0; m < 4; ++m) _Pragma("unroll") for (int n = 0; n < 2; ++n) _Pragma("unroll") for (int k = 0; k < 2; ++k) \
        acc[ai][bj][m][n] = __builtin_amdgcn_mfma_f32_16x16x32_bf16(Bt[n][k], At[m][k], acc[ai][bj][m][n], 0, 0, 0); __builtin_amdgcn_s_setprio(0); } while (0)
#define PG8_WAIT_V(n) asm volatile("s_waitcnt vmcnt(" #n ")" ::: "memory")
#define PG8_WAIT_L(n) asm volatile("s_waitcnt lgkmcnt(" #n ")" ::: "memory")
#define PG8_BAR __builtin_amdgcn_s_barrier()
#define PG8_SCHED __builtin_amdgcn_sched_barrier(0)
    Unit cur, nxt; int ui = 0;
    if (!S.next(0, cur)) return;
    f32x4 acc[2][2][4][2];
#pragma unroll
    for (int a = 0; a < 2; ++a)
#pragma unroll
        for (int b = 0; b < 2; ++b)
#pragma unroll
            for (int m = 0; m < 4; ++m)
#pragma unroll
                for (int n = 0; n < 2; ++n) acc[a][b][m][n] = (f32x4){0.f, 0.f, 0.f, 0.f};
    bf16x8 At[4][2], B0[2][2], B1[2][2];
    const char* cA = (const char*)g.A + (size_t)cur.pm * tstepA + (size_t)cur.pz * g.zA; const char* cB = (const char*)g.Bt + (size_t)cur.pn * tstepB + (size_t)cur.pz * g.zB;
    PG8_STAGE(PG8_SB(0, 0), cB, voffB); PG8_STAGE(PG8_SB(0, 1), cB + hstepB, voffB); PG8_STAGE(PG8_SA(0, 0), cA, voffA); PG8_STAGE(PG8_SA(0, 1), cA + hstepA, voffA);
    if (wr == 1) PG8_BAR;
    PG8_WAIT_V(2); PG8_BAR;
    PG8_STAGE(PG8_SB(1, 0), cB + kstep, voffB); PG8_STAGE(PG8_SA(1, 0), cA + kstep, voffA); PG8_STAGE(PG8_SB(1, 1), cB + hstepB + kstep, voffB);
    PG8_WAIT_V(6); PG8_BAR;
    for (;;) {
        const bool has_next = S.next(ui + 1, nxt);
        const char* nA = has_next ? (const char*)g.A + (size_t)nxt.pm * tstepA + (size_t)nxt.pz * g.zA : cA;
        const char* nB = has_next ? (const char*)g.Bt + (size_t)nxt.pn * tstepB + (size_t)nxt.pz * g.zB : cB;
        for (int t = 0; t < nt; t += 2) {
            const bool last = (t == nt - 2);
            const char* a1 = cA + (size_t)(t + 1) * kstep;
            const char* a2 = last ? nA : cA + (size_t)(t + 2) * kstep; const char* b2 = last ? nB : cB + (size_t)(t + 2) * kstep;
            const char* a3 = a2 + kstep; const char* b3 = b2 + kstep;
            PG8_LDB(B0, 0, 0); PG8_LDB(B1, 0, 1); PG8_SCHED; PG8_LDA(At, 0, 0); PG8_STAGE(PG8_SA(1, 1), a1 + hstepA, voffA);
            PG8_WAIT_V(8); PG8_WAIT_L(0); PG8_BAR; PG8_MMA(0, 0, At, B0); PG8_MMA(0, 1, At, B1); PG8_BAR; PG8_SCHED;
            PG8_LDA(At, 0, 1); PG8_STAGE(PG8_SB(0, 0), b2, voffB); PG8_STAGE(PG8_SB(0, 1), b2 + hstepB, voffB); PG8_STAGE(PG8_SA(0, 0), a2, voffA);
            PG8_WAIT_V(8); PG8_WAIT_L(0); PG8_BAR; PG8_MMA(1, 0, At, B0); PG8_MMA(1, 1, At, B1); PG8_BAR; PG8_SCHED;
            PG8_LDB(B0, 1, 0); PG8_LDB(B1, 1, 1); PG8_SCHED; PG8_LDA(At, 1, 0); PG8_STAGE(PG8_SA(0, 1), a2 + hstepA, voffA);
            PG8_WAIT_V(8); PG8_WAIT_L(0); PG8_BAR; PG8_MMA(0, 0, At, B0); PG8_MMA(0, 1, At, B1); PG8_BAR; PG8_SCHED;
            PG8_LDA(At, 1, 1); PG8_STAGE(PG8_SB(1, 0), b3, voffB); PG8_STAGE(PG8_SB(1, 1), b3 + hstepB, voffB); PG8_STAGE(PG8_SA(1, 0), a3, voffA);
            PG8_WAIT_V(8); PG8_WAIT_L(0); PG8_BAR; PG8_MMA(1, 0, At, B0); PG8_MMA(1, 1, At, B1); PG8_BAR; PG8_SCHED;
        }
        if (wr == 0) PG8_BAR;
        E(acc, cur, wr, wc, fr, fq);
        if (!has_next) break;
#pragma unroll
        for (int a = 0; a < 2; ++a)
#pragma unroll
            for (int b = 0; b < 2; ++b)
#pragma unroll
                for (int m = 0; m < 4; ++m)
#pragma unroll
                    for (int n = 0; n < 2; ++n) acc[a][b][m][n] = (f32x4){0.f, 0.f, 0.f, 0.f};
        cur = nxt; cA = nA; cB = nB; ++ui;
        if (wr == 1) PG8_BAR;
    }
    PG8_WAIT_V(0);
    PG8_BAR;
#undef PG8_SA
#undef PG8_SB
#undef PG8_STAGE
#undef PG8_LDA
#undef PG8_LDB
#undef PG8_MMA
#undef PG8_WAIT_V
#undef PG8_WAIT_L
#undef PG8_BAR
#undef PG8_SCHED
}

template <int ACT> __device__ __forceinline__ float act_f(float x) {
    if (ACT == 0) return x;
    if (ACT == 1) { const float z = x * (1.5957691216f + 0.0713548163f * x * x); return x * fast_sig(z); }
    if (ACT == 2) return x * fast_sig(x);
    if (ACT == 3) return fast_sig(x);
    return 2.0f * fast_sig(2.0f * x) - 1.0f;
}
template <int ACT0, int ACT1> __device__ __forceinline__ void epi_store_bf16(const f32x4 (&acc)[2][2][4][2], bf16_t* base, int ld, int row0, int col0) {
#pragma unroll
    for (int ai = 0; ai < 2; ++ai)
#pragma unroll
        for (int m = 0; m < 4; ++m) { bf16_t* rowp = base + (size_t)(row0 + ai * HALF + m * 16) * ld + col0;
#pragma unroll
            for (int bj = 0; bj < 2; ++bj) { const f32x4 v0 = acc[ai][bj][m][0], v1 = acc[ai][bj][m][1];
                float o[8];
                if (bj == 0) { o[0] = act_f<ACT0>(v0[0]); o[1] = act_f<ACT0>(v0[1]); o[2] = act_f<ACT0>(v0[2]); o[3] = act_f<ACT0>(v0[3]); o[4] = act_f<ACT0>(v1[0]); o[5] = act_f<ACT0>(v1[1]); o[6] = act_f<ACT0>(v1[2]); o[7] = act_f<ACT0>(v1[3]); }
                else         { o[0] = act_f<ACT1>(v0[0]); o[1] = act_f<ACT1>(v0[1]); o[2] = act_f<ACT1>(v0[2]); o[3] = act_f<ACT1>(v0[3]); o[4] = act_f<ACT1>(v1[0]); o[5] = act_f<ACT1>(v1[1]); o[6] = act_f<ACT1>(v1[2]); o[7] = act_f<ACT1>(v1[3]); }
                *(u32x4*)(rowp + bj * HALF) = pack8(o); } __builtin_amdgcn_sched_barrier(0); }
}
struct Epi1 {
    static constexpr bool PERM = true;
    bf16_t *Kb, *Vb, *RW, *LA, *Qb, *GU, *VA, *Z, *G;
    __device__ __forceinline__ void operator()(const f32x4 (&acc)[2][2][4][2], const Unit& u, int wr, int wc, int fr, int fq) const {
        const int pn = u.pn; bf16_t* base; int ld, colt, act;
        if (pn < 2)       { base = Kb; ld = 512;  colt = pn * 256;               act = 0; }
        else if (pn < 4)  { base = Vb; ld = 512;  colt = (pn - 2) * 256;         act = 0; }
        else if (pn < 8)  { base = RW; ld = 1536; colt = (pn - 4) * 256;         act = 0; }
        else if (pn == 8) { base = LA; ld = 256;  colt = 0;                      act = 4; }
        else if (pn < 11) { base = Qb; ld = 512;  colt = (pn - 9) * 256;         act = 0; }
        else if (pn < 13) { base = RW; ld = 1536; colt = 1024 + (pn - 11) * 256; act = 0; }
        else if (pn < 15) { base = GU; ld = 512;  colt = (pn - 13) * 256;        act = 1; }
        else if (pn < 17) { base = VA; ld = 512;  colt = (pn - 15) * 256;        act = 1; }
        else if (pn < 23) { base = Z;  ld = 1536; colt = (pn - 17) * 256;        act = 2; }
        else              { base = G;  ld = 3072; colt = (pn - 23) * 256;        act = 3; }
        const int row0 = u.pm * BM + wr * 64 + fr, col0 = colt + wc * 32 + 8 * fq;
        if (act == 0) epi_store_bf16<0, 0>(acc, base, ld, row0, col0);
        else if (act == 1) epi_store_bf16<1, 1>(acc, base, ld, row0, col0);
        else if (act == 2) epi_store_bf16<2, 2>(acc, base, ld, row0, col0);
        else if (act == 3) epi_store_bf16<3, 3>(acc, base, ld, row0, col0);
        else epi_store_bf16<4, 0>(acc, base, ld, row0, col0);
    }
};
template <bool ISW> __device__ __forceinline__ void epi_lora_store(const f32x4 (&acc)[2][2][4][2], bf16_t* WA, const float* bias, int row0, int col0) {
#pragma unroll
    for (int bj = 0; bj < 2; ++bj) {
        const f32x4 bv0 = *(const f32x4*)(bias + bj * HALF), bv1 = *(const f32x4*)(bias + bj * HALF + 4);
#pragma unroll
        for (int ai = 0; ai < 2; ++ai)
#pragma unroll
            for (int m = 0; m < 4; ++m) { bf16_t* rowp = WA + (size_t)(row0 + ai * HALF + m * 16) * 2048 + col0 + bj * HALF; float o[8];
#pragma unroll
                for (int e = 0; e < 4; ++e) { const float s0 = fast_sig(acc[ai][bj][m][0][e] + bv0[e]), s1 = fast_sig(acc[ai][bj][m][1][e] + bv1[e]);
                    o[e] = ISW ? (1.0f - __builtin_amdgcn_exp2f(-0.60653065971f * LOG2E * s0)) : s0;
                    o[4 + e] = ISW ? (1.0f - __builtin_amdgcn_exp2f(-0.60653065971f * LOG2E * s1)) : s1; }
                *(u32x4*)rowp = pack8(o); __builtin_amdgcn_sched_barrier(0); }
        asm volatile("" ::: "memory");
    }
}
struct EpiLora {
    static constexpr bool PERM = true;
    bf16_t* WA; const float* w0; const float* a0;
    __device__ __forceinline__ void operator()(const f32x4 (&acc)[2][2][4][2], const Unit& u, int wr, int wc, int fr, int fq) const {
        const int row0 = u.pm * BM + wr * 64 + fr, col0 = u.pn * BM + wc * 32 + 8 * fq;
        if (u.pn < 4) epi_lora_store<true>(acc, WA, w0 + col0, row0, col0);
        else epi_lora_store<false>(acc, WA, a0 + col0 - 1024, row0, col0);
    }
};
struct EpiMerge {
    static constexpr bool PERM = true;
    const bf16_t* G; bf16_t* MB; int z0; bool first;
    __device__ __forceinline__ void operator()(const f32x4 (&acc)[2][2][4][2], const Unit& u, int wr, int wc, int fr, int fq) const {
        const int row0 = u.pm * BM + wr * 64 + fr, col0 = u.pn * BM + wc * 32 + 8 * fq, z = z0; const bool accu = !first;
        u32x4 gc[2], gn[2], pc[2], pn_[2];
#define MLOAD(dg, dp, g_) do { const size_t row_ = (size_t)(row0 + ((g_) >> 2) * HALF + ((g_) & 3) * 16); \
        _Pragma("unroll") for (int bj = 0; bj < 2; ++bj) { const int c_ = col0 + bj * HALF; dg[bj] = *(const u32x4*)(G + row_ * 3072 + z * 1024 + c_); \
            if (accu) dp[bj] = *(const u32x4*)(MB + row_ * 1024 + c_); } } while (0)
        MLOAD(gc, pc, 0);
#pragma unroll
        for (int g = 0; g < 8; ++g) { const int ai = g >> 2, m = g & 3; const size_t row = (size_t)(row0 + ai * HALF + m * 16);
            if (g + 1 < 8) MLOAD(gn, pn_, g + 1);
#pragma unroll
            for (int bj = 0; bj < 2; ++bj) { const int c = col0 + bj * HALF; float gf[8]; unpack8(gc[bj], gf); float o[8];
#pragma unroll
                for (int n = 0; n < 2; ++n)
#pragma unroll
                    for (int e = 0; e < 4; ++e) o[n * 4 + e] = acc[ai][bj][m][n][e] * gf[n * 4 + e];
                if (accu) { float pf[8]; unpack8(pc[bj], pf);
#pragma unroll
                    for (int e = 0; e < 8; ++e) o[e] += pf[e]; }
                *(u32x4*)(MB + row * 1024 + c) = pack8(o); }
#pragma unroll
            for (int bj = 0; bj < 2; ++bj) { gc[bj] = gn[bj]; pc[bj] = pn_[bj]; } }
#undef MLOAD
    }
};
struct EpiOut {
    static constexpr bool PERM = false;
    const float* xin; float* xout; const float* xcin; float* xcout; const float* modl;
    __device__ __forceinline__ void operator()(const f32x4 (&acc)[2][2][4][2], const Unit& u, int wr, int wc, int fr, int fq) const {
        const bool lat = u.pm < (ML / BM);
        const int b = lat ? (u.pm >> 4) : 4;
        const float* src = lat ? xin : xcin; float* dst = lat ? xout : xcout;
        const int row0 = (lat ? u.pm * BM : u.pm * BM - ML) + wr * 64 + fr, col0 = u.pn * BM + wc * 32 + 4 * fq;
        const float* gate = modl + b * 3072 + 2048 + col0;
        f32x4 gv[2][2];
#pragma unroll
        for (int bj = 0; bj < 2; ++bj)
#pragma unroll
            for (int n = 0; n < 2; ++n) gv[bj][n] = *(const f32x4*)(gate + bj * HALF + n * 16);
        f32x4 xc[2][2], xn[2][2];
#define XLOAD(dst, g_) do { const size_t off_ = (size_t)(row0 + ((g_) >> 2) * HALF + ((g_) & 3) * 16) * 1024 + col0; \
        _Pragma("unroll") for (int bj = 0; bj < 2; ++bj) _Pragma("unroll") for (int n = 0; n < 2; ++n) dst[bj][n] = *(const f32x4*)(src + off_ + bj * HALF + n * 16); } while (0)
        XLOAD(xc, 0);
#pragma unroll
        for (int g = 0; g < 8; ++g) { const int ai = g >> 2, m = g & 3; const size_t off = (size_t)(row0 + ai * HALF + m * 16) * 1024 + col0;
            if (g + 1 < 8) XLOAD(xn, g + 1);
#pragma unroll
            for (int bj = 0; bj < 2; ++bj)
#pragma unroll
                for (int n = 0; n < 2; ++n) *(f32x4*)(dst + off + bj * HALF + n * 16) = xc[bj][n] + gv[bj][n] * acc[ai][bj][m][n];
#pragma unroll
            for (int bj = 0; bj < 2; ++bj)
#pragma unroll
                for (int n = 0; n < 2; ++n) xc[bj][n] = xn[bj][n]; }
#undef XLOAD
    }
};
}

__device__ __forceinline__ void phase_A(ArgP a, LAS unsigned char* lds, int tid, int wave, int lane, int bid, int G) {
    float* MODB = (float*)(a->ws + WS_MODB); f32x2* ROPE = (f32x2*)(a->ws + WS_ROPE); float* SCAL = (float*)(a->ws + WS_SCAL);
    for (int u = bid; u < 194; u += G) {
        if (u < 192) {
            const int l = u / 48, n0 = (u % 48) * 64;
            LAS float* act = (LAS float*)lds;
            for (int i = tid; i < 5120; i += 512) { const int b = i >> 10, k = i & 1023; const float v = b < 4 ? a->in[1][b * 1024 + k] : a->in[3][k]; act[i] = v / (1.0f + __expf(-v)); }
            __syncthreads();
            float acc[5] = {0.f, 0.f, 0.f, 0.f, 0.f};
            const float* W = a->in[4] + ((size_t)l * 1024 + wave * 128) * 3072 + n0 + lane;
#pragma unroll 16
            for (int k = 0; k < 128; ++k) { const float w = W[(size_t)k * 3072];
#pragma unroll
                for (int b = 0; b < 5; ++b) acc[b] += act[b * 1024 + wave * 128 + k] * w; }
            LAS float* part = (LAS float*)(lds + 20480);
#pragma unroll
            for (int b = 0; b < 5; ++b) part[(wave * 5 + b) * 64 + lane] = acc[b];
            __syncthreads();
            if (tid < 320) { const int b = tid >> 6, ln = tid & 63; float s = a->in[5][l * 3072 + n0 + ln];
#pragma unroll
                for (int w = 0; w < 8; ++w) s += part[(w * 5 + b) * 64 + ln];
                MODB[(size_t)(l * 5 + b) * 3072 + n0 + ln] = s; }
            __syncthreads();
        } else if (u == 192) {
            for (int i = tid; i < 1024; i += 512) { const int pos = i >> 4, f = i & 15;
                const float inv = exp2f(-(float)f * (13.287712379549449f / 16.0f)); const float ang = (float)pos * inv;
                ROPE[i] = (f32x2){cosf(ang), sinf(ang)}; }
        } else {
            if (tid < NL) { const int l = tid; const float* lp = a->in[14] + l * 256;
                float s1 = 0.f, s2 = 0.f; for (int i = 0; i < 64; ++i) { s1 += lp[i] * lp[64 + i]; s2 += lp[128 + i] * lp[192 + i]; }
                const float li = l == 0 ? 0.2f : l == 1 ? 0.35550907f : l == 2 ? 0.47071302f : 0.55605819f;
                float gq = 0.f, gk = 0.f; for (int i = 0; i < 64; ++i) { gq = fmaxf(gq, fabsf(a->in[12][l * 64 + i])); gk = fmaxf(gk, fabsf(a->in[13][l * 64 + i])); }
                SCAL[l * 8 + 0] = expf(s1) - expf(s2) + li;
                SCAL[l * 8 + 1] = -(64.0f * QSCALE * gq * gk * 1.001f);
                SCAL[l * 8 + 2] = 1.0f - li; }
        }
    }
}

__device__ __forceinline__ void transpose_item(const float* W, int K, int N, bf16_t* WT, LAS float* scr, int item, int lane) {
    const int nblk = N / 32, kb = item / nblk, nb = item % nblk, k0 = 64 * kb, n0 = 32 * nb;
#pragma unroll 8
    for (int i = 0; i < 32; ++i) { const int kk = 2 * i + (lane >> 5); scr[kk * 33 + (lane & 31)] = W[(size_t)(k0 + kk) * N + n0 + (lane & 31)]; }
    asm volatile("s_waitcnt lgkmcnt(0)" ::: "memory");
    const int c = lane & 7;
#pragma unroll
    for (int j = 0; j < 4; ++j) { const int n = (lane >> 3) + 8 * j; const LAS float* s = scr + (8 * c) * 33 + n;
        u32x4 o; o.x = cvt_pk_bf16(s[0 * 33], s[1 * 33]); o.y = cvt_pk_bf16(s[2 * 33], s[3 * 33]); o.z = cvt_pk_bf16(s[4 * 33], s[5 * 33]); o.w = cvt_pk_bf16(s[6 * 33], s[7 * 33]);
        *(u32x4*)(WT + (size_t)(n0 + n) * K + k0 + 8 * c) = o; }
    asm volatile("s_waitcnt lgkmcnt(0)" ::: "memory");
}
__device__ __forceinline__ void convert_weights(ArgP a, int l, LAS unsigned char* lds, int wave, int lane, int gw, int NGW) {
    LAS float* scr = (LAS float*)(lds + wave * 16384);
    unsigned char* wb = a->ws + (size_t)(l & 1) * WS_WSET2;
    bf16_t* WIN = (bf16_t*)(wb + WS_WIN); bf16_t* WBR = (bf16_t*)(wb + WS_WBR); bf16_t* WOUT = (bf16_t*)(wb + WS_WOUT); bf16_t* WLORA = (bf16_t*)(wb + WS_WLORA);
    constexpr int I_IN = (1024 / 64) * (INC / 32), I_BR = (512 / 64) * (1024 / 32), I_OUT = (1024 / 64) * (1024 / 32), I_LORA = 1024;
    constexpr int NITEMS = I_IN + 3 * I_BR + I_OUT + I_LORA;
    for (int it = gw; it < NITEMS; it += NGW) {
        int r = it;
        if (r < I_IN) { transpose_item(a->in[7] + (size_t)l * 1024 * INC, 1024, INC, WIN, scr, r, lane); continue; } r -= I_IN;
        if (r < 3 * I_BR) { const int i = r / I_BR; transpose_item(a->in[26] + ((size_t)l * 3 + i) * 512 * 1024, 512, 1024, WBR + (size_t)i * 1024 * 512, scr, r % I_BR, lane); continue; } r -= 3 * I_BR;
        if (r < I_OUT) { transpose_item(a->in[27] + (size_t)l * 1024 * 1024, 1024, 1024, WOUT, scr, r, lane); continue; } r -= I_OUT;
        {
            const int idx = r * 512 + lane * 8, n = idx >> 8, k = idx & 255, kb = k >> 6, rr = k & 63;
            const bool isw = n < 1024; const int nn = isw ? n : n - 1024, d = nn >> 9, c = nn & 511;
            const float* src = (isw ? a->in[18] : a->in[20]) + ((size_t)(l * 2 + d) * 64 + rr) * 512 + c;
            const bool nz = kb == (isw ? d : 2 + d);
            float f[8];
#pragma unroll
            for (int e = 0; e < 8; ++e) f[e] = nz ? src[(size_t)e * 512] : 0.f;
            *(u32x4*)(WLORA + idx) = pack8(f);
        }
    }
}
__device__ __forceinline__ void phase_B(ArgP a, int l, LAS unsigned char* lds, int tid, int wave, int lane, int bid, int G) {
    const int gw = bid * 8 + wave, NGW = G * 8;
    const float* xin = l == 0 ? a->in[0] : a->out; const float* xcin = l == 0 ? a->in[2] : (const float*)(a->ws + WS_XC);
    const float* modl = (const float*)(a->ws + WS_MODB) + (size_t)l * 5 * 3072; const float* ng = a->in[6] + l * 1024;
    bf16_t* H = (bf16_t*)(a->ws + WS_H);
    for (int m = gw; m < MT; m += NGW) {
        const bool lat = m < ML; const int b = lat ? (m >> 12) : 4;
        const f32x4* xr = (const f32x4*)(lat ? xin + (size_t)m * 1024 : xcin + (size_t)(m - ML) * 1024) + lane;
        f32x4 v[4]; float s = 0.f;
#pragma unroll
        for (int j = 0; j < 4; ++j) { v[j] = xr[64 * j]; s += (v[j].x * v[j].x + v[j].y * v[j].y) + (v[j].z * v[j].z + v[j].w * v[j].w); }
        const float rstd = 1.0f / sqrtf(wave_sum(s) * (1.0f / 1024.0f) + NORM_EPS);
        u32x2* o8 = (u32x2*)(H + (size_t)m * 1024) + lane;
#pragma unroll
        for (int j = 0; j < 4; ++j) { const int c = 4 * lane + 256 * j;
            const f32x4 g = *(const f32x4*)(ng + c), sh = *(const f32x4*)(modl + b * 3072 + c), sc = *(const f32x4*)(modl + b * 3072 + 1024 + c);
            const f32x4 h = v[j] * rstd * g * (1.0f + sc) + sh;
            o8[64 * j] = (u32x2){cvt_pk_bf16(h.x, h.y), cvt_pk_bf16(h.z, h.w)}; }
    }
}

__device__ __forceinline__ void qk_normrope(const u32x4 w, bf16_t* rowp, const float* gain, float oscale, bool rope, int ridx, int cidx, const f32x2* ROPE, int lane) {
    const int sub = lane & 7;
    float x[8]; unpack8(w, x);
    float ss = 0.f;
#pragma unroll
    for (int e = 0; e < 8; ++e) ss += x[e] * x[e];
    ss += __shfl_xor(ss, 1); ss += __shfl_xor(ss, 2); ss += __shfl_xor(ss, 4);
    const float rstd = 1.0f / sqrtf(ss * (1.0f / 64.0f) + NORM_EPS);
    const f32x4 g0 = *(const f32x4*)(gain + sub * 8), g1 = *(const f32x4*)(gain + sub * 8 + 4);
    x[0] *= rstd * g0.x; x[1] *= rstd * g0.y; x[2] *= rstd * g0.z; x[3] *= rstd * g0.w; x[4] *= rstd * g1.x; x[5] *= rstd * g1.y; x[6] *= rstd * g1.z; x[7] *= rstd * g1.w;
    float p[8];
#pragma unroll
    for (int e = 0; e < 8; ++e) p[e] = __shfl_xor(x[e], 2);
    if (rope) {
        const int pos = (sub < 4) ? ridx : cidx; const bool first = (sub & 2) == 0; const f32x4* tb = (const f32x4*)(ROPE + pos * 16 + 8 * (sub & 1));
#pragma unroll
        for (int e2 = 0; e2 < 4; ++e2) { const f32x4 cs = tb[e2];
            x[2 * e2] = first ? (x[2 * e2] * cs.x - p[2 * e2] * cs.y) : (p[2 * e2] * cs.y + x[2 * e2] * cs.x);
            x[2 * e2 + 1] = first ? (x[2 * e2 + 1] * cs.z - p[2 * e2 + 1] * cs.w) : (p[2 * e2 + 1] * cs.w + x[2 * e2 + 1] * cs.z); }
    }
#pragma unroll
    for (int e = 0; e < 8; ++e) x[e] *= oscale;
    *(u32x4*)(rowp + lane * 8) = pack8(x);
}
template <int PART> __device__ __forceinline__ void phase_prep(ArgP a, int l, int tid, int wave, int lane, int bid, int G) {
    const int gw = bid * 8 + wave, NGW = G * 8;
    bf16_t* Kb = (bf16_t*)(a->ws + WS_KB); bf16_t* Qb = (bf16_t*)(a->ws + WS_QB); bf16_t* VA = (bf16_t*)(a->ws + WS_VA);
    const bf16_t* RW = (const bf16_t*)(a->ws + WS_RW); bf16_t* RWP = (bf16_t*)(a->ws + WS_RWP);
    const f32x2* ROPE = (const f32x2*)(a->ws + WS_ROPE);
    const float* qg = a->in[12] + l * 64; const float* kg = a->in[13] + l * 64;
    const float* lng = a->in[8] + l * 512; const float* lnb = a->in[9] + l * 512;
    const float* conv = a->in[16] + (size_t)l * 9 * 512;
    const float* rkk = a->in[21] + l * 512;
    constexpr int PREP_R1 = PART == 0 ? 32 * 256 : MT;
    const int nlo = (PREP_R1 - gw + NGW - 1) / NGW;
    const int gw2 = gw - 32 * 8, NGW2 = NGW - 32 * 8;
    const int nhi = gw2 >= 0 ? (MT - PREP_R1 - gw2 + NGW2 - 1) / NGW2 : 0;
    for (int it = 0; it < nlo + nhi; ++it) {
        const int m = it < nlo ? gw + it * NGW : PREP_R1 + gw2 + (it - nlo) * NGW2;
        const bool lat = m < ML; const int t = lat ? (m & 4095) : ((m - ML) & 255); const int tlast = lat ? 4095 : 255;
        const bf16_t* r0 = RW + (size_t)m * 1536 + lane * 8; const bool hp = t > 0, hn = t < tlast;
        if (PART == 0) {
            const u32x4 wk = *(const u32x4*)(Kb + (size_t)m * 512 + lane * 8), wq = *(const u32x4*)(Qb + (size_t)m * 512 + lane * 8);
            qk_normrope(wk, Kb + (size_t)m * 512, kg, 1.0f, lat, t >> 6, t & 63, ROPE, lane);
            qk_normrope(wq, Qb + (size_t)m * 512, qg, QSCALE, lat, t >> 6, t & 63, ROPE, lane);
            continue; }
        const u32x4 wva = *(const u32x4*)(VA + (size_t)m * 512 + lane * 8);
        u32x4 wc[3], wp[3], wn[3];
#pragma unroll
        for (int w = 0; w < 3; ++w) { wc[w] = *(const u32x4*)(r0 + w * 512); wp[w] = (u32x4){0u, 0u, 0u, 0u}; wn[w] = (u32x4){0u, 0u, 0u, 0u};
            if (hp) wp[w] = *(const u32x4*)(r0 + w * 512 - 1536);
            if (hn) wn[w] = *(const u32x4*)(r0 + w * 512 + 1536); }
        {   bf16_t* rp = VA + (size_t)m * 512 + lane * 8; float x[8]; unpack8(wva, x);
            float s = 0.f;
#pragma unroll
            for (int e = 0; e < 8; ++e) s += x[e];
            const float mu = wave_sum(s) * (1.0f / 512.0f); float q = 0.f;
#pragma unroll
            for (int e = 0; e < 8; ++e) { x[e] -= mu; q += x[e] * x[e]; }
            const float rstd = 1.0f / sqrtf(wave_sum(q) * (1.0f / 512.0f) + LN_EPS);
            const f32x4 g0 = *(const f32x4*)(lng + lane * 8), g1 = *(const f32x4*)(lng + lane * 8 + 4), b0 = *(const f32x4*)(lnb + lane * 8), b1 = *(const f32x4*)(lnb + lane * 8 + 4);
            x[0] = x[0] * rstd * g0.x + b0.x; x[1] = x[1] * rstd * g0.y + b0.y; x[2] = x[2] * rstd * g0.z + b0.z; x[3] = x[3] * rstd * g0.w + b0.w;
            x[4] = x[4] * rstd * g1.x + b1.x; x[5] = x[5] * rstd * g1.y + b1.y; x[6] = x[6] * rstd * g1.z + b1.z; x[7] = x[7] * rstd * g1.w + b1.w;
            *(u32x4*)rp = pack8(x); }
        {   float o[3][8];
#pragma unroll
            for (int w = 0; w < 3; ++w) {
                const int ci = (w == 0) ? 1 : (w == 1) ? 2 : 0; const float* tp = conv + (size_t)ci * 3 * 512 + lane * 8;
                float xc[8], xp[8], xn[8]; unpack8(wc[w], xc); unpack8(wp[w], xp); unpack8(wn[w], xn);
                const f32x4 t0a = *(const f32x4*)tp, t0b = *(const f32x4*)(tp + 4), t1a = *(const f32x4*)(tp + 512), t1b = *(const f32x4*)(tp + 516), t2a = *(const f32x4*)(tp + 1024), t2b = *(const f32x4*)(tp + 1028);
#pragma unroll
                for (int e = 0; e < 4; ++e) { o[w][e] = xp[e] * t0a[e] + xc[e] * t1a[e] + xn[e] * t2a[e]; o[w][4 + e] = xp[4 + e] * t0b[e] + xc[4 + e] * t1b[e] + xn[4 + e] * t2b[e]; } }
            float kq[8], ss = 0.f; const f32x4 rk0 = *(const f32x4*)(rkk + lane * 8), rk1 = *(const f32x4*)(rkk + lane * 8 + 4);
#pragma unroll
            for (int e = 0; e < 8; ++e) { kq[e] = o[0][e] * ((e < 4) ? rk0[e & 3] : rk1[e & 3]); ss += kq[e] * kq[e]; }
            ss += __shfl_xor(ss, 1); ss += __shfl_xor(ss, 2); ss += __shfl_xor(ss, 4);
            const float inv = 1.0f / fmaxf(sqrtf(ss), 1e-12f);
#pragma unroll
            for (int e = 0; e < 8; ++e) kq[e] *= inv;
            bf16_t* op = RWP + (size_t)m * 2048 + lane * 8;
            *(u32x4*)(op) = pack8(kq); *(u32x4*)(op + 512) = pack8(o[0]); *(u32x4*)(op + 1024) = pack8(o[1]); *(u32x4*)(op + 1536) = pack8(o[2]); }
    }
}

#define SBAR() __builtin_amdgcn_sched_barrier(0)
__device__ __forceinline__ int crow(int r, int hi) { return (r & 3) + 8 * (r >> 2) + 4 * hi; }
__device__ __forceinline__ int v_st(int k, int c) { const int kk = (k & ~0xC) | ((k & 4) << 1) | ((k & 8) >> 1); return ((kk >> 3) * 4 + (c >> 5)) * 512 + ((kk & 7) * 32 + (c & 31)) * 2; }
__device__ __forceinline__ int v_rd_base(int lane) { return ((lane & 3) << 3) | (((lane >> 2) & 3) << 6) | (((lane >> 4) & 1) << 5) | (((lane >> 5) & 1) << 8); }
constexpr int v_rd_off(int d0, int ks, int half) { return d0 * 512 + ks * 4096 + half * 2048; }
template <int OFF> __device__ __forceinline__ s16x4 tr_read(int vb) {
    s16x4 r; asm volatile("ds_read_b64_tr_b16 %0, %1 offset:%2" : "=&v"(r) : "v"(vb), "i"(OFF) : "memory"); return r;
}
template <int D0> __device__ __forceinline__ void pv_one(f32x16& od, int vb, bf16x8 pa0, bf16x8 pa1, bf16x8 pa2, bf16x8 pa3) {
    const s16x4 l0 = tr_read<v_rd_off(D0, 0, 0)>(vb), h0 = tr_read<v_rd_off(D0, 0, 1)>(vb), l1 = tr_read<v_rd_off(D0, 1, 0)>(vb), h1 = tr_read<v_rd_off(D0, 1, 1)>(vb);
    const s16x4 l2 = tr_read<v_rd_off(D0, 2, 0)>(vb), h2 = tr_read<v_rd_off(D0, 2, 1)>(vb), l3 = tr_read<v_rd_off(D0, 3, 0)>(vb), h3 = tr_read<v_rd_off(D0, 3, 1)>(vb);
    asm volatile("s_waitcnt lgkmcnt(0)" ::: "memory"); SBAR();
#define PK(L, H) (bf16x8){L[0], L[1], L[2], L[3], H[0], H[1], H[2], H[3]}
    od = __builtin_amdgcn_mfma_f32_32x32x16_bf16(pa0, PK(l0, h0), od, 0, 0, 0);
    od = __builtin_amdgcn_mfma_f32_32x32x16_bf16(pa1, PK(l1, h1), od, 0, 0, 0);
    od = __builtin_amdgcn_mfma_f32_32x32x16_bf16(pa2, PK(l2, h2), od, 0, 0, 0);
    od = __builtin_amdgcn_mfma_f32_32x32x16_bf16(pa3, PK(l3, h3), od, 0, 0, 0);
#undef PK
}

namespace att {
constexpr int SHM_V = 16384, SHM_K = 8192, OFF_K = 2 * SHM_V, OFF_WS = OFF_K + 2 * SHM_K;
#define KSWZ(row, colB) ((row) * 128 + ((colB) ^ (((row) & 7) << 4)))
__device__ __forceinline__ void qkt(f32x16& p0, f32x16& p1, const char* Ks, const bf16x8* qr, int r32, int hi) {
    p0 = f32x16{}; p1 = f32x16{};
#pragma unroll
    for (int d0 = 0; d0 < 4; ++d0) { const int cb = (d0 * 16 + hi * 8) * 2;
        const bf16x8 b0 = *reinterpret_cast<const bf16x8*>(Ks + KSWZ(r32, cb));
        const bf16x8 b1 = *reinterpret_cast<const bf16x8*>(Ks + KSWZ(32 + r32, cb));
        p0 = __builtin_amdgcn_mfma_f32_32x32x16_bf16(b0, qr[d0], p0, 0, 0, 0);
        p1 = __builtin_amdgcn_mfma_f32_32x32x16_bf16(b1, qr[d0], p1, 0, 0, 0); }
}
__device__ __forceinline__ void partialSM(f32x16& p0) {
#pragma unroll
    for (int r = 0; r < 16; ++r) p0[r] = __builtin_amdgcn_exp2f(p0[r]);
}
__device__ __forceinline__ void finishSM(f32x16& p0, f32x16& p1, float& l_reg, bf16x8& pa0, bf16x8& pa1, bf16x8& pa2, bf16x8& pa3) {
#pragma unroll
    for (int r = 0; r < 16; ++r) p1[r] = __builtin_amdgcn_exp2f(p1[r]);
    float ps = 0.f;
#pragma unroll
    for (int r = 0; r < 16; ++r) ps += p0[r];
#pragma unroll
    for (int r = 0; r < 16; ++r) ps += p1[r];
    l_reg += ps;
#define PK4(P, BASE, OUT) do { unsigned a0 = cvt_pk_bf16(P[BASE + 0], P[BASE + 1]), a1 = cvt_pk_bf16(P[BASE + 2], P[BASE + 3]);   \
    unsigned b0 = cvt_pk_bf16(P[BASE + 4], P[BASE + 5]), b1 = cvt_pk_bf16(P[BASE + 6], P[BASE + 7]);                              \
    auto r0 = __builtin_amdgcn_permlane32_swap(a0, b0, false, false); auto r1 = __builtin_amdgcn_permlane32_swap(a1, b1, false, false); \
    u32x4 w = {r0[0], r1[0], r0[1], r1[1]}; OUT = *reinterpret_cast<bf16x8*>(&w); } while (0)
    PK4(p0, 0, pa0); PK4(p0, 8, pa1); PK4(p1, 0, pa2); PK4(p1, 8, pa3);
#undef PK4
}
__device__ __forceinline__ void pv_d0(f32x16* o, int vb, bf16x8 pa0, bf16x8 pa1, bf16x8 pa2, bf16x8 pa3) {
    pv_one<0>(o[0], vb, pa0, pa1, pa2, pa3); pv_one<1>(o[1], vb, pa0, pa1, pa2, pa3); pv_one<2>(o[2], vb, pa0, pa1, pa2, pa3); pv_one<3>(o[3], vb, pa0, pa1, pa2, pa3);
}
constexpr int RSK = 272;
constexpr int SHM_K2 = 64 * RSK, OFF_K2 = 2 * SHM_V, OFF_Q2 = OFF_K2 + 2 * SHM_K2, OFF_WS2 = OFF_Q2 + 65536;
template <int S, int HALF_> __device__ __forceinline__ void qkt2(f32x16& p, const char* kr_, const char* qp_) {
    p = f32x16{};
#pragma unroll
    for (int d0 = 0; d0 < 4; ++d0) {
        const bf16x8 b0 = *reinterpret_cast<const bf16x8*>(kr_ + HALF_ * 32 * RSK + S * 128 + d0 * 32);
        const bf16x8 q = *reinterpret_cast<const bf16x8*>(qp_ + (S * 4 + d0) * 1024);
        p = __builtin_amdgcn_mfma_f32_32x32x16_bf16(b0, q, p, 0, 0, 0); }
}
template <int D0, int KH> __device__ __forceinline__ void pv_two(f32x16& oa, f32x16& ob, int vb, bf16x8 pa0, bf16x8 pa1, bf16x8 pb0, bf16x8 pb1) {
    const s16x4 l0 = tr_read<v_rd_off(D0, 2 * KH, 0)>(vb), h0 = tr_read<v_rd_off(D0, 2 * KH, 1)>(vb), l1 = tr_read<v_rd_off(D0, 2 * KH + 1, 0)>(vb), h1 = tr_read<v_rd_off(D0, 2 * KH + 1, 1)>(vb);
    asm volatile("s_waitcnt lgkmcnt(0)" ::: "memory"); SBAR();
#define PK(L, H) (bf16x8){L[0], L[1], L[2], L[3], H[0], H[1], H[2], H[3]}
    const bf16x8 v0 = PK(l0, h0), v1 = PK(l1, h1);
#undef PK
    oa = __builtin_amdgcn_mfma_f32_32x32x16_bf16(pa0, v0, oa, 0, 0, 0); ob = __builtin_amdgcn_mfma_f32_32x32x16_bf16(pb0, v0, ob, 0, 0, 0);
    oa = __builtin_amdgcn_mfma_f32_32x32x16_bf16(pa1, v1, oa, 0, 0, 0); ob = __builtin_amdgcn_mfma_f32_32x32x16_bf16(pb1, v1, ob, 0, 0, 0);
}
__device__ __forceinline__ void attn_unit(ArgP a, int l, int unit, char* lds, const int tid_) {
    int tid = tid_; asm volatile("" : "+v"(tid));
    const int wid = tid >> 6, lane = tid & 63, r32 = lane & 31, hi = lane >> 5;
    const bf16_t* Kb = (const bf16_t*)(a->ws + WS_KB); const bf16_t* Qb = (const bf16_t*)(a->ws + WS_QB); const bf16_t* Vb = (const bf16_t*)(a->ws + WS_VB);
    int b, h, qrow0, t0, NT;
    if (unit < 256) { b = unit >> 6; h = (unit >> 4) & 3; qrow0 = b * 4096 + (unit & 15) * 256; t0 = 0; NT = 68; }
    else { const int cu = unit - 256; b = cu >> 2; h = cu & 3; qrow0 = ML + b * 256; t0 = 64; NT = 4; }
    char* V_lds = lds; char* K_lds = lds + OFF_K2;
    char* qp = lds + OFF_Q2 + wid * 8192 + lane * 16;
    {   const bf16_t* Qw = Qb + (size_t)(qrow0 + wid * 32 + r32) * 512 + h * 128 + hi * 8;
#pragma unroll
        for (int f = 0; f < 8; ++f) *reinterpret_cast<bf16x8*>(qp + f * 1024) = *reinterpret_cast<const bf16x8*>(Qw + (f >> 2) * 64 + (f & 3) * 16); }
    const int kr = tid >> 3, kc = tid & 7;
    const int sr = tid >> 4, sc = (tid & 15) * 8, vst0 = v_st(sr, sc), vst1 = v_st(32 + sr, sc);
    const int vb0 = (int)(uintptr_t)V_lds + v_rd_base(lane);
    const int kst = kr * RSK + kc * 32;
    const char* krd = K_lds + r32 * RSK + hi * 16;
    bf16x8 s_v0, s_v1, s_k0, s_k1;
#define TROW(t) ((t) < 64 ? (size_t)b * 4096 + (size_t)(t) * 64 : (size_t)ML + (size_t)b * 256 + (size_t)((t) - 64) * 64)
    const unsigned voff_ = (unsigned)(sr * 512 + h * 128 + sc) * 2u, koff_ = (unsigned)(kr * 1024 + h * 256 + kc * 32);
#define SLOAD(t) do { const size_t r0_ = TROW(t) * 1024; const char* vt_ = (const char*)Vb + r0_; const char* kt_ = (const char*)Kb + r0_; \
    s_v0 = *reinterpret_cast<const bf16x8*>(vt_ + voff_); s_v1 = *reinterpret_cast<const bf16x8*>(vt_ + 32768 + voff_); \
    s_k0 = *reinterpret_cast<const bf16x8*>(kt_ + koff_); s_k1 = *reinterpret_cast<const bf16x8*>(kt_ + koff_ + 16); } while (0)
#define SWRITE(bb) do { *(bf16x8*)(V_lds + (bb) * SHM_V + vst0) = s_v0; *(bf16x8*)(V_lds + (bb) * SHM_V + vst1) = s_v1; \
    *(bf16x8*)(K_lds + (bb) * SHM_K2 + kst) = s_k0; *(bf16x8*)(K_lds + (bb) * SHM_K2 + kst + 16) = s_k1; } while (0)
#define EXPSUM(L_) do { float ps_ = 0.f; _Pragma("unroll") for (int r_ = 0; r_ < 16; ++r_) { p[r_] = __builtin_amdgcn_exp2f(p[r_]); ps_ += p[r_]; } L_ += ps_; } while (0)
#define PK4(P, BASE, OUT) do { unsigned a0 = cvt_pk_bf16(P[BASE + 0], P[BASE + 1]), a1 = cvt_pk_bf16(P[BASE + 2], P[BASE + 3]);   \
    unsigned b0 = cvt_pk_bf16(P[BASE + 4], P[BASE + 5]), b1 = cvt_pk_bf16(P[BASE + 6], P[BASE + 7]);                              \
    auto r0 = __builtin_amdgcn_permlane32_swap(a0, b0, false, false); auto r1 = __builtin_amdgcn_permlane32_swap(a1, b1, false, false); \
    u32x4 w = {r0[0], r1[0], r0[1], r1[1]}; OUT = *reinterpret_cast<bf16x8*>(&w); } while (0)
    f32x16 o0[4] = {}, o1[4] = {}; float l0 = 0.f, l1 = 0.f;
    SLOAD(t0); SWRITE(0); __syncthreads();
    if (1 < NT) SLOAD(t0 + 1);
#pragma nounroll
    for (int j = 0; j < NT; ++j) {
        int bb = j & 1; asm volatile("" : "+s"(bb));
        SBAR();
        const char* ks_ = krd + bb * SHM_K2; const int vb_ = vb0 + bb * SHM_V;
        {   f32x16 p; bf16x8 pa0, pa1, pb0, pb1;
            qkt2<0, 0>(p, ks_, qp); EXPSUM(l0); PK4(p, 0, pa0); PK4(p, 8, pa1); SBAR();
            qkt2<1, 0>(p, ks_, qp); EXPSUM(l1); PK4(p, 0, pb0); PK4(p, 8, pb1); SBAR();
            pv_two<0, 0>(o0[0], o1[0], vb_, pa0, pa1, pb0, pb1); pv_two<1, 0>(o0[1], o1[1], vb_, pa0, pa1, pb0, pb1); pv_two<2, 0>(o0[2], o1[2], vb_, pa0, pa1, pb0, pb1); pv_two<3, 0>(o0[3], o1[3], vb_, pa0, pa1, pb0, pb1); }
        SBAR();
        if (j + 1 < NT) { SWRITE(bb ^ 1); if (j + 2 < NT) SLOAD(t0 + j + 2); }
        SBAR();
        {   f32x16 p; bf16x8 pa0, pa1, pb0, pb1;
            qkt2<0, 1>(p, ks_, qp); EXPSUM(l0); PK4(p, 0, pa0); PK4(p, 8, pa1); SBAR();
            qkt2<1, 1>(p, ks_, qp); EXPSUM(l1); PK4(p, 0, pb0); PK4(p, 8, pb1); SBAR();
            pv_two<0, 1>(o0[0], o1[0], vb_, pa0, pa1, pb0, pb1); pv_two<1, 1>(o0[1], o1[1], vb_, pa0, pa1, pb0, pb1); pv_two<2, 1>(o0[2], o1[2], vb_, pa0, pa1, pb0, pb1); pv_two<3, 1>(o0[3], o1[3], vb_, pa0, pa1, pb0, pb1); }
        __syncthreads();
    }
#undef TROW
#undef SLOAD
#undef SWRITE
#undef EXPSUM
#undef PK4
    int tid2 = tid_; asm volatile("" : "+v"(tid2));
    const int wid2 = tid2 >> 6, lane2 = tid2 & 63, r32e = lane2 & 31, hie = lane2 >> 5;
    { auto rr = __builtin_amdgcn_permlane32_swap(__float_as_uint(l0), __float_as_uint(l0), false, false); l0 = __uint_as_float(rr[0]) + __uint_as_float(rr[1]); }
    { auto rr = __builtin_amdgcn_permlane32_swap(__float_as_uint(l1), __float_as_uint(l1), false, false); l1 = __uint_as_float(rr[0]) + __uint_as_float(rr[1]); }
    const bf16_t* Z = (const bf16_t*)(a->ws + WS_Z); bf16_t* Y = (bf16_t*)(a->ws + WS_QB);
    const float* SCAL = (const float*)(a->ws + WS_SCAL) + l * 8;
    const float lam = SCAL[0], oml = SCAL[2];
    const float* sg = a->in[15] + l * 128;
    float* li_l = (float*)(lds + OFF_WS2) + wid2 * 128;
    if (hie == 0) { li_l[r32e] = l0; li_l[64 + r32e] = l1; } asm volatile("s_waitcnt lgkmcnt(0)" ::: "memory");
    float ss[16];
#pragma unroll
    for (int r = 0; r < 16; ++r) { const float ra = __builtin_amdgcn_rcpf(li_l[crow(r, hie)]), rb_ = lam * __builtin_amdgcn_rcpf(li_l[64 + crow(r, hie)]); float s = 0.f;
#pragma unroll
        for (int d0 = 0; d0 < 4; ++d0) { const float v = o0[d0][r] * ra - o1[d0][r] * rb_; o0[d0][r] = v; s += v * v; }
        s += __shfl_xor(s, 1); s += __shfl_xor(s, 2); s += __shfl_xor(s, 4); s += __shfl_xor(s, 8); s += __shfl_xor(s, 16);
        ss[r] = oml / sqrtf(s * (1.0f / 128.0f) + NORM_EPS); }
    const GAS bf16_t* Z_ = (const GAS bf16_t*)Z; GAS bf16_t* Y_ = (GAS bf16_t*)Y;
#pragma unroll
    for (int d0 = 0; d0 < 4; ++d0) { const int col = h * 128 + d0 * 32 + r32e; const float g = sg[d0 * 32 + r32e];
        const size_t rb = (size_t)(qrow0 + wid2 * 32 + 4 * hie) * 1536 + 512 + col, yb_ = (size_t)(qrow0 + wid2 * 32 + 4 * hie) * 512 + col;
        unsigned short zq[16];
#pragma unroll
        for (int r = 0; r < 16; ++r) zq[r] = Z_[rb + (size_t)((r & 3) + 8 * (r >> 2)) * 1536];
#pragma unroll
        for (int r = 0; r < 16; ++r) { const size_t idx = yb_ + (size_t)((r & 3) + 8 * (r >> 2)) * 512;
            const float y = o0[d0][r] * ss[r] * g * bf2f(zq[r]);
            Y_[idx] = (bf16_t)(cvt_pk_bf16(y, 0.f) & 0xffffu); }
        asm volatile("" ::: "memory"); }
    asm volatile("s_waitcnt vmcnt(0) lgkmcnt(0)" ::: "memory");
    __syncthreads();
}
}

__device__ __forceinline__ void gmlp_unit(ArgP a, int l, int unit, char* lds, const int tid) {
    const int wid = tid >> 6, lane = tid & 63, r32 = lane & 31, hi = lane >> 5;
    const int chunk = unit >> 2, g = unit & 3; const size_t row0 = (size_t)chunk * 128;
    const bf16_t* VA = (const bf16_t*)(a->ws + WS_VA); const bf16_t* GU = (const bf16_t*)(a->ws + WS_GU); const bf16_t* Z = (const bf16_t*)(a->ws + WS_Z); bf16_t* Y = (bf16_t*)(a->ws + WS_RW);
    const float* Ws = a->in[10] + ((size_t)l * 4 + g) * 128 * 128; const float* bs = a->in[11] + (l * 4 + g) * 128;
    const int sr = tid >> 4, sc = (tid & 15) * 8;
#pragma unroll
    for (int t = 0; t < 2; ++t) {
        const bf16x8 v0 = *reinterpret_cast<const bf16x8*>(VA + (row0 + t * 64 + sr) * 512 + g * 128 + sc);
        const bf16x8 v1 = *reinterpret_cast<const bf16x8*>(VA + (row0 + t * 64 + 32 + sr) * 512 + g * 128 + sc);
        *(bf16x8*)(lds + t * 16384 + v_st(sr, sc)) = v0; *(bf16x8*)(lds + t * 16384 + v_st(32 + sr, sc)) = v1; }
    __syncthreads();
    const int pb = (wid & 3) * 32, ch = wid >> 2;
    const int vb0 = (int)(uintptr_t)lds + v_rd_base(lane);
    f32x16 o0 = {}, o1 = {};
#pragma unroll
    for (int t = 0; t < 2; ++t) {
        bf16x8 pa[4];
#pragma unroll
        for (int ks = 0; ks < 4; ++ks) { const float* wp = Ws + (size_t)(pb + r32) * 128 + t * 64 + ks * 16 + hi * 8;
            const f32x4 w0 = *(const f32x4*)wp, w1 = *(const f32x4*)(wp + 4);
            u32x4 w = {cvt_pk_bf16(w0.x, w0.y), cvt_pk_bf16(w0.z, w0.w), cvt_pk_bf16(w1.x, w1.y), cvt_pk_bf16(w1.z, w1.w)}; pa[ks] = *reinterpret_cast<bf16x8*>(&w); }
        if (ch == 0) { pv_one<0>(o0, vb0 + t * 16384, pa[0], pa[1], pa[2], pa[3]); pv_one<1>(o1, vb0 + t * 16384, pa[0], pa[1], pa[2], pa[3]); }
        else         { pv_one<2>(o0, vb0 + t * 16384, pa[0], pa[1], pa[2], pa[3]); pv_one<3>(o1, vb0 + t * 16384, pa[0], pa[1], pa[2], pa[3]); }
    }
    {   unsigned short gq[32], zq[32]; float bq[16];
#pragma unroll
        for (int r = 0; r < 16; ++r) { const int p = pb + crow(r, hi); bq[r] = bs[p]; const size_t row = row0 + p;
#pragma unroll
            for (int d = 0; d < 2; ++d) { const int col = g * 128 + ch * 64 + d * 32 + r32; gq[2 * r + d] = GU[row * 512 + col]; zq[2 * r + d] = Z[row * 1536 + col]; } }
#pragma unroll
        for (int r = 0; r < 16; ++r) { const int p = pb + crow(r, hi); const size_t row = row0 + p;
#pragma unroll
            for (int d = 0; d < 2; ++d) { const int col = g * 128 + ch * 64 + d * 32 + r32;
                const float s = (d == 0 ? o0[r] : o1[r]) + bq[r];
                const float y = bf2f(gq[2 * r + d]) * s * bf2f(zq[2 * r + d]);
                Y[row * 1536 + col] = (bf16_t)(cvt_pk_bf16(y, 0.f) & 0xffffu); } } }
    __syncthreads();
}

template <int CTRL> __device__ __forceinline__ float dppf(float v) { return __builtin_bit_cast(float, __builtin_amdgcn_update_dpp(0, __builtin_bit_cast(int, v), CTRL, 0xF, 0xF, true)); }
__device__ __forceinline__ float allreduce16(float x) { x += dppf<0xB1>(x); x += dppf<0x4E>(x); x += dppf<0x141>(x); x += dppf<0x140>(x); return x; }
namespace scanc {
constexpr int CS = 16, NBLK = (256 + 4096) / CS;
constexpr int RS = 144;
constexpr int O_AK = 0, O_KHB = 32 * RS, O_V = 64 * RS, O_T = 80 * RS, O_X = O_T + 1024, O_BK = O_X + 1024, O_NBB = O_BK + 1024, O_GC = O_NBB + 1024, O_F = O_GC + 256, SLOT = O_F + 2048, NSLOT = 6;
constexpr int O_CTL = NSLOT * SLOT;
__device__ __forceinline__ int perm16(int m) { return 8 * ((m >> 2) & 1) + 4 * (m >> 3) + (m & 3); }
__device__ __forceinline__ bf16x8 pack_tile8(const f32x16& x, int base) {
    u32x4 w = {cvt_pk_bf16(x[base + 0], x[base + 1]), cvt_pk_bf16(x[base + 2], x[base + 3]), cvt_pk_bf16(x[base + 4], x[base + 5]), cvt_pk_bf16(x[base + 6], x[base + 7])};
    return __builtin_bit_cast(bf16x8, w);
}
__device__ __forceinline__ unsigned short f2bf_s(float f) { return (unsigned short)(cvt_pk_bf16(f, 0.f) & 0xffffu); }
constexpr int O_ID = O_CTL + 1024;
__device__ __forceinline__ void scan_unit(ArgP a, int l, int chain, LAS char* lds, const int tid, unsigned* ctxflag) {
    const int wid = __builtin_amdgcn_readfirstlane(tid >> 6), lane = tid & 63, r32 = lane & 31, hi = lane >> 5;
    const int d = chain >> 5, b = (chain >> 3) & 3, h = chain & 7;
    const bf16_t* RWP = (const bf16_t*)(a->ws + WS_RWP); const bf16_t* WA = (const bf16_t*)(a->ws + WS_WA); bf16_t* YD = (bf16_t*)(a->ws + WS_YD) + (size_t)d * MT * 512;
    volatile LAS unsigned* ctl = (volatile LAS unsigned*)(lds + O_CTL);
    if (tid < 8) ctl[tid] = 0u;
    *(LAS float*)(lds + O_ID + (tid >> 5) * 128 + (tid & 31) * 4) = (tid >> 5) == (tid & 31) ? 1.0f : 0.f;
    __syncthreads();
#define ROWOF(s) ((s) < 256 ? (size_t)ML + (size_t)b * 256 + (size_t)(d ? 255 - (s) : (s)) : (size_t)b * 4096 + (size_t)(d ? 4095 - ((s) - 256) : (s) - 256))
    if (wid >= 2) {
        const int sw = wid - 2; LAS char* sl = lds + sw * SLOT;
        const int st = lane & 15, cq = lane >> 4, ps = perm16(st);
        const float* kap = a->in[22] + l * 512 + h * 64 + cq * 16;
        const f32x4 ka0 = *(const f32x4*)kap, ka1 = *(const f32x4*)(kap + 4), ka2 = *(const f32x4*)(kap + 8), ka3 = *(const f32x4*)(kap + 12);
        const int hig = lane >> 5, jj = (r32 & 15) - 4 * hig;
        const int goff = O_F + hig * 512 + r32 * 4;
        const int boff = (r32 < 16 ? O_BK + (r32 & 15) * 2 : O_NBB + perm16(r32 & 15) * 2) + hig * 128;
        const int sc_ = lane & 15; const bool isT = lane < 16;
        const int ooff = isT ? O_T + perm16(sc_) * 2 : O_X + sc_ * 2;
        u32x4 W[12];
#define LOADRAW(bb_) do { const size_t rw = ROWOF((bb_) * CS + st); const bf16_t* p = RWP + rw * 2048 + h * 64 + cq * 16; const bf16_t* q = WA + rw * 2048 + d * 512 + h * 64 + cq * 16; \
            W[0] = *(const u32x4*)p; W[1] = *(const u32x4*)(p + 8); W[2] = *(const u32x4*)(p + 512); W[3] = *(const u32x4*)(p + 520); W[4] = *(const u32x4*)(p + 1024); W[5] = *(const u32x4*)(p + 1032); \
            W[6] = *(const u32x4*)(p + 1536); W[7] = *(const u32x4*)(p + 1544); W[8] = *(const u32x4*)q; W[9] = *(const u32x4*)(q + 8); W[10] = *(const u32x4*)(q + 1024); W[11] = *(const u32x4*)(q + 1032); } while (0)
        LOADRAW(sw);
        for (int bi = sw; bi < NBLK; bi += NSLOT) {
            if (bi >= NSLOT) { const unsigned need = (unsigned)(bi - NSLOT + 1); while (ctl[6] < need || ctl[7] < need) __builtin_amdgcn_s_sleep(1); }
            asm volatile("" ::: "memory");
            {
                *(LAS u32x4*)(sl + O_V + st * RS + cq * 32) = W[4]; *(LAS u32x4*)(sl + O_V + st * RS + cq * 32 + 16) = W[5];
                float kk[16], kx[16], rr[16], om[16], aa[16];
                unpack8(W[0], *(float(*)[8])&kk[0]); unpack8(W[1], *(float(*)[8])&kk[8]); unpack8(W[2], *(float(*)[8])&kx[0]); unpack8(W[3], *(float(*)[8])&kx[8]);
                unpack8(W[6], *(float(*)[8])&rr[0]); unpack8(W[7], *(float(*)[8])&rr[8]);
                unpack8(W[8], *(float(*)[8])&om[0]); unpack8(W[9], *(float(*)[8])&om[8]); unpack8(W[10], *(float(*)[8])&aa[0]); unpack8(W[11], *(float(*)[8])&aa[8]);
                { const int bn = bi + NSLOT < NBLK ? bi + NSLOT : NBLK - 1; LOADRAW(bn); }
                unsigned ktp[8], rtp[8], khp[8], bhp[8]; float G[16];
#pragma unroll
                for (int c = 0; c < 16; ++c) G[c] = 1.0f - om[c];
#define DPPL(S) "v_mul_f32_dpp %0, %0, %0 " S " row_mask:0xf bank_mask:0xf\n v_mul_f32_dpp %1, %1, %1 " S " row_mask:0xf bank_mask:0xf\n v_mul_f32_dpp %2, %2, %2 " S " row_mask:0xf bank_mask:0xf\n v_mul_f32_dpp %3, %3, %3 " S " row_mask:0xf bank_mask:0xf\n" \
                "v_mul_f32_dpp %4, %4, %4 " S " row_mask:0xf bank_mask:0xf\n v_mul_f32_dpp %5, %5, %5 " S " row_mask:0xf bank_mask:0xf\n v_mul_f32_dpp %6, %6, %6 " S " row_mask:0xf bank_mask:0xf\n v_mul_f32_dpp %7, %7, %7 " S " row_mask:0xf bank_mask:0xf\n" \
                "v_mul_f32_dpp %8, %8, %8 " S " row_mask:0xf bank_mask:0xf\n v_mul_f32_dpp %9, %9, %9 " S " row_mask:0xf bank_mask:0xf\n v_mul_f32_dpp %10, %10, %10 " S " row_mask:0xf bank_mask:0xf\n v_mul_f32_dpp %11, %11, %11 " S " row_mask:0xf bank_mask:0xf\n" \
                "v_mul_f32_dpp %12, %12, %12 " S " row_mask:0xf bank_mask:0xf\n v_mul_f32_dpp %13, %13, %13 " S " row_mask:0xf bank_mask:0xf\n v_mul_f32_dpp %14, %14, %14 " S " row_mask:0xf bank_mask:0xf\n v_mul_f32_dpp %15, %15, %15 " S " row_mask:0xf bank_mask:0xf\n"
                asm volatile("s_nop 1\n" DPPL("row_shr:1") DPPL("row_shr:2") DPPL("row_shr:4") DPPL("row_shr:8") "s_nop 1\n"
                    : "+v"(G[0]), "+v"(G[1]), "+v"(G[2]), "+v"(G[3]), "+v"(G[4]), "+v"(G[5]), "+v"(G[6]), "+v"(G[7]), "+v"(G[8]), "+v"(G[9]), "+v"(G[10]), "+v"(G[11]), "+v"(G[12]), "+v"(G[13]), "+v"(G[14]), "+v"(G[15]));
#undef DPPL
#pragma unroll
                for (int m = 0; m < 8; ++m) { float v4[8];
#pragma unroll
                    for (int e = 0; e < 2; ++e) { const int c = 2 * m + e; const float g = G[c];
                        const float gp = __builtin_bit_cast(float, __builtin_amdgcn_update_dpp(0x3f800000, __builtin_bit_cast(int, g), 0x111, 0xF, 0xF, false));
                        const float ig = __builtin_amdgcn_rcpf(g);
                        const float kac = c < 4 ? ka0[c & 3] : c < 8 ? ka1[c & 3] : c < 12 ? ka2[c & 3] : ka3[c & 3];
                        const float kd = kx[c] * (1.0f + (aa[c] - 1.0f) * kac), be = kk[c] * aa[c];
                        v4[e] = kk[c] * gp; v4[2 + e] = rr[c] * g; v4[4 + e] = kd * ig; v4[6 + e] = be * ig; }
                    ktp[m] = cvt_pk_bf16(v4[0], v4[1]); rtp[m] = cvt_pk_bf16(v4[2], v4[3]); khp[m] = cvt_pk_bf16(v4[4], v4[5]); bhp[m] = cvt_pk_bf16(v4[6], v4[7]); }
                *(LAS u32x4*)(sl + O_AK + st * RS + cq * 32) = (u32x4){ktp[0], ktp[1], ktp[4], ktp[5]}; *(LAS u32x4*)(sl + O_AK + st * RS + cq * 32 + 16) = (u32x4){ktp[2], ktp[3], ktp[6], ktp[7]};
                *(LAS u32x4*)(sl + O_AK + (16 + st) * RS + cq * 32) = (u32x4){rtp[0], rtp[1], rtp[4], rtp[5]}; *(LAS u32x4*)(sl + O_AK + (16 + st) * RS + cq * 32 + 16) = (u32x4){rtp[2], rtp[3], rtp[6], rtp[7]};
                *(LAS u32x4*)(sl + O_KHB + st * RS + cq * 32) = (u32x4){khp[0], khp[1], khp[2], khp[3]}; *(LAS u32x4*)(sl + O_KHB + st * RS + cq * 32 + 16) = (u32x4){khp[4], khp[5], khp[6], khp[7]};
                *(LAS u32x4*)(sl + O_KHB + (16 + st) * RS + cq * 32) = (u32x4){bhp[0] ^ 0x80008000u, bhp[1] ^ 0x80008000u, bhp[2] ^ 0x80008000u, bhp[3] ^ 0x80008000u};
                *(LAS u32x4*)(sl + O_KHB + (16 + st) * RS + cq * 32 + 16) = (u32x4){bhp[4] ^ 0x80008000u, bhp[5] ^ 0x80008000u, bhp[6] ^ 0x80008000u, bhp[7] ^ 0x80008000u};
                if (st == 15) {
                    *(LAS f32x4*)(sl + O_GC + cq * 64) = (f32x4){G[0], G[1], G[2], G[3]}; *(LAS f32x4*)(sl + O_GC + cq * 64 + 16) = (f32x4){G[4], G[5], G[6], G[7]};
                    *(LAS f32x4*)(sl + O_GC + cq * 64 + 32) = (f32x4){G[8], G[9], G[10], G[11]}; *(LAS f32x4*)(sl + O_GC + cq * 64 + 48) = (f32x4){G[12], G[13], G[14], G[15]}; }
            }
            asm volatile("s_waitcnt lgkmcnt(0)" ::: "memory");
            f32x16 gr = {};
            {   const LAS char* ga = sl + O_AK + r32 * RS + hig * 16; const LAS char* gb = sl + O_KHB + r32 * RS + hig * 8;
                bf16x8 fa[4]; u32x2 fl[4], fh[4];
#pragma unroll
                for (int q = 0; q < 4; ++q) { fa[q] = *(const LAS bf16x8*)(ga + q * 32); fl[q] = *(const LAS u32x2*)(gb + q * 32); fh[q] = *(const LAS u32x2*)(gb + q * 32 + 16); }
#pragma unroll
                for (int q = 0; q < 4; ++q) { const u32x4 fb = {fl[q][0], fl[q][1], fh[q][0], fh[q][1]};
                    gr = __builtin_amdgcn_mfma_f32_32x32x16_bf16(fa[q], __builtin_bit_cast(bf16x8, fb), gr, 0, 0, 0); } }
#pragma unroll
            for (int r = 0; r < 16; ++r) { const int cr = (r & 3) + 8 * (r >> 2);
                const bool keep = r < 8 ? (jj < cr) : (jj <= cr - 16); const float g = keep ? gr[r] : 0.f;
                if (r < 8) *(LAS float*)(sl + goff + cr * 128) = g;
                else *(LAS unsigned short*)(sl + boff + (cr - 16) * 32) = f2bf_s(g); }
            asm volatile("s_waitcnt lgkmcnt(0)" ::: "memory");
            if (lane < 32) { const LAS char* rhs = isT ? lds + O_ID + sc_ * 4 : sl + O_F + sc_ * 4; float t[CS];
#pragma unroll
                for (int i = 0; i < CS; ++i) t[i] = *(const LAS float*)(rhs + i * 128);
#define ABQ(i, q) (*(const LAS f32x4*)(sl + O_F + (i) * 128 + 64 + (q) * 16))
#define SROW(i, Q0, Q1, Q2, Q3) do { const f32x4 qq_[4] = {Q0, Q1, Q2, Q3}; f32x2 acc2 = {t[i], 0.f}; \
                    _Pragma("unroll") for (int j = 0; j + 1 < (i); j += 2) acc2 += (f32x2){qq_[j >> 2][j & 3], qq_[(j + 1) >> 2][(j + 1) & 3]} * (f32x2){t[j], t[j + 1]}; \
                    float acc = acc2[0] + acc2[1]; if ((i) & 1) acc += qq_[((i) - 1) >> 2][((i) - 1) & 3] * t[(i) - 1]; t[i] = acc; } while (0)
                {   const f32x4 a1 = ABQ(1, 0), a2 = ABQ(2, 0), a3 = ABQ(3, 0), a4 = ABQ(4, 0), a50 = ABQ(5, 0), a51 = ABQ(5, 1), a60 = ABQ(6, 0), a61 = ABQ(6, 1), a70 = ABQ(7, 0), a71 = ABQ(7, 1), a80 = ABQ(8, 0), a81 = ABQ(8, 1);
                    SBAR();
                    SROW(1, a1, a1, a1, a1); SROW(2, a2, a2, a2, a2); SROW(3, a3, a3, a3, a3); SROW(4, a4, a4, a4, a4);
                    SROW(5, a50, a51, a51, a51); SROW(6, a60, a61, a61, a61); SROW(7, a70, a71, a71, a71); SROW(8, a80, a81, a81, a81); }
                SBAR();
                {   const f32x4 a90 = ABQ(9, 0), a91 = ABQ(9, 1), a92 = ABQ(9, 2), aa0 = ABQ(10, 0), aa1 = ABQ(10, 1), aa2 = ABQ(10, 2), ab0 = ABQ(11, 0), ab1 = ABQ(11, 1), ab2 = ABQ(11, 2), ac0 = ABQ(12, 0), ac1 = ABQ(12, 1), ac2 = ABQ(12, 2);
                    SBAR();
                    SROW(9, a90, a91, a92, a92); SROW(10, aa0, aa1, aa2, aa2); SROW(11, ab0, ab1, ab2, ab2); SROW(12, ac0, ac1, ac2, ac2); }
                SBAR();
                {   const f32x4 ad0 = ABQ(13, 0), ad1 = ABQ(13, 1), ad2 = ABQ(13, 2), ad3 = ABQ(13, 3), ae0 = ABQ(14, 0), ae1 = ABQ(14, 1), ae2 = ABQ(14, 2), ae3 = ABQ(14, 3), af0 = ABQ(15, 0), af1 = ABQ(15, 1), af2 = ABQ(15, 2), af3 = ABQ(15, 3);
                    SBAR();
                    SROW(13, ad0, ad1, ad2, ad3); SROW(14, ae0, ae1, ae2, ae3); SROW(15, af0, af1, af2, af3); }
#undef SROW
#undef ABQ
#pragma unroll
                for (int i = 0; i < CS; ++i) *(LAS unsigned short*)(sl + ooff + i * 32) = f2bf_s(t[i]); }
            asm volatile("s_waitcnt lgkmcnt(0)" ::: "memory");
            if (lane == 0) ctl[sw] = (unsigned)(bi + 1);
        }
    } else {
        f32x16 Z0 = {}, Z1 = {};
        const int rho = wid * 32 + r32;
        const int trb = (int)(uintptr_t)lds + ((lane >> 2) & 3) * RS + (16 * ((lane >> 4) & 1) + 4 * (lane & 3)) * 2;
        const int trk = trb + 8 * hi * RS, trn = trb + 4 * hi * RS;
        const unsigned yoff = (unsigned)(((d ? 15 - 4 * hi : 4 * hi) * 512 + h * 64 + rho) * 2);
        for (int bi = 0; bi < NBLK; ++bi) {
            const int sw = bi % NSLOT; const LAS char* sl = lds + sw * SLOT;
            while (ctl[sw] != (unsigned)(bi + 1)) __builtin_amdgcn_s_sleep(1);
            asm volatile("" ::: "memory");
            const LAS char* ra = sl + r32 * RS + hi * 16; const LAS char* rb = sl + r32 * 32 + hi * 16;
            const bf16x8 ak0 = *(const LAS bf16x8*)(ra + O_AK), ak1 = *(const LAS bf16x8*)(ra + O_AK + 32), ak2 = *(const LAS bf16x8*)(ra + O_AK + 64), ak3 = *(const LAS bf16x8*)(ra + O_AK + 96);
            const bf16x8 tq = *(const LAS bf16x8*)(rb + O_T), xq = *(const LAS bf16x8*)(rb + O_X), bkq = *(const LAS bf16x8*)(rb + O_BK), nbbq = *(const LAS bf16x8*)(rb + O_NBB);
            const int tk = trk + sw * SLOT, tn = trn + sw * SLOT;
            const s16x4 kb0l = tr_read<O_KHB>(tk), kb0h = tr_read<O_KHB + 4 * RS>(tk), kb1l = tr_read<O_KHB + 64>(tk), kb1h = tr_read<O_KHB + 4 * RS + 64>(tk);
            const s16x4 nb0l = tr_read<O_KHB + 16 * RS>(tn), nb0h = tr_read<O_KHB + 24 * RS>(tn), nb1l = tr_read<O_KHB + 16 * RS + 64>(tn), nb1h = tr_read<O_KHB + 24 * RS + 64>(tn);
            const s16x4 vfl = tr_read<O_V>(tk + wid * 64), vfh = tr_read<O_V + 4 * RS>(tk + wid * 64);
            f32x4 gc0[4], gc1[4];
            {   const LAS float* gc = (const LAS float*)(sl + O_GC) + 4 * hi;
#pragma unroll
                for (int g4 = 0; g4 < 4; ++g4) { gc0[g4] = *(const LAS f32x4*)(gc + 8 * g4); gc1[g4] = *(const LAS f32x4*)(gc + 32 + 8 * g4); } }
            asm volatile("s_waitcnt lgkmcnt(0)" ::: "memory"); SBAR();
#define PK(L, H) (bf16x8){L[0], L[1], L[2], L[3], H[0], H[1], H[2], H[3]}
            const bf16x8 kb0 = PK(kb0l, kb0h), kb1 = PK(kb1l, kb1h), nb0 = PK(nb0l, nb0h), nb1 = PK(nb1l, nb1h), vf = PK(vfl, vfh);
#undef PK
            f32x16 a1 = {};
            a1 = __builtin_amdgcn_mfma_f32_32x32x16_bf16(ak0, pack_tile8(Z0, 0), a1, 0, 0, 0);
            a1 = __builtin_amdgcn_mfma_f32_32x32x16_bf16(ak1, pack_tile8(Z0, 8), a1, 0, 0, 0);
            a1 = __builtin_amdgcn_mfma_f32_32x32x16_bf16(ak2, pack_tile8(Z1, 0), a1, 0, 0, 0);
            a1 = __builtin_amdgcn_mfma_f32_32x32x16_bf16(ak3, pack_tile8(Z1, 8), a1, 0, 0, 0);
            f32x16 a2 = {};
            a2 = __builtin_amdgcn_mfma_f32_32x32x16_bf16(xq, vf, a2, 0, 0, 0);
            a2 = __builtin_amdgcn_mfma_f32_32x32x16_bf16(tq, pack_tile8(a1, 0), a2, 0, 0, 0);
            f32x16 a3 = {};
            a3 = __builtin_amdgcn_mfma_f32_32x32x16_bf16(bkq, vf, a3, 0, 0, 0);
            Z0 = __builtin_amdgcn_mfma_f32_32x32x16_bf16(kb0, vf, Z0, 0, 0, 0);
            Z1 = __builtin_amdgcn_mfma_f32_32x32x16_bf16(kb1, vf, Z1, 0, 0, 0);
            const bf16x8 sf = pack_tile8(a2, 0);
            Z0 = __builtin_amdgcn_mfma_f32_32x32x16_bf16(nb0, sf, Z0, 0, 0, 0);
            Z1 = __builtin_amdgcn_mfma_f32_32x32x16_bf16(nb1, sf, Z1, 0, 0, 0);
            a3 = __builtin_amdgcn_mfma_f32_32x32x16_bf16(nbbq, sf, a3, 0, 0, 0);
            if (lane == 0) ctl[6 + wid] = (unsigned)(bi + 1);
#pragma unroll
            for (int g4 = 0; g4 < 4; ++g4) {
#pragma unroll
                for (int e = 0; e < 4; ++e) { Z0[4 * g4 + e] *= gc0[g4][e]; Z1[4 * g4 + e] *= gc1[g4][e]; } }
            {   const int s0 = bi * CS; const int rlo = s0 < 256 ? ML + b * 256 + (d ? 240 - s0 : s0) : b * 4096 + (d ? 4080 - (s0 - 256) : s0 - 256);
                const char* yb = (const char*)YD + (size_t)rlo * 1024;
                if (bi < 16) {
#pragma unroll
                    for (int r = 0; r < 8; ++r) { const int cr = (r & 3) + 8 * (r >> 2);
                        __hip_atomic_store((unsigned short*)(yb + (d ? -cr : cr) * 1024 + yoff), f2bf_s(a3[r] + a1[8 + r]), __ATOMIC_RELAXED, __HIP_MEMORY_SCOPE_AGENT); }
                    if (bi == 15) { asm volatile("s_waitcnt vmcnt(0)" ::: "memory"); if (lane == 0) (void)__hip_atomic_fetch_add(ctxflag, 1u, __ATOMIC_RELAXED, __HIP_MEMORY_SCOPE_AGENT); }
                } else {
#pragma unroll
                    for (int r = 0; r < 8; ++r) { const int cr = (r & 3) + 8 * (r >> 2);
                        *(unsigned short*)(yb + (d ? -cr : cr) * 1024 + yoff) = f2bf_s(a3[r] + a1[8 + r]); } } }
        }
    }
#undef ROWOF
#undef LOADRAW
    __syncthreads();
}
}

__device__ __forceinline__ void phase_readout(ArgP a, int l, int lane, int m0, int m1, int gw, int NGW) {
    const bf16_t* YD = (const bf16_t*)(a->ws + WS_YD); const bf16_t* RWP = (const bf16_t*)(a->ws + WS_RWP); const bf16_t* Z = (const bf16_t*)(a->ws + WS_Z); bf16_t* Y = (bf16_t*)(a->ws + WS_RW);
    const float* lng = a->in[24] + l * 512 + lane * 8; const float* lnb = a->in[25] + l * 512 + lane * 8; const float* rk = a->in[23] + l * 512 + lane * 8;
    for (int m = m0 + gw; m < m1; m += NGW) {
        float y0[8], y1[8], k[8], v[8], r[8], zc[8];
        unpack8(*(const u32x4*)(YD + (size_t)m * 512 + lane * 8), y0); unpack8(*(const u32x4*)(YD + ((size_t)MT + m) * 512 + lane * 8), y1);
        const bf16_t* rp = RWP + (size_t)m * 2048 + lane * 8;
        unpack8(*(const u32x4*)(rp + 512), k); unpack8(*(const u32x4*)(rp + 1024), v); unpack8(*(const u32x4*)(rp + 1536), r);
        unpack8(*(const u32x4*)(Z + (size_t)m * 1536 + 1024 + lane * 8), zc);
        float s = 0.f, rks = 0.f; const f32x4 rka = *(const f32x4*)rk, rkb = *(const f32x4*)(rk + 4);
#pragma unroll
        for (int e = 0; e < 8; ++e) { y0[e] += y1[e]; s += y0[e]; rks += r[e] * k[e] * ((e < 4) ? rka[e & 3] : rkb[e & 3]); }
        s += __shfl_xor(s, 1); s += __shfl_xor(s, 2); s += __shfl_xor(s, 4);
        rks += __shfl_xor(rks, 1); rks += __shfl_xor(rks, 2); rks += __shfl_xor(rks, 4);
        const float mu = s * (1.0f / 64.0f); float q = 0.f;
#pragma unroll
        for (int e = 0; e < 8; ++e) { y0[e] -= mu; q += y0[e] * y0[e]; }
        q += __shfl_xor(q, 1); q += __shfl_xor(q, 2); q += __shfl_xor(q, 4);
        const float rstd = 1.0f / sqrtf(q * (1.0f / 64.0f) + GN_EPS);
        float o[8]; const f32x4 g0 = *(const f32x4*)lng, g1 = *(const f32x4*)(lng + 4), b0 = *(const f32x4*)lnb, b1 = *(const f32x4*)(lnb + 4);
#pragma unroll
        for (int e = 0; e < 4; ++e) { o[e] = (y0[e] * rstd * g0[e] + b0[e] + rks * v[e]) * zc[e]; o[4 + e] = (y0[4 + e] * rstd * g1[e] + b1[e] + rks * v[4 + e]) * zc[4 + e]; }
        *(u32x4*)(Y + (size_t)m * 1536 + 1024 + lane * 8) = pack8(o);
    }
}


#define XB_TMO      128
#define XB_XCNT(j)  (256  + 64 * (j))
#define XB_XSUB(j)  (1280 + 64 * (j))
#define XB_XGEN(j)  (2304 + 64 * (j))
#define XB_TOP      3328
#define XB_TOPGEN   3392
#define XCD_BAR_WORDS 3456
#define XB_SPIN_CAP (1u << 22)
__device__ __forceinline__ unsigned xb_ld(unsigned* p)              { return __hip_atomic_load(p, __ATOMIC_RELAXED, __HIP_MEMORY_SCOPE_AGENT); }
__device__ __forceinline__ unsigned xb_add(unsigned* p, unsigned v) { return __hip_atomic_fetch_add(p, v, __ATOMIC_RELAXED, __HIP_MEMORY_SCOPE_AGENT); }
__device__ __forceinline__ unsigned xb_xcc_id() { return (unsigned)__builtin_amdgcn_s_getreg((3 << 11) | 20) & 0xFu; }
#define XB_SPIN(cond, bar) do { unsigned _sp = 0; while (cond) { __builtin_amdgcn_s_sleep(1); \
    if ((++_sp & 255u) == 0u) { if (xb_ld(&(bar)[XB_TMO])) break; if (_sp > XB_SPIN_CAP) { atomicAdd(&(bar)[XB_TMO], 1u); break; } } } } while (0)
struct XcdBarrier { unsigned* bar; unsigned x; volatile LAS unsigned* st; };
__device__ __forceinline__ XcdBarrier xcd_barrier_post(unsigned* bar, volatile LAS unsigned* st) {
    XcdBarrier b; b.bar = bar; b.x = xb_xcc_id(); b.st = st;
    if (threadIdx.x == 0) (void)xb_add(&bar[XB_XCNT(b.x)], 1u);
    return b;
}
__device__ __forceinline__ void xcd_barrier_complete(unsigned* bar, unsigned x, unsigned& nloc, unsigned& nx) {
    const unsigned G = gridDim.x * gridDim.y * gridDim.z;
    unsigned sum, cnt, mine, sp = 0u;
    for (;;) {
        sum = 0u; cnt = 0u; mine = 0u;
#pragma unroll
        for (unsigned j = 0; j < 16; ++j) { const unsigned c = xb_ld(&bar[XB_XCNT(j)]); sum += c; cnt += (c > 0u) ? 1u : 0u; mine = (j == x) ? c : mine; }
        if (sum == G) break;
        __builtin_amdgcn_s_sleep(1);
        if ((++sp & 255u) == 0u) { if (xb_ld(&bar[XB_TMO])) break; if (sp > XB_SPIN_CAP) { atomicAdd(&bar[XB_TMO], 1u); break; } }
    }
    nloc = mine > 0u ? mine : 1u; nx = cnt > 0u ? cnt : 1u;
}
__device__ __forceinline__ void xcd_barrier(const XcdBarrier& b) {
    asm volatile("s_waitcnt vmcnt(0)" ::: "memory");
    __syncthreads();
    if (threadIdx.x == 0) {
        unsigned* bar = b.bar;
        __builtin_amdgcn_s_waitcnt(0);
        unsigned nloc = b.st[0], nx = b.st[1];
        if (nloc == 0u) { xcd_barrier_complete(bar, b.x, nloc, nx); b.st[0] = nloc; b.st[1] = nx; }
        const unsigned old = xb_add(&bar[XB_XSUB(b.x)], 1u);
        const unsigned gen = old / nloc;
        if (old + 1u == (gen + 1u) * nloc) {
            __builtin_amdgcn_fence(__ATOMIC_RELEASE, "agent");
            asm volatile("s_waitcnt vmcnt(0)" ::: "memory");
            const unsigned og = xb_add(&bar[XB_TOP], 1u);
            const unsigned tg = og / nx;
            if (og + 1u == (tg + 1u) * nx) xb_add(&bar[XB_TOPGEN], 1u);
            else XB_SPIN(xb_ld(&bar[XB_TOPGEN]) == tg, bar);
            __builtin_amdgcn_fence(__ATOMIC_ACQUIRE, "agent");
            xb_add(&bar[XB_XGEN(b.x)], 1u);
            asm volatile("s_waitcnt vmcnt(0)" ::: "memory");
        } else {
            XB_SPIN(xb_ld(&bar[XB_XGEN(b.x)]) == gen, bar);
            __builtin_amdgcn_fence(__ATOMIC_ACQUIRE, "agent");
            asm volatile("s_waitcnt vmcnt(0)" ::: "memory");
        }
    }
    __syncthreads();
}
constexpr int LDS_MISC = 139264;
constexpr size_t WS_BAR = 4096;
constexpr size_t CTL_ZERO_BYTES = 65536;

__device__ __forceinline__ void group_barrier(unsigned* ctr, unsigned nblk) {
    asm volatile("s_waitcnt vmcnt(0)" ::: "memory");
    __syncthreads();
    if (threadIdx.x == 0) {
        __builtin_amdgcn_fence(__ATOMIC_RELEASE, "agent");
        asm volatile("s_waitcnt vmcnt(0)" ::: "memory");
        (void)xb_add(ctr, 1u);
        unsigned sp = 0u;
        while (xb_ld(ctr) < nblk) { __builtin_amdgcn_s_sleep(1); if (++sp > XB_SPIN_CAP) break; }
        __builtin_amdgcn_fence(__ATOMIC_ACQUIRE, "agent");
        asm volatile("s_waitcnt vmcnt(0)" ::: "memory");
    }
    __syncthreads();
}
constexpr size_t WS_GBAR = 32768;

constexpr int NPH_L = 8;
constexpr int NPHASES = 1 + NL * NPH_L;

template <int ONLY>
__global__ void __launch_bounds__(512, 2) mk_fwd(Args args) {
    extern __shared__ __attribute__((aligned(16))) unsigned char lds_raw[];
    LAS unsigned char* lds = (LAS unsigned char*)lds_raw;
    const int G = gridDim.x;
#if MK_ONE_LAUNCH
    if (threadIdx.x < 2) ((volatile LAS unsigned*)(lds + LDS_MISC))[threadIdx.x] = 0u;
    __syncthreads();
    XcdBarrier xbar = xcd_barrier_post((unsigned*)(args.ws + WS_BAR), (volatile LAS unsigned*)(lds + LDS_MISC));
    if (args.ph_hi > 100000) cg::this_grid().sync();
#endif
    for (int ph = args.ph_lo; ph < args.ph_hi; ++ph) {
        int tid = threadIdx.x; asm volatile("" : "+v"(tid));
        int bid = blockIdx.x; asm volatile("" : "+s"(bid));
        ArgP A = (ArgP)__builtin_amdgcn_kernarg_segment_ptr(); asm volatile("" : "+s"(A));
        const int lane = tid & 63, wave = __builtin_amdgcn_readfirstlane(tid >> 6);
        unsigned char* ws = A->ws;
        if (ph == 0) { if (ONLY == -1 || ONLY == 100) { phase_A(A, lds, tid, wave, lane, bid, G); __syncthreads(); convert_weights(A, 0, lds, wave, lane, bid * 8 + wave, G * 8); } }
        else {
            const int l = (ph - 1) / NPH_L; int sp = (int)((0x98764210ull >> (4 * ((ph - 1) % NPH_L))) & 15ull);
            if (ONLY >= 0) { if (ONLY == 100 || sp != ONLY) continue; sp = ONLY; }
            if (sp == 0) phase_B(A, l, lds, tid, wave, lane, bid, G);
            else if (sp == 1) {
                pg8::Gemm g{(const bf16_t*)(ws + WS_H), (const bf16_t*)(ws + (size_t)(l & 1) * WS_WSET2 + WS_WIN), 1024, 1024, 1024, 0, 0};
                pg8::Sched S; if (l == NL - 1) S.init(ML / 256, INC / 256, 1, G, bid, MC / 256, 9); else S.init_gemm1_holes(G, bid);
                pg8::Epi1 E{(bf16_t*)(ws + WS_KB), (bf16_t*)(ws + WS_VB), (bf16_t*)(ws + WS_RW), (bf16_t*)(ws + WS_YD), (bf16_t*)(ws + WS_QB), (bf16_t*)(ws + WS_GU), (bf16_t*)(ws + WS_VA), (bf16_t*)(ws + WS_Z), (bf16_t*)(ws + WS_G)};
                pg8::gemm_phase<pg8::Epi1>(lds, g, S, E, tid);
            } else if (sp == 2) {
                pg8::Gemm g{(const bf16_t*)(ws + WS_YD), (const bf16_t*)(ws + (size_t)(l & 1) * WS_WSET2 + WS_WLORA), 256, 256, 256, 0, 0};
                pg8::Sched S; S.init(MT / 256, 2048 / 256, 1, G, bid);
                pg8::EpiLora E{(bf16_t*)(ws + WS_WA), A->in[17] + l * 1024, A->in[19] + l * 1024};
                pg8::gemm_phase<pg8::EpiLora>(lds, g, S, E, tid);
                phase_prep<0>(A, l, tid, wave, lane, bid, G);
            }
            else if (sp == 4) {
                const int par = (bid >> 3) & 1;
#pragma nounroll
                for (int pass = 0; pass < 2; ++pass) {
                    if (pass == par) { for (int u = bid; u < 256; u += G) att::attn_unit(A, l, u, (char*)lds_raw, tid); }
                    else phase_prep<1>(A, l, tid, wave, lane, bid, G);
                    __syncthreads(); }
            }
            else if (sp == 5) { for (int u = bid; u < (MT / 128) * 4; u += G) gmlp_unit(A, l, u, (char*)lds_raw, tid); }
            else if (sp == 6) {
                if (l < NL - 1 && bid >= 64 && bid < 80) {
                    att::attn_unit(A, l, 256 + (bid - 64), (char*)lds_raw, tid);
                    asm volatile("s_waitcnt vmcnt(0)" ::: "memory"); __syncthreads();
                    if (tid == 0) (void)xb_add((unsigned*)(ws + WS_GBAR) + l * 512 + 6 * 64, 1u);
                }
                unsigned* gb = (unsigned*)(ws + WS_GBAR) + l * 512;
                const bool crewl = l < NL - 1;
                const bf16_t* wbr = (const bf16_t*)(ws + (size_t)(l & 1) * WS_WSET2 + WS_WBR);
                if (bid < 64) scanc::scan_unit(A, l, bid, (LAS char*)lds, tid, gb + 4 * 64);
                else if (crewl && bid < 80) {
                    const int c = bid - 64;
                    gmlp_unit(A, l, 512 + 2 * c, (char*)lds_raw, tid); gmlp_unit(A, l, 513 + 2 * c, (char*)lds_raw, tid);
                    group_barrier(gb + 1 * 64, 16u);
                    pg8::Sched S; S.init(ML / 256, 0, 1, 16, c, MC / 256, 4);
                    {   pg8::Gemm g{(const bf16_t*)(ws + WS_QB), wbr + (size_t)1024 * 512, 512, 512, 512, 0, 0};
                        pg8::EpiMerge E{(const bf16_t*)(ws + WS_G), (bf16_t*)(ws + WS_MB), 1, true};
                        pg8::gemm_phase<pg8::EpiMerge>(lds, g, S, E, tid); }
                    asm volatile("s_waitcnt vmcnt(0)" ::: "memory"); __syncthreads();
                    {   pg8::Gemm g{(const bf16_t*)(ws + WS_RW), wbr, 1536, 512, 512, 0, 0};
                        pg8::EpiMerge E{(const bf16_t*)(ws + WS_G), (bf16_t*)(ws + WS_MB), 0, false};
                        pg8::gemm_phase<pg8::EpiMerge>(lds, g, S, E, tid); }
                    if (tid == 0) { unsigned sp_ = 0u; while (xb_ld(gb + 4 * 64) < 128u) { __builtin_amdgcn_s_sleep(2); if (++sp_ > XB_SPIN_CAP) break; } __builtin_amdgcn_fence(__ATOMIC_ACQUIRE, "agent"); }
                    __syncthreads();
                    phase_readout(A, l, lane, ML, MT, c * 8 + wave, 16 * 8);
                    group_barrier(gb + 2 * 64, 16u);
                    {   pg8::Gemm g{(const bf16_t*)(ws + WS_RW) + 1024, wbr + (size_t)2 * 1024 * 512, 1536, 512, 512, 0, 0};
                        pg8::EpiMerge E{(const bf16_t*)(ws + WS_G), (bf16_t*)(ws + WS_MB), 2, false};
                        pg8::gemm_phase<pg8::EpiMerge>(lds, g, S, E, tid); }
                    group_barrier(gb + 3 * 64, 16u);
                    {   pg8::Gemm g{(const bf16_t*)(ws + WS_MB), (const bf16_t*)(ws + (size_t)(l & 1) * WS_WSET2 + WS_WOUT), 1024, 1024, 1024, 0, 0};
                        pg8::EpiOut E{l == 0 ? A->in[0] : A->out, A->out, l == 0 ? A->in[2] : (const float*)(ws + WS_XC), (float*)(ws + WS_XC), (const float*)(ws + WS_MODB) + (size_t)l * 5 * 3072};
                        pg8::gemm_phase<pg8::EpiOut>(lds, g, S, E, tid); }
                } else { const int b0 = crewl ? 80 : 64, nb = G - b0, ob = bid - b0;
                    if (crewl && ob >= 80 && ob < 156) {
                        const int dt = ob - 80;
                        pg8::Gemm g1{(const bf16_t*)(ws + WS_H), (const bf16_t*)(ws + (size_t)(l & 1) * WS_WSET2 + WS_WIN), 1024, 1024, 1024, 0, 0};
                        pg8::Sched S1; S1.init_single(dt < 64 ? dt : dt - 64, dt < 64 ? 23 : 24);
                        pg8::Epi1 E1{(bf16_t*)(ws + WS_KB), (bf16_t*)(ws + WS_VB), (bf16_t*)(ws + WS_RW), (bf16_t*)(ws + WS_YD), (bf16_t*)(ws + WS_QB), (bf16_t*)(ws + WS_GU), (bf16_t*)(ws + WS_VA), (bf16_t*)(ws + WS_Z), (bf16_t*)(ws + WS_G)};
                        pg8::gemm_phase<pg8::Epi1>(lds, g1, S1, E1, tid);
                        asm volatile("s_waitcnt vmcnt(0)" ::: "memory"); __syncthreads();
                        if (tid == 0) (void)xb_add(gb + 7 * 64, 1u); }
                    for (int u = ob; u < (ML / 128) * 4; u += nb) gmlp_unit(A, l, u, (char*)lds_raw, tid);
                    if (crewl) { if (tid == 0) { unsigned sp_ = 0u; while (xb_ld(gb + 7 * 64) < 76u) { __builtin_amdgcn_s_sleep(2); if (++sp_ > XB_SPIN_CAP) break; } } }
                    if (false) { }
                    __syncthreads();
                    pg8::Sched S; S.init(ML / 256, 1024 / 256, 1, nb, ob);
                    {   pg8::Gemm g{(const bf16_t*)(ws + WS_QB), wbr + (size_t)1024 * 512, 512, 512, 512, 0, 0};
                        pg8::EpiMerge E{(const bf16_t*)(ws + WS_G), (bf16_t*)(ws + WS_MB), 1, true};
                        pg8::gemm_phase<pg8::EpiMerge>(lds, g, S, E, tid); }
                    __syncthreads();
                    if (l + 1 < NL) convert_weights(A, l + 1, lds, wave, lane, ob * 8 + wave, nb * 8);
                    group_barrier(gb, (unsigned)nb);
                    {   pg8::Gemm g{(const bf16_t*)(ws + WS_RW), wbr, 1536, 512, 512, 0, 0};
                        pg8::EpiMerge E{(const bf16_t*)(ws + WS_G), (bf16_t*)(ws + WS_MB), 0, false};
                        pg8::gemm_phase<pg8::EpiMerge>(lds, g, S, E, tid); } }
            }
            else if (sp == 7) phase_readout(A, l, lane, 0, ML, bid * 8 + wave, G * 8);
            else if (sp == 8) {
                pg8::Gemm g{(const bf16_t*)(ws + WS_RW) + 1024, (const bf16_t*)(ws + (size_t)(l & 1) * WS_WSET2 + WS_WBR) + (size_t)2 * 1024 * 512, 1536, 512, 512, 0, 0};
                pg8::Sched S; S.init(ML / 256, 1024 / 256, 1, G, bid);
                pg8::EpiMerge E{(const bf16_t*)(ws + WS_G), (bf16_t*)(ws + WS_MB), 2, false};
                pg8::gemm_phase<pg8::EpiMerge>(lds, g, S, E, tid);
            } else {
                pg8::Gemm g{(const bf16_t*)(ws + WS_MB), (const bf16_t*)(ws + (size_t)(l & 1) * WS_WSET2 + WS_WOUT), 1024, 1024, 1024, 0, 0};
                pg8::Sched S; S.init(ML / 256, 1024 / 256, 1, G, bid);
                pg8::EpiOut E{l == 0 ? A->in[0] : A->out, A->out, l == 0 ? A->in[2] : (const float*)(ws + WS_XC), (float*)(ws + WS_XC), (const float*)(ws + WS_MODB) + (size_t)l * 5 * 3072};
                pg8::gemm_phase<pg8::EpiOut>(lds, g, S, E, tid);
            }
        }
#if MK_ONE_LAUNCH
        if (ph + 1 < args.ph_hi) xcd_barrier(xbar);
#endif
    }
}


extern "C" void kernel_launch(void* const* d_in, const int* in_sizes, int n_in, void* d_out, int out_size, void* d_ws, size_t ws_size, hipStream_t stream) {
    static int state = 0;
    if (state == 0) {
        if (n_in != 28 || out_size != ML * DM || ws_size < WS_END) { fprintf(stderr, "kernel_launch: unexpected shapes (n_in %d out %d ws %zu)\n", n_in, out_size, ws_size); state = -1; return; }
        state = 1;
    }
    if (state < 0) return;
    Args a{};
    for (int i = 0; i < 28; ++i) a.in[i] = (const float*)d_in[i];
    a.out = (float*)d_out; a.ws = (unsigned char*)d_ws;
#if MK_ONE_LAUNCH
    static int grid = 0;
    if (grid == 0) {
        if (hipFuncSetAttribute((const void*)mk_fwd<-1>, hipFuncAttributeMaxDynamicSharedMemorySize, LDS_BYTES) != hipSuccess) fprintf(stderr, "kernel_launch: hipFuncSetAttribute failed\n");
        int dev = 0, cus = 0, per_cu = 0;
        hipGetDevice(&dev); hipDeviceGetAttribute(&cus, hipDeviceAttributeMultiprocessorCount, dev);
        if (hipOccupancyMaxActiveBlocksPerMultiprocessor(&per_cu, (const void*)mk_fwd<-1>, 512, LDS_BYTES) != hipSuccess || per_cu < 1) { fprintf(stderr, "kernel_launch: occupancy query says %d blocks per CU\n", per_cu); per_cu = 1; }
        (void)hipGetLastError();
        grid = cus * (per_cu < 1 ? 1 : 1);
        if (grid > 256) grid = 256;
    }
    (void)hipMemsetAsync(d_ws, 0, CTL_ZERO_BYTES, stream);
    a.ph_lo = 0; a.ph_hi = NPHASES;
    void* kargs[] = {&a};
    hipError_t e = hipLaunchCooperativeKernel((const void*)mk_fwd<-1>, dim3(grid), dim3(512), kargs, LDS_BYTES, stream);
    if (e != hipSuccess) fprintf(stderr, "cooperative launch failed: %s\n", hipGetErrorString(e));
#endif
}
```

```cpp
#include <hip/hip_runtime.h>
#include <hip/hip_cooperative_groups.h>
#include <cstdint>
#include <cstdio>
namespace cg = cooperative_groups;

#ifndef MK_ONE_LAUNCH
#define MK_ONE_LAUNCH 1
#endif

#define LAS __attribute__((address_space(3)))
#define GAS __attribute__((address_space(1)))
typedef unsigned short bf16_t;
typedef short bf16x8 __attribute__((ext_vector_type(8)));
typedef short s16x4 __attribute__((ext_vector_type(4)));
typedef float f32x2 __attribute__((ext_vector_type(2)));
typedef float f32x4 __attribute__((ext_vector_type(4)));
typedef float f32x16 __attribute__((ext_vector_type(16)));
typedef unsigned u32x2 __attribute__((ext_vector_type(2)));
typedef unsigned u32x4 __attribute__((ext_vector_type(4)));

constexpr int DM = 1024, NB = 4, SEQ = 4096, NL = 4, CTX = 256;
constexpr int ML = NB * SEQ;
constexpr int MC = NB * CTX;
constexpr int MT = ML + MC;
constexpr int INC = 8960;
constexpr float NORM_EPS = 1e-6f, LN_EPS = 1e-5f, GN_EPS = 64e-5f;
constexpr float LOG2E = 1.4426950408889634f;
constexpr float QSCALE = 0.125f * LOG2E;

constexpr size_t MiB = 1u << 20;
constexpr size_t WS_MODB = 1 * MiB;
constexpr size_t WS_ROPE = WS_MODB + 256 * 1024;
constexpr size_t WS_SCAL = WS_ROPE + 16 * 1024;
constexpr size_t WS_WIN  = 2 * MiB;
constexpr size_t WS_WBR  = 20 * MiB;
constexpr size_t WS_WOUT = 23 * MiB;
constexpr size_t WS_WLORA = 25 * MiB;
constexpr size_t WS_XC   = 26 * MiB;
constexpr size_t WS_H    = 30 * MiB;
constexpr size_t WS_MB   = 64 * MiB;
constexpr size_t WS_KB   = 64 * MiB;
constexpr size_t WS_QB   = 81 * MiB;
constexpr size_t WS_VB   = 98 * MiB;
constexpr size_t WS_RW   = 115 * MiB;
constexpr size_t WS_GU   = 166 * MiB;
constexpr size_t WS_VA   = 183 * MiB;
constexpr size_t WS_Z    = 200 * MiB;
constexpr size_t WS_G    = 251 * MiB;
constexpr size_t WS_WA   = 353 * MiB;
constexpr size_t WS_RWP  = 421 * MiB;
constexpr size_t WS_YD   = 489 * MiB;
constexpr size_t WS_WSET2 = 521 * MiB;
constexpr size_t WS_END  = 547 * MiB;

constexpr int LDS_BYTES = 147456;

__device__ __forceinline__ float bf2f(unsigned short h) { return __uint_as_float(((unsigned)h) << 16); }
typedef __bf16 bf16x2_t __attribute__((ext_vector_type(2)));
__device__ __forceinline__ unsigned cvt_pk_bf16(float lo, float hi) { f32x2 v = {lo, hi}; bf16x2_t b = __builtin_convertvector(v, bf16x2_t); return __builtin_bit_cast(unsigned, b); }
__device__ __forceinline__ float fast_sig(float z) { return __builtin_amdgcn_rcpf(1.0f + __builtin_amdgcn_exp2f(-z * LOG2E)); }
__device__ __forceinline__ float wave_sum(float v) {
#pragma unroll
    for (int o = 1; o < 64; o <<= 1) v += __shfl_xor(v, o);
    return v;
}
__device__ __forceinline__ void unpack8(const u32x4 w, float (&f)[8]) {
    f[0] = __uint_as_float(w.x << 16); f[1] = __uint_as_float(w.x & 0xffff0000u);
    f[2] = __uint_as_float(w.y << 16); f[3] = __uint_as_float(w.y & 0xffff0000u);
    f[4] = __uint_as_float(w.z << 16); f[5] = __uint_as_float(w.z & 0xffff0000u);
    f[6] = __uint_as_float(w.w << 16); f[7] = __uint_as_float(w.w & 0xffff0000u);
}
__device__ __forceinline__ u32x4 pack8(const float (&f)[8]) {
    u32x4 w; w.x = cvt_pk_bf16(f[0], f[1]); w.y = cvt_pk_bf16(f[2], f[3]); w.z = cvt_pk_bf16(f[4], f[5]); w.w = cvt_pk_bf16(f[6], f[7]); return w;
}

struct Args {
    const float* in[28];
    float* out; unsigned char* ws;
    int ph_lo, ph_hi;
};
typedef const __attribute__((address_space(4))) Args* ArgP;

namespace pg8 {
constexpr int BM = 256, BK = 64, HALF = 128, HTB = HALF * BK * 2, STAGE_BYTES = 8 * HTB, NXCD = 8, WGM = 4;
__host__ __device__ __forceinline__ int lds_byte(int r, int c) { const int st = (r >> 4) * 2 + (c >> 5), rr = r & 15, cc = c & 31, ob = rr * 64 + cc * 2; return st * 1024 + (ob ^ (((ob >> 9) & 1) << 5)); }
__host__ __device__ __forceinline__ void stage_rc(int b, int& R, int& C) { const int st = b / 1024, sb = b % 1024, swz = sb ^ (((sb >> 9) & 1) << 5); R = (st >> 1) * 16 + swz / 64; C = (st & 1) * 32 + (swz % 64) / 2; }
__host__ __device__ __forceinline__ int perm32(int rho) { const int n = rho >> 4, i = rho & 15; return 8 * (i >> 2) + 4 * n + (i & 3); }

struct Unit { int pm, pn, pz; };
struct Gemm { const bf16_t* A; const bf16_t* Bt; int lda, ldb, K; size_t zA, zB; };

struct Sched {
    int nM, nN, nZ, nwg, G, c, nM2, nN2;
    int mode = 0, spm = 0, spn = 0;
    __device__ void init(int nM_, int nN_, int nZ_, int G_, int c_, int nM2_ = 0, int nN2_ = 0) { nM = nM_; nN = nN_; nZ = nZ_; nwg = nM * nN; G = G_; c = c_; nM2 = nM2_; nN2 = nN2_; }
    __device__ void init_gemm1_holes(int G_, int c_) { init(MT / 256, 33, 1, G_, c_); mode = 1; }
    __device__ void init_single(int pm_, int pn_) { init(1, 1, 1, 1, 0); mode = 2; spm = pm_; spn = pn_; }
    __device__ bool next(int i, Unit& u) const {
        if (mode == 2) { if (i > 0) return false; u.pm = spm; u.pn = spn; u.pz = 0; return true; }
        if (mode == 1) { const long L1 = (long)i * G + c;
            if (L1 >= nwg) { const int e = (int)(L1 - nwg); if (e >= 60) return false; if (e < 4) { u.pm = 64 + e; u.pn = 23; } else { u.pm = 12 + (e - 4); u.pn = 24; } u.pz = 0; return true; } }
        const int ti = i / nZ, z = i - ti * nZ;
        const long L = (long)ti * G + c;
        if (L >= nwg) { const int e = (int)(L - nwg); if (e >= nM2 * nN2) return false; u.pm = nM + e % nM2; u.pn = e / nM2; u.pz = 0; return true; }
        int wgid = (int)L; { const int q = nwg / NXCD, r = nwg % NXCD, xcd = wgid % NXCD, off = wgid / NXCD; wgid = (xcd < r ? xcd * (q + 1) : r * (q + 1) + (xcd - r) * q) + off; }
        const int nig = WGM * nN, gid = wgid / nig, fm = gid * WGM, gsz = (nM - fm) < WGM ? (nM - fm) : WGM;
        u.pm = fm + ((wgid % nig) % gsz); u.pn = (wgid % nig) / gsz; u.pz = z; if (mode == 1 && u.pn >= 23) u.pn += 2; return true;
    }
};

template <class Epi>
__device__ __forceinline__ void gemm_phase(LAS unsigned char* lds, const Gemm g, const Sched& S, const Epi& E, const int tid) {
    const int wid = __builtin_amdgcn_readfirstlane(tid >> 6), lane = tid & 63, wr = wid >> 2, wc = wid & 3, fr = lane & 15, fq = lane >> 4;
    int Kl = g.K; asm volatile("" : "+s"(Kl));
    const int K = Kl, nt = K / BK;
    unsigned voffA[2], voffB[2];
#pragma unroll
    for (int i = 0; i < 2; ++i) { int R, C; stage_rc(tid * 16 + i * 8192, R, C); const int Rb = Epi::PERM ? ((R & ~31) + perm32(R & 31)) : R;
        voffA[i] = (unsigned)(R * g.lda + C) * 2u; voffB[i] = (unsigned)(Rb * g.ldb + C) * 2u; }
    const size_t kstep = (size_t)(BK * 2);
    const size_t hstepA = (size_t)HALF * g.lda * 2, hstepB = (size_t)HALF * g.ldb * 2;
    const size_t tstepA = 2 * hstepA, tstepB = 2 * hstepB;
    const unsigned ldsw = (unsigned)wid * 1024u;
    const int aoff = lds_byte(wr * 64 + fr, fq * 8), boff = lds_byte(wc * 32 + fr, fq * 8);
#define PG8_SA(b, h) (((b) * 2 + (h)) * HTB)
#define PG8_SB(b, h) ((4 + (b) * 2 + (h)) * HTB)
#define PG8_STAGE(bufoff, gbase, voff) do { _Pragma("unroll") for (int _i = 0; _i < 2; ++_i) \
        __builtin_amdgcn_global_load_lds((const unsigned*)((const char*)(gbase) + (voff)[_i]), (LAS unsigned*)(lds + (bufoff) + ldsw + _i * 8192), 16, 0, 0); } while (0)
#define PG8_LDA(dst, b, h) do { _Pragma("unroll") for (int m = 0; m < 4; ++m) _Pragma("unroll") for (int k = 0; k < 2; ++k) dst[m][k] = *(const LAS bf16x8*)(lds + PG8_SA(b, h) + aoff + m * 2048 + k * 1024); } while (0)
#define PG8_LDB(dst, b, h) do { _Pragma("unroll") for (int n = 0; n < 2; ++n) _Pragma("unroll") for (int k = 0; k < 2; ++k) dst[n][k] = *(const LAS bf16x8*)(lds + PG8_SB(b, h) + boff + n * 2048 + k * 1024); } while (0)
#define PG8_MMA(ai, bj, At, Bt) do { __builtin_amdgcn_s_setprio(1); _Pragma("unroll") for (int m = 0; m < 4; ++m) _Pragma("unroll") for (int n = 0; n < 2; ++n) _Pragma("unroll") for (int k = 0; k < 2; ++k) \
        acc[ai][bj][m][n] = __builtin_amdgcn_mfma_f32_16x16x32_bf16(Bt[n][k], At[m][k], acc[ai][bj][m][n], 0, 0, 0); __builtin_amdgcn_s_setprio(0); } while (0)
#define PG8_WAIT_V(n) asm volatile("s_waitcnt vmcnt(" #n ")" ::: "memory")
#define PG8_WAIT_L(n) asm volatile("s_waitcnt lgkmcnt(" #n ")" ::: "memory")
#define PG8_BAR __builtin_amdgcn_s_barrier()
#define PG8_SCHED __builtin_amdgcn_sched_barrier(0)
    Unit cur, nxt; int ui = 0;
    if (!S.next(0, cur)) return;
    f32x4 acc[2][2][4][2];
#pragma unroll
    for (int a = 0; a < 2; ++a)
#pragma unroll
        for (int b = 0; b < 2; ++b)
#pragma unroll
            for (int m = 0; m < 4; ++m)
#pragma unroll
                for (int n = 0; n < 2; ++n) acc[a][b][m][n] = (f32x4){0.f, 0.f, 0.f, 0.f};
    bf16x8 At[4][2], B0[2][2], B1[2][2];
    const char* cA = (const char*)g.A + (size_t)cur.pm * tstepA + (size_t)cur.pz * g.zA; const char* cB = (const char*)g.Bt + (size_t)cur.pn * tstepB + (size_t)cur.pz * g.zB;
    PG8_STAGE(PG8_SB(0, 0), cB, voffB); PG8_STAGE(PG8_SB(0, 1), cB + hstepB, voffB); PG8_STAGE(PG8_SA(0, 0), cA, voffA); PG8_STAGE(PG8_SA(0, 1), cA + hstepA, voffA);
    if (wr == 1) PG8_BAR;
    PG8_WAIT_V(2); PG8_BAR;
    PG8_STAGE(PG8_SB(1, 0), cB + kstep, voffB); PG8_STAGE(PG8_SA(1, 0), cA + kstep, voffA); PG8_STAGE(PG8_SB(1, 1), cB + hstepB + kstep, voffB);
    PG8_WAIT_V(6); PG8_BAR;
    for (;;) {
        const bool has_next = S.next(ui + 1, nxt);
        const char* nA = has_next ? (const char*)g.A + (size_t)nxt.pm * tstepA + (size_t)nxt.pz * g.zA : cA;
        const char* nB = has_next ? (const char*)g.Bt + (size_t)nxt.pn * tstepB + (size_t)nxt.pz * g.zB : cB;
        for (int t = 0; t < nt; t += 2) {
            const bool last = (t == nt - 2);
            const char* a1 = cA + (size_t)(t + 1) * kstep;
            const char* a2 = last ? nA : cA + (size_t)(t + 2) * kstep; const char* b2 = last ? nB : cB + (size_t)(t + 2) * kstep;
            const char* a3 = a2 + kstep; const char* b3 = b2 + kstep;
            PG8_LDB(B0, 0, 0); PG8_LDB(B1, 0, 1); PG8_SCHED; PG8_LDA(At, 0, 0); PG8_STAGE(PG8_SA(1, 1), a1 + hstepA, voffA);
            PG8_WAIT_V(8); PG8_WAIT_L(0); PG8_BAR; PG8_MMA(0, 0, At, B0); PG8_MMA(0, 1, At, B1); PG8_BAR; PG8_SCHED;
            PG8_LDA(At, 0, 1); PG8_STAGE(PG8_SB(0, 0), b2, voffB); PG8_STAGE(PG8_SB(0, 1), b2 + hstepB, voffB); PG8_STAGE(PG8_SA(0, 0), a2, voffA);
            PG8_WAIT_V(8); PG8_WAIT_L(0); PG8_BAR; PG8_MMA(1, 0, At, B0); PG8_MMA(1, 1, At, B1); PG8_BAR; PG8_SCHED;
            PG8_LDB(B0, 1, 0); PG8_LDB(B1, 1, 1); PG8_SCHED; PG8_LDA(At, 1, 0); PG8_STAGE(PG8_SA(0, 1), a2 + hstepA, voffA);
            PG8_WAIT_V(8); PG8_WAIT_L(0); PG8_BAR; PG8_MMA(0, 0, At, B0); PG8_MMA(0, 1, At, B1); PG8_BAR; PG8_SCHED;
            PG8_LDA(At, 1, 1); PG8_STAGE(PG8_SB(1, 0), b3, voffB); PG8_STAGE(PG8_SB(1, 1), b3 + hstepB, voffB); PG8_STAGE(PG8_SA(1, 0), a3, voffA);
            PG8_WAIT_V(8); PG8_WAIT_L(0); PG8_BAR; PG8_MMA(1, 0, At, B0); PG8_MMA(1, 1, At, B1); PG8_BAR; PG8_SCHED;
        }
        if (wr == 0) PG8_BAR;
        E(acc, cur, wr, wc, fr, fq);
        if (!has_next) break;
#pragma unroll
        for (int a = 0; a < 2; ++a)
#pragma unroll
            for (int b = 0; b < 2; ++b)
#pragma unroll
                for (int m = 0; m < 4; ++m)
#pragma unroll
                    for (int n = 0; n < 2; ++n) acc[a][b][m][n] = (f32x4){0.f, 0.f, 0.f, 0.f};
        cur = nxt; cA = nA; cB = nB; ++ui;
        if (wr == 1) PG8_BAR;
    }
    PG8_WAIT_V(0);
    PG8_BAR;
#undef PG8_SA
#undef PG8_SB
#undef PG8_STAGE
#undef PG8_LDA
#undef PG8_LDB
#undef PG8_MMA
#undef PG8_WAIT_V
#undef PG8_WAIT_L
#undef PG8_BAR
#undef PG8_SCHED
}

template <int ACT> __device__ __forceinline__ float act_f(float x) {
    if (ACT == 0) return x;
    if (ACT == 1) { const float z = x * (1.5957691216f + 0.0713548163f * x * x); return x * fast_sig(z); }
    if (ACT == 2) return x * fast_sig(x);
    if (ACT == 3) return fast_sig(x);
    return 2.0f * fast_sig(2.0f * x) - 1.0f;
}
template <int ACT0, int ACT1> __device__ __forceinline__ void epi_store_bf16(const f32x4 (&acc)[2][2][4][2], bf16_t* base, int ld, int row0, int col0) {
#pragma unroll
    for (int ai = 0; ai < 2; ++ai)
#pragma unroll
        for (int m = 0; m < 4; ++m) { bf16_t* rowp = base + (size_t)(row0 + ai * HALF + m * 16) * ld + col0;
#pragma unroll
            for (int bj = 0; bj < 2; ++bj) { const f32x4 v0 = acc[ai][bj][m][0], v1 = acc[ai][bj][m][1];
                float o[8];
                if (bj == 0) { o[0] = act_f<ACT0>(v0[0]); o[1] = act_f<ACT0>(v0[1]); o[2] = act_f<ACT0>(v0[2]); o[3] = act_f<ACT0>(v0[3]); o[4] = act_f<ACT0>(v1[0]); o[5] = act_f<ACT0>(v1[1]); o[6] = act_f<ACT0>(v1[2]); o[7] = act_f<ACT0>(v1[3]); }
                else         { o[0] = act_f<ACT1>(v0[0]); o[1] = act_f<ACT1>(v0[1]); o[2] = act_f<ACT1>(v0[2]); o[3] = act_f<ACT1>(v0[3]); o[4] = act_f<ACT1>(v1[0]); o[5] = act_f<ACT1>(v1[1]); o[6] = act_f<ACT1>(v1[2]); o[7] = act_f<ACT1>(v1[3]); }
                *(u32x4*)(rowp + bj * HALF) = pack8(o); } __builtin_amdgcn_sched_barrier(0); }
}
struct Epi1 {
    static constexpr bool PERM = true;
    bf16_t *Kb, *Vb, *RW, *LA, *Qb, *GU, *VA, *Z, *G;
    __device__ __forceinline__ void operator()(const f32x4 (&acc)[2][2][4][2], const Unit& u, int wr, int wc, int fr, int fq) const {
        const int pn = u.pn; bf16_t* base; int ld, colt, act;
        if (pn < 2)       { base = Kb; ld = 512;  colt = pn * 256;               act = 0; }
        else if (pn < 4)  { base = Vb; ld = 512;  colt = (pn - 2) * 256;         act = 0; }
        else if (pn < 8)  { base = RW; ld = 1536; colt = (pn - 4) * 256;         act = 0; }
        else if (pn == 8) { base = LA; ld = 256;  colt = 0;                      act = 4; }
        else if (pn < 11) { base = Qb; ld = 512;  colt = (pn - 9) * 256;         act = 0; }
        else if (pn < 13) { base = RW; ld = 1536; colt = 1024 + (pn - 11) * 256; act = 0; }
        else if (pn < 15) { base = GU; ld = 512;  colt = (pn - 13) * 256;        act = 1; }
        else if (pn < 17) { base = VA; ld = 512;  colt = (pn - 15) * 256;        act = 1; }
        else if (pn < 23) { base = Z;  ld = 1536; colt = (pn - 17) * 256;        act = 2; }
        else              { base = G;  ld = 3072; colt = (pn - 23) * 256;        act = 3; }
        const int row0 = u.pm * BM + wr * 64 + fr, col0 = colt + wc * 32 + 8 * fq;
        if (act == 0) epi_store_bf16<0, 0>(acc, base, ld, row0, col0);
        else if (act == 1) epi_store_bf16<1, 1>(acc, base, ld, row0, col0);
        else if (act == 2) epi_store_bf16<2, 2>(acc, base, ld, row0, col0);
        else if (act == 3) epi_store_bf16<3, 3>(acc, base, ld, row0, col0);
        else epi_store_bf16<4, 0>(acc, base, ld, row0, col0);
    }
};
template <bool ISW> __device__ __forceinline__ void epi_lora_store(const f32x4 (&acc)[2][2][4][2], bf16_t* WA, const float* bias, int row0, int col0) {
#pragma unroll
    for (int bj = 0; bj < 2; ++bj) {
        const f32x4 bv0 = *(const f32x4*)(bias + bj * HALF), bv1 = *(const f32x4*)(bias + bj * HALF + 4);
#pragma unroll
        for (int ai = 0; ai < 2; ++ai)
#pragma unroll
            for (int m = 0; m < 4; ++m) { bf16_t* rowp = WA + (size_t)(row0 + ai * HALF + m * 16) * 2048 + col0 + bj * HALF; float o[8];
#pragma unroll
                for (int e = 0; e < 4; ++e) { const float s0 = fast_sig(acc[ai][bj][m][0][e] + bv0[e]), s1 = fast_sig(acc[ai][bj][m][1][e] + bv1[e]);
                    o[e] = ISW ? (1.0f - __builtin_amdgcn_exp2f(-0.60653065971f * LOG2E * s0)) : s0;
                    o[4 + e] = ISW ? (1.0f - __builtin_amdgcn_exp2f(-0.60653065971f * LOG2E * s1)) : s1; }
                *(u32x4*)rowp = pack8(o); __builtin_amdgcn_sched_barrier(0); }
        asm volatile("" ::: "memory");
    }
}
struct EpiLora {
    static constexpr bool PERM = true;
    bf16_t* WA; const float* w0; const float* a0;
    __device__ __forceinline__ void operator()(const f32x4 (&acc)[2][2][4][2], const Unit& u, int wr, int wc, int fr, int fq) const {
        const int row0 = u.pm * BM + wr * 64 + fr, col0 = u.pn * BM + wc * 32 + 8 * fq;
        if (u.pn < 4) epi_lora_store<true>(acc, WA, w0 + col0, row0, col0);
        else epi_lora_store<false>(acc, WA, a0 + col0 - 1024, row0, col0);
    }
};
struct EpiMerge {
    static constexpr bool PERM = true;
    const bf16_t* G; bf16_t* MB; int z0; bool first;
    __device__ __forceinline__ void operator()(const f32x4 (&acc)[2][2][4][2], const Unit& u, int wr, int wc, int fr, int fq) const {
        const int row0 = u.pm * BM + wr * 64 + fr, col0 = u.pn * BM + wc * 32 + 8 * fq, z = z0; const bool accu = !first;
        u32x4 gc[2], gn[2], pc[2], pn_[2];
#define MLOAD(dg, dp, g_) do { const size_t row_ = (size_t)(row0 + ((g_) >> 2) * HALF + ((g_) & 3) * 16); \
        _Pragma("unroll") for (int bj = 0; bj < 2; ++bj) { const int c_ = col0 + bj * HALF; dg[bj] = *(const u32x4*)(G + row_ * 3072 + z * 1024 + c_); \
            if (accu) dp[bj] = *(const u32x4*)(MB + row_ * 1024 + c_); } } while (0)
        MLOAD(gc, pc, 0);
#pragma unroll
        for (int g = 0; g < 8; ++g) { const int ai = g >> 2, m = g & 3; const size_t row = (size_t)(row0 + ai * HALF + m * 16);
            if (g + 1 < 8) MLOAD(gn, pn_, g + 1);
#pragma unroll
            for (int bj = 0; bj < 2; ++bj) { const int c = col0 + bj * HALF; float gf[8]; unpack8(gc[bj], gf); float o[8];
#pragma unroll
                for (int n = 0; n < 2; ++n)
#pragma unroll
                    for (int e = 0; e < 4; ++e) o[n * 4 + e] = acc[ai][bj][m][n][e] * gf[n * 4 + e];
                if (accu) { float pf[8]; unpack8(pc[bj], pf);
#pragma unroll
                    for (int e = 0; e < 8; ++e) o[e] += pf[e]; }
                *(u32x4*)(MB + row * 1024 + c) = pack8(o); }
#pragma unroll
            for (int bj = 0; bj < 2; ++bj) { gc[bj] = gn[bj]; pc[bj] = pn_[bj]; } }
#undef MLOAD
    }
};
struct EpiOut {
    static constexpr bool PERM = false;
    const float* xin; float* xout; const float* xcin; float* xcout; const float* modl;
    __device__ __forceinline__ void operator()(const f32x4 (&acc)[2][2][4][2], const Unit& u, int wr, int wc, int fr, int fq) const {
        const bool lat = u.pm < (ML / BM);
        const int b = lat ? (u.pm >> 4) : 4;
        const float* src = lat ? xin : xcin; float* dst = lat ? xout : xcout;
        const int row0 = (lat ? u.pm * BM : u.pm * BM - ML) + wr * 64 + fr, col0 = u.pn * BM + wc * 32 + 4 * fq;
        const float* gate = modl + b * 3072 + 2048 + col0;
        f32x4 gv[2][2];
#pragma unroll
        for (int bj = 0; bj < 2; ++bj)
#pragma unroll
            for (int n = 0; n < 2; ++n) gv[bj][n] = *(const f32x4*)(gate + bj * HALF + n * 16);
        f32x4 xc[2][2], xn[2][2];
#define XLOAD(dst, g_) do { const size_t off_ = (size_t)(row0 + ((g_) >> 2) * HALF + ((g_) & 3) * 16) * 1024 + col0; \
        _Pragma("unroll") for (int bj = 0; bj < 2; ++bj) _Pragma("unroll") for (int n = 0; n < 2; ++n) dst[bj][n] = *(const f32x4*)(src + off_ + bj * HALF + n * 16); } while (0)
        XLOAD(xc, 0);
#pragma unroll
        for (int g = 0; g < 8; ++g) { const int ai = g >> 2, m = g & 3; const size_t off = (size_t)(row0 + ai * HALF + m * 16) * 1024 + col0;
            if (g + 1 < 8) XLOAD(xn, g + 1);
#pragma unroll
            for (int bj = 0; bj < 2; ++bj)
#pragma unroll
                for (int n = 0; n < 2; ++n) *(f32x4*)(dst + off + bj * HALF + n * 16) = xc[bj][n] + gv[bj][n] * acc[ai][bj][m][n];
#pragma unroll
            for (int bj = 0; bj < 2; ++bj)
#pragma unroll
                for (int n = 0; n < 2; ++n) xc[bj][n] = xn[bj][n]; }
#undef XLOAD
    }
};
}

__device__ __forceinline__ void phase_A(ArgP a, LAS unsigned char* lds, int tid, int wave, int lane, int bid, int G) {
    float* MODB = (float*)(a->ws + WS_MODB); f32x2* ROPE = (f32x2*)(a->ws + WS_ROPE); float* SCAL = (float*)(a->ws + WS_SCAL);
    for (int u = bid; u < 194; u += G) {
        if (u < 192) {
            const int l = u / 48, n0 = (u % 48) * 64;
            LAS float* act = (LAS float*)lds;
            for (int i = tid; i < 5120; i += 512) { const int b = i >> 10, k = i & 1023; const float v = b < 4 ? a->in[1][b * 1024 + k] : a->in[3][k]; act[i] = v / (1.0f + __expf(-v)); }
            __syncthreads();
            float acc[5] = {0.f, 0.f, 0.f, 0.f, 0.f};
            const float* W = a->in[4] + ((size_t)l * 1024 + wave * 128) * 3072 + n0 + lane;
#pragma unroll 16
            for (int k = 0; k < 128; ++k) { const float w = W[(size_t)k * 3072];
#pragma unroll
                for (int b = 0; b < 5; ++b) acc[b] += act[b * 1024 + wave * 128 + k] * w; }
            LAS float* part = (LAS float*)(lds + 20480);
#pragma unroll
            for (int b = 0; b < 5; ++b) part[(wave * 5 + b) * 64 + lane] = acc[b];
            __syncthreads();
            if (tid < 320) { const int b = tid >> 6, ln = tid & 63; float s = a->in[5][l * 3072 + n0 + ln];
#pragma unroll
                for (int w = 0; w < 8; ++w) s += part[(w * 5 + b) * 64 + ln];
                MODB[(size_t)(l * 5 + b) * 3072 + n0 + ln] = s; }
            __syncthreads();
        } else if (u == 192) {
            for (int i = tid; i < 1024; i += 512) { const int pos = i >> 4, f = i & 15;
                const float inv = exp2f(-(float)f * (13.287712379549449f / 16.0f)); const float ang = (float)pos * inv;
                ROPE[i] = (f32x2){cosf(ang), sinf(ang)}; }
        } else {
            if (tid < NL) { const int l = tid; const float* lp = a->in[14] + l * 256;
                float s1 = 0.f, s2 = 0.f; for (int i = 0; i < 64; ++i) { s1 += lp[i] * lp[64 + i]; s2 += lp[128 + i] * lp[192 + i]; }
                const float li = l == 0 ? 0.2f : l == 1 ? 0.35550907f : l == 2 ? 0.47071302f : 0.55605819f;
                float gq = 0.f, gk = 0.f; for (int i = 0; i < 64; ++i) { gq = fmaxf(gq, fabsf(a->in[12][l * 64 + i])); gk = fmaxf(gk, fabsf(a->in[13][l * 64 + i])); }
                SCAL[l * 8 + 0] = expf(s1) - expf(s2) + li;
                SCAL[l * 8 + 1] = -(64.0f * QSCALE * gq * gk * 1.001f);
                SCAL[l * 8 + 2] = 1.0f - li; }
        }
    }
}

__device__ __forceinline__ void transpose_item(const float* W, int K, int N, bf16_t* WT, LAS float* scr, int item, int lane) {
    const int nblk = N / 32, kb = item / nblk, nb = item % nblk, k0 = 64 * kb, n0 = 32 * nb;
#pragma unroll 8
    for (int i = 0; i < 32; ++i) { const int kk = 2 * i + (lane >> 5); scr[kk * 33 + (lane & 31)] = W[(size_t)(k0 + kk) * N + n0 + (lane & 31)]; }
    asm volatile("s_waitcnt lgkmcnt(0)" ::: "memory");
    const int c = lane & 7;
#pragma unroll
    for (int j = 0; j < 4; ++j) { const int n = (lane >> 3) + 8 * j; const LAS float* s = scr + (8 * c) * 33 + n;
        u32x4 o; o.x = cvt_pk_bf16(s[0 * 33], s[1 * 33]); o.y = cvt_pk_bf16(s[2 * 33], s[3 * 33]); o.z = cvt_pk_bf16(s[4 * 33], s[5 * 33]); o.w = cvt_pk_bf16(s[6 * 33], s[7 * 33]);
        *(u32x4*)(WT + (size_t)(n0 + n) * K + k0 + 8 * c) = o; }
    asm volatile("s_waitcnt lgkmcnt(0)" ::: "memory");
}
__device__ __forceinline__ void convert_weights(ArgP a, int l, LAS unsigned char* lds, int wave, int lane, int gw, int NGW) {
    LAS float* scr = (LAS float*)(lds + wave * 16384);
    unsigned char* wb = a->ws + (size_t)(l & 1) * WS_WSET2;
    bf16_t* WIN = (bf16_t*)(wb + WS_WIN); bf16_t* WBR = (bf16_t*)(wb + WS_WBR); bf16_t* WOUT = (bf16_t*)(wb + WS_WOUT); bf16_t* WLORA = (bf16_t*)(wb + WS_WLORA);
    constexpr int I_IN = (1024 / 64) * (INC / 32), I_BR = (512 / 64) * (1024 / 32), I_OUT = (1024 / 64) * (1024 / 32), I_LORA = 1024;
    constexpr int NITEMS = I_IN + 3 * I_BR + I_OUT + I_LORA;
    for (int it = gw; it < NITEMS; it += NGW) {
        int r = it;
        if (r < I_IN) { transpose_item(a->in[7] + (size_t)l * 1024 * INC, 1024, INC, WIN, scr, r, lane); continue; } r -= I_IN;
        if (r < 3 * I_BR) { const int i = r / I_BR; transpose_item(a->in[26] + ((size_t)l * 3 + i) * 512 * 1024, 512, 1024, WBR + (size_t)i * 1024 * 512, scr, r % I_BR, lane); continue; } r -= 3 * I_BR;
        if (r < I_OUT) { transpose_item(a->in[27] + (size_t)l * 1024 * 1024, 1024, 1024, WOUT, scr, r, lane); continue; } r -= I_OUT;
        {
            const int idx = r * 512 + lane * 8, n = idx >> 8, k = idx & 255, kb = k >> 6, rr = k & 63;
            const bool isw = n < 1024; const int nn = isw ? n : n - 1024, d = nn >> 9, c = nn & 511;
            const float* src = (isw ? a->in[18] : a->in[20]) + ((size_t)(l * 2 + d) * 64 + rr) * 512 + c;
            const bool nz = kb == (isw ? d : 2 + d);
            float f[8];
#pragma unroll
            for (int e = 0; e < 8; ++e) f[e] = nz ? src[(size_t)e * 512] : 0.f;
            *(u32x4*)(WLORA + idx) = pack8(f);
        }
    }
}
__device__ __forceinline__ void phase_B(ArgP a, int l, LAS unsigned char* lds, int tid, int wave, int lane, int bid, int G) {
    const int gw = bid * 8 + wave, NGW = G * 8;
    const float* xin = l == 0 ? a->in[0] : a->out; const float* xcin = l == 0 ? a->in[2] : (const float*)(a->ws + WS_XC);
    const float* modl = (const float*)(a->ws + WS_MODB) + (size_t)l * 5 * 3072; const float* ng = a->in[6] + l * 1024;
    bf16_t* H = (bf16_t*)(a->ws + WS_H);
    for (int m = gw; m < MT; m += NGW) {
        const bool lat = m < ML; const int b = lat ? (m >> 12) : 4;
        const f32x4* xr = (const f32x4*)(lat ? xin + (size_t)m * 1024 : xcin + (size_t)(m - ML) * 1024) + lane;
        f32x4 v[4]; float s = 0.f;
#pragma unroll
        for (int j = 0; j < 4; ++j) { v[j] = xr[64 * j]; s += (v[j].x * v[j].x + v[j].y * v[j].y) + (v[j].z * v[j].z + v[j].w * v[j].w); }
        const float rstd = 1.0f / sqrtf(wave_sum(s) * (1.0f / 1024.0f) + NORM_EPS);
        u32x2* o8 = (u32x2*)(H + (size_t)m * 1024) + lane;
#pragma unroll
        for (int j = 0; j < 4; ++j) { const int c = 4 * lane + 256 * j;
            const f32x4 g = *(const f32x4*)(ng + c), sh = *(const f32x4*)(modl + b * 3072 + c), sc = *(const f32x4*)(modl + b * 3072 + 1024 + c);
            const f32x4 h = v[j] * rstd * g * (1.0f + sc) + sh;
            o8[64 * j] = (u32x2){cvt_pk_bf16(h.x, h.y), cvt_pk_bf16(h.z, h.w)}; }
    }
}

__device__ __forceinline__ void qk_normrope(const u32x4 w, bf16_t* rowp, const float* gain, float oscale, bool rope, int ridx, int cidx, const f32x2* ROPE, int lane) {
    const int sub = lane & 7;
    float x[8]; unpack8(w, x);
    float ss = 0.f;
#pragma unroll
    for (int e = 0; e < 8; ++e) ss += x[e] * x[e];
    ss += __shfl_xor(ss, 1); ss += __shfl_xor(ss, 2); ss += __shfl_xor(ss, 4);
    const float rstd = 1.0f / sqrtf(ss * (1.0f / 64.0f) + NORM_EPS);
    const f32x4 g0 = *(const f32x4*)(gain + sub * 8), g1 = *(const f32x4*)(gain + sub * 8 + 4);
    x[0] *= rstd * g0.x; x[1] *= rstd * g0.y; x[2] *= rstd * g0.z; x[3] *= rstd * g0.w; x[4] *= rstd * g1.x; x[5] *= rstd * g1.y; x[6] *= rstd * g1.z; x[7] *= rstd * g1.w;
    float p[8];
#pragma unroll
    for (int e = 0; e < 8; ++e) p[e] = __shfl_xor(x[e], 2);
    if (rope) {
        const int pos = (sub < 4) ? ridx : cidx; const bool first = (sub & 2) == 0; const f32x4* tb = (const f32x4*)(ROPE + pos * 16 + 8 * (sub & 1));
#pragma unroll
        for (int e2 = 0; e2 < 4; ++e2) { const f32x4 cs = tb[e2];
            x[2 * e2] = first ? (x[2 * e2] * cs.x - p[2 * e2] * cs.y) : (p[2 * e2] * cs.y + x[2 * e2] * cs.x);
            x[2 * e2 + 1] = first ? (x[2 * e2 + 1] * cs.z - p[2 * e2 + 1] * cs.w) : (p[2 * e2 + 1] * cs.w + x[2 * e2 + 1] * cs.z); }
    }
#pragma unroll
    for (int e = 0; e < 8; ++e) x[e] *= oscale;
    *(u32x4*)(rowp + lane * 8) = pack8(x);
}
__device__ __forceinline__ void phase_prep(ArgP a, int l, int tid, int wave, int lane, int bid, int G) {
    const int gw = bid * 8 + wave, NGW = G * 8;
    bf16_t* Kb = (bf16_t*)(a->ws + WS_KB); bf16_t* Qb = (bf16_t*)(a->ws + WS_QB); bf16_t* VA = (bf16_t*)(a->ws + WS_VA);
    const bf16_t* RW = (const bf16_t*)(a->ws + WS_RW); bf16_t* RWP = (bf16_t*)(a->ws + WS_RWP);
    const f32x2* ROPE = (const f32x2*)(a->ws + WS_ROPE);
    const float* qg = a->in[12] + l * 64; const float* kg = a->in[13] + l * 64;
    const float* lng = a->in[8] + l * 512; const float* lnb = a->in[9] + l * 512;
    const float* conv = a->in[16] + (size_t)l * 9 * 512;
    const float* rkk = a->in[21] + l * 512;
    constexpr int PREP_R1 = 56 * 256;
    const int nlo = (PREP_R1 - gw + NGW - 1) / NGW;
    const int gw2 = gw - 32 * 8, NGW2 = NGW - 32 * 8;
    const int nhi = gw2 >= 0 ? (MT - PREP_R1 - gw2 + NGW2 - 1) / NGW2 : 0;
    for (int it = 0; it < nlo + nhi; ++it) {
        const int m = it < nlo ? gw + it * NGW : PREP_R1 + gw2 + (it - nlo) * NGW2;
        const bool lat = m < ML; const int t = lat ? (m & 4095) : ((m - ML) & 255); const int tlast = lat ? 4095 : 255;
        const bf16_t* r0 = RW + (size_t)m * 1536 + lane * 8; const bool hp = t > 0, hn = t < tlast;
        const u32x4 wk = *(const u32x4*)(Kb + (size_t)m * 512 + lane * 8), wq = *(const u32x4*)(Qb + (size_t)m * 512 + lane * 8), wva = *(const u32x4*)(VA + (size_t)m * 512 + lane * 8);
        u32x4 wc[3], wp[3], wn[3];
#pragma unroll
        for (int w = 0; w < 3; ++w) { wc[w] = *(const u32x4*)(r0 + w * 512); wp[w] = (u32x4){0u, 0u, 0u, 0u}; wn[w] = (u32x4){0u, 0u, 0u, 0u};
            if (hp) wp[w] = *(const u32x4*)(r0 + w * 512 - 1536);
            if (hn) wn[w] = *(const u32x4*)(r0 + w * 512 + 1536); }
        qk_normrope(wk, Kb + (size_t)m * 512, kg, 1.0f, lat, t >> 6, t & 63, ROPE, lane);
        qk_normrope(wq, Qb + (size_t)m * 512, qg, QSCALE, lat, t >> 6, t & 63, ROPE, lane);
        {   bf16_t* rp = VA + (size_t)m * 512 + lane * 8; float x[8]; unpack8(wva, x);
            float s = 0.f;
#pragma unroll
            for (int e = 0; e < 8; ++e) s += x[e];
            const float mu = wave_sum(s) * (1.0f / 512.0f); float q = 0.f;
#pragma unroll
            for (int e = 0; e < 8; ++e) { x[e] -= mu; q += x[e] * x[e]; }
            const float rstd = 1.0f / sqrtf(wave_sum(q) * (1.0f / 512.0f) + LN_EPS);
            const f32x4 g0 = *(const f32x4*)(lng + lane * 8), g1 = *(const f32x4*)(lng + lane * 8 + 4), b0 = *(const f32x4*)(lnb + lane * 8), b1 = *(const f32x4*)(lnb + lane * 8 + 4);
            x[0] = x[0] * rstd * g0.x + b0.x; x[1] = x[1] * rstd * g0.y + b0.y; x[2] = x[2] * rstd * g0.z + b0.z; x[3] = x[3] * rstd * g0.w + b0.w;
            x[4] = x[4] * rstd * g1.x + b1.x; x[5] = x[5] * rstd * g1.y + b1.y; x[6] = x[6] * rstd * g1.z + b1.z; x[7] = x[7] * rstd * g1.w + b1.w;
            *(u32x4*)rp = pack8(x); }
        {   float o[3][8];
#pragma unroll
            for (int w = 0; w < 3; ++w) {
                const int ci = (w == 0) ? 1 : (w == 1) ? 2 : 0; const float* tp = conv + (size_t)ci * 3 * 512 + lane * 8;
                float xc[8], xp[8], xn[8]; unpack8(wc[w], xc); unpack8(wp[w], xp); unpack8(wn[w], xn);
                const f32x4 t0a = *(const f32x4*)tp, t0b = *(const f32x4*)(tp + 4), t1a = *(const f32x4*)(tp + 512), t1b = *(const f32x4*)(tp + 516), t2a = *(const f32x4*)(tp + 1024), t2b = *(const f32x4*)(tp + 1028);
#pragma unroll
                for (int e = 0; e < 4; ++e) { o[w][e] = xp[e] * t0a[e] + xc[e] * t1a[e] + xn[e] * t2a[e]; o[w][4 + e] = xp[4 + e] * t0b[e] + xc[4 + e] * t1b[e] + xn[4 + e] * t2b[e]; } }
            float kq[8], ss = 0.f; const f32x4 rk0 = *(const f32x4*)(rkk + lane * 8), rk1 = *(const f32x4*)(rkk + lane * 8 + 4);
#pragma unroll
            for (int e = 0; e < 8; ++e) { kq[e] = o[0][e] * ((e < 4) ? rk0[e & 3] : rk1[e & 3]); ss += kq[e] * kq[e]; }
            ss += __shfl_xor(ss, 1); ss += __shfl_xor(ss, 2); ss += __shfl_xor(ss, 4);
            const float inv = 1.0f / fmaxf(sqrtf(ss), 1e-12f);
#pragma unroll
            for (int e = 0; e < 8; ++e) kq[e] *= inv;
            bf16_t* op = RWP + (size_t)m * 2048 + lane * 8;
            *(u32x4*)(op) = pack8(kq); *(u32x4*)(op + 512) = pack8(o[0]); *(u32x4*)(op + 1024) = pack8(o[1]); *(u32x4*)(op + 1536) = pack8(o[2]); }
    }
}

#define SBAR() __builtin_amdgcn_sched_barrier(0)
__device__ __forceinline__ int crow(int r, int hi) { return (r & 3) + 8 * (r >> 2) + 4 * hi; }
__device__ __forceinline__ int v_st(int k, int c) { const int kk = (k & ~0xC) | ((k & 4) << 1) | ((k & 8) >> 1); return ((kk >> 3) * 4 + (c >> 5)) * 512 + ((kk & 7) * 32 + (c & 31)) * 2; }
__device__ __forceinline__ int v_rd_base(int lane) { return ((lane & 3) << 3) | (((lane >> 2) & 3) << 6) | (((lane >> 4) & 1) << 5) | (((lane >> 5) & 1) << 8); }
constexpr int v_rd_off(int d0, int ks, int half) { return d0 * 512 + ks * 4096 + half * 2048; }
template <int OFF> __device__ __forceinline__ s16x4 tr_read(int vb) {
    s16x4 r; asm volatile("ds_read_b64_tr_b16 %0, %1 offset:%2" : "=&v"(r) : "v"(vb), "i"(OFF) : "memory"); return r;
}
template <int D0> __device__ __forceinline__ void pv_one(f32x16& od, int vb, bf16x8 pa0, bf16x8 pa1, bf16x8 pa2, bf16x8 pa3) {
    const s16x4 l0 = tr_read<v_rd_off(D0, 0, 0)>(vb), h0 = tr_read<v_rd_off(D0, 0, 1)>(vb), l1 = tr_read<v_rd_off(D0, 1, 0)>(vb), h1 = tr_read<v_rd_off(D0, 1, 1)>(vb);
    const s16x4 l2 = tr_read<v_rd_off(D0, 2, 0)>(vb), h2 = tr_read<v_rd_off(D0, 2, 1)>(vb), l3 = tr_read<v_rd_off(D0, 3, 0)>(vb), h3 = tr_read<v_rd_off(D0, 3, 1)>(vb);
    asm volatile("s_waitcnt lgkmcnt(0)" ::: "memory"); SBAR();
#define PK(L, H) (bf16x8){L[0], L[1], L[2], L[3], H[0], H[1], H[2], H[3]}
    od = __builtin_amdgcn_mfma_f32_32x32x16_bf16(pa0, PK(l0, h0), od, 0, 0, 0);
    od = __builtin_amdgcn_mfma_f32_32x32x16_bf16(pa1, PK(l1, h1), od, 0, 0, 0);
    od = __builtin_amdgcn_mfma_f32_32x32x16_bf16(pa2, PK(l2, h2), od, 0, 0, 0);
    od = __builtin_amdgcn_mfma_f32_32x32x16_bf16(pa3, PK(l3, h3), od, 0, 0, 0);
#undef PK
}

namespace att {
constexpr int SHM_V = 16384, SHM_K = 8192, OFF_K = 2 * SHM_V, OFF_WS = OFF_K + 2 * SHM_K;
#define KSWZ(row, colB) ((row) * 128 + ((colB) ^ (((row) & 7) << 4)))
__device__ __forceinline__ void qkt(f32x16& p0, f32x16& p1, const char* Ks, const bf16x8* qr, int r32, int hi) {
    p0 = f32x16{}; p1 = f32x16{};
#pragma unroll
    for (int d0 = 0; d0 < 4; ++d0) { const int cb = (d0 * 16 + hi * 8) * 2;
        const bf16x8 b0 = *reinterpret_cast<const bf16x8*>(Ks + KSWZ(r32, cb));
        const bf16x8 b1 = *reinterpret_cast<const bf16x8*>(Ks + KSWZ(32 + r32, cb));
        p0 = __builtin_amdgcn_mfma_f32_32x32x16_bf16(b0, qr[d0], p0, 0, 0, 0);
        p1 = __builtin_amdgcn_mfma_f32_32x32x16_bf16(b1, qr[d0], p1, 0, 0, 0); }
}
__device__ __forceinline__ void partialSM(f32x16& p0) {
#pragma unroll
    for (int r = 0; r < 16; ++r) p0[r] = __builtin_amdgcn_exp2f(p0[r]);
}
__device__ __forceinline__ void finishSM(f32x16& p0, f32x16& p1, float& l_reg, bf16x8& pa0, bf16x8& pa1, bf16x8& pa2, bf16x8& pa3) {
#pragma unroll
    for (int r = 0; r < 16; ++r) p1[r] = __builtin_amdgcn_exp2f(p1[r]);
    float ps = 0.f;
#pragma unroll
    for (int r = 0; r < 16; ++r) ps += p0[r];
#pragma unroll
    for (int r = 0; r < 16; ++r) ps += p1[r];
    l_reg += ps;
#define PK4(P, BASE, OUT) do { unsigned a0 = cvt_pk_bf16(P[BASE + 0], P[BASE + 1]), a1 = cvt_pk_bf16(P[BASE + 2], P[BASE + 3]);   \
    unsigned b0 = cvt_pk_bf16(P[BASE + 4], P[BASE + 5]), b1 = cvt_pk_bf16(P[BASE + 6], P[BASE + 7]);                              \
    auto r0 = __builtin_amdgcn_permlane32_swap(a0, b0, false, false); auto r1 = __builtin_amdgcn_permlane32_swap(a1, b1, false, false); \
    u32x4 w = {r0[0], r1[0], r0[1], r1[1]}; OUT = *reinterpret_cast<bf16x8*>(&w); } while (0)
    PK4(p0, 0, pa0); PK4(p0, 8, pa1); PK4(p1, 0, pa2); PK4(p1, 8, pa3);
#undef PK4
}
__device__ __forceinline__ void pv_d0(f32x16* o, int vb, bf16x8 pa0, bf16x8 pa1, bf16x8 pa2, bf16x8 pa3) {
    pv_one<0>(o[0], vb, pa0, pa1, pa2, pa3); pv_one<1>(o[1], vb, pa0, pa1, pa2, pa3); pv_one<2>(o[2], vb, pa0, pa1, pa2, pa3); pv_one<3>(o[3], vb, pa0, pa1, pa2, pa3);
}
constexpr int RSK = 272;
constexpr int SHM_K2 = 64 * RSK, OFF_K2 = 2 * SHM_V, OFF_Q2 = OFF_K2 + 2 * SHM_K2, OFF_WS2 = OFF_Q2 + 65536;
template <int S, int HALF_> __device__ __forceinline__ void qkt2(f32x16& p, const char* kr_, const char* qp_) {
    p = f32x16{};
#pragma unroll
    for (int d0 = 0; d0 < 4; ++d0) {
        const bf16x8 b0 = *reinterpret_cast<const bf16x8*>(kr_ + HALF_ * 32 * RSK + S * 128 + d0 * 32);
        const bf16x8 q = *reinterpret_cast<const bf16x8*>(qp_ + (S * 4 + d0) * 1024);
        p = __builtin_amdgcn_mfma_f32_32x32x16_bf16(b0, q, p, 0, 0, 0); }
}
template <int D0, int KH> __device__ __forceinline__ void pv_two(f32x16& oa, f32x16& ob, int vb, bf16x8 pa0, bf16x8 pa1, bf16x8 pb0, bf16x8 pb1) {
    const s16x4 l0 = tr_read<v_rd_off(D0, 2 * KH, 0)>(vb), h0 = tr_read<v_rd_off(D0, 2 * KH, 1)>(vb), l1 = tr_read<v_rd_off(D0, 2 * KH + 1, 0)>(vb), h1 = tr_read<v_rd_off(D0, 2 * KH + 1, 1)>(vb);
    asm volatile("s_waitcnt lgkmcnt(0)" ::: "memory"); SBAR();
#define PK(L, H) (bf16x8){L[0], L[1], L[2], L[3], H[0], H[1], H[2], H[3]}
    const bf16x8 v0 = PK(l0, h0), v1 = PK(l1, h1);
#undef PK
    oa = __builtin_amdgcn_mfma_f32_32x32x16_bf16(pa0, v0, oa, 0, 0, 0); ob = __builtin_amdgcn_mfma_f32_32x32x16_bf16(pb0, v0, ob, 0, 0, 0);
    oa = __builtin_amdgcn_mfma_f32_32x32x16_bf16(pa1, v1, oa, 0, 0, 0); ob = __builtin_amdgcn_mfma_f32_32x32x16_bf16(pb1, v1, ob, 0, 0, 0);
}
__device__ __forceinline__ void attn_unit(ArgP a, int l, int unit, char* lds, const int tid_) {
    int tid = tid_; asm volatile("" : "+v"(tid));
    const int wid = tid >> 6, lane = tid & 63, r32 = lane & 31, hi = lane >> 5;
    const bf16_t* Kb = (const bf16_t*)(a->ws + WS_KB); const bf16_t* Qb = (const bf16_t*)(a->ws + WS_QB); const bf16_t* Vb = (const bf16_t*)(a->ws + WS_VB);
    int b, h, qrow0, t0, NT;
    if (unit < 256) { b = unit >> 6; h = (unit >> 4) & 3; qrow0 = b * 4096 + (unit & 15) * 256; t0 = 0; NT = 68; }
    else { const int cu = unit - 256; b = cu >> 2; h = cu & 3; qrow0 = ML + b * 256; t0 = 64; NT = 4; }
    char* V_lds = lds; char* K_lds = lds + OFF_K2;
    char* qp = lds + OFF_Q2 + wid * 8192 + lane * 16;
    {   const bf16_t* Qw = Qb + (size_t)(qrow0 + wid * 32 + r32) * 512 + h * 128 + hi * 8;
#pragma unroll
        for (int f = 0; f < 8; ++f) *reinterpret_cast<bf16x8*>(qp + f * 1024) = *reinterpret_cast<const bf16x8*>(Qw + (f >> 2) * 64 + (f & 3) * 16); }
    const int kr = tid >> 3, kc = tid & 7;
    const int sr = tid >> 4, sc = (tid & 15) * 8, vst0 = v_st(sr, sc), vst1 = v_st(32 + sr, sc);
    const int vb0 = (int)(uintptr_t)V_lds + v_rd_base(lane);
    const int kst = kr * RSK + kc * 32;
    const char* krd = K_lds + r32 * RSK + hi * 16;
    bf16x8 s_v0, s_v1, s_k0, s_k1;
#define TROW(t) ((t) < 64 ? (size_t)b * 4096 + (size_t)(t) * 64 : (size_t)ML + (size_t)b * 256 + (size_t)((t) - 64) * 64)
    const unsigned voff_ = (unsigned)(sr * 512 + h * 128 + sc) * 2u, koff_ = (unsigned)(kr * 1024 + h * 256 + kc * 32);
#define SLOAD(t) do { const size_t r0_ = TROW(t) * 1024; const char* vt_ = (const char*)Vb + r0_; const char* kt_ = (const char*)Kb + r0_; \
    s_v0 = *reinterpret_cast<const bf16x8*>(vt_ + voff_); s_v1 = *reinterpret_cast<const bf16x8*>(vt_ + 32768 + voff_); \
    s_k0 = *reinterpret_cast<const bf16x8*>(kt_ + koff_); s_k1 = *reinterpret_cast<const bf16x8*>(kt_ + koff_ + 16); } while (0)
#define SWRITE(bb) do { *(bf16x8*)(V_lds + (bb) * SHM_V + vst0) = s_v0; *(bf16x8*)(V_lds + (bb) * SHM_V + vst1) = s_v1; \
    *(bf16x8*)(K_lds + (bb) * SHM_K2 + kst) = s_k0; *(bf16x8*)(K_lds + (bb) * SHM_K2 + kst + 16) = s_k1; } while (0)
#define EXPSUM(L_) do { float ps_ = 0.f; _Pragma("unroll") for (int r_ = 0; r_ < 16; ++r_) { p[r_] = __builtin_amdgcn_exp2f(p[r_]); ps_ += p[r_]; } L_ += ps_; } while (0)
#define PK4(P, BASE, OUT) do { unsigned a0 = cvt_pk_bf16(P[BASE + 0], P[BASE + 1]), a1 = cvt_pk_bf16(P[BASE + 2], P[BASE + 3]);   \
    unsigned b0 = cvt_pk_bf16(P[BASE + 4], P[BASE + 5]), b1 = cvt_pk_bf16(P[BASE + 6], P[BASE + 7]);                              \
    auto r0 = __builtin_amdgcn_permlane32_swap(a0, b0, false, false); auto r1 = __builtin_amdgcn_permlane32_swap(a1, b1, false, false); \
    u32x4 w = {r0[0], r1[0], r0[1], r1[1]}; OUT = *reinterpret_cast<bf16x8*>(&w); } while (0)
    f32x16 o0[4] = {}, o1[4] = {}; float l0 = 0.f, l1 = 0.f;
    SLOAD(t0); SWRITE(0); __syncthreads();
    if (1 < NT) SLOAD(t0 + 1);
#pragma nounroll
    for (int j = 0; j < NT; ++j) {
        int bb = j & 1; asm volatile("" : "+s"(bb));
        if (j + 1 < NT) { SWRITE(bb ^ 1); if (j + 2 < NT) SLOAD(t0 + j + 2); }
        SBAR();
        const char* ks_ = krd + bb * SHM_K2; const int vb_ = vb0 + bb * SHM_V;
        {   f32x16 p; bf16x8 pa0, pa1, pb0, pb1;
            qkt2<0, 0>(p, ks_, qp); EXPSUM(l0); PK4(p, 0, pa0); PK4(p, 8, pa1); SBAR();
            qkt2<1, 0>(p, ks_, qp); EXPSUM(l1); PK4(p, 0, pb0); PK4(p, 8, pb1); SBAR();
            pv_two<0, 0>(o0[0], o1[0], vb_, pa0, pa1, pb0, pb1); pv_two<1, 0>(o0[1], o1[1], vb_, pa0, pa1, pb0, pb1); pv_two<2, 0>(o0[2], o1[2], vb_, pa0, pa1, pb0, pb1); pv_two<3, 0>(o0[3], o1[3], vb_, pa0, pa1, pb0, pb1); }
        SBAR();
        {   f32x16 p; bf16x8 pa0, pa1, pb0, pb1;
            qkt2<0, 1>(p, ks_, qp); EXPSUM(l0); PK4(p, 0, pa0); PK4(p, 8, pa1); SBAR();
            qkt2<1, 1>(p, ks_, qp); EXPSUM(l1); PK4(p, 0, pb0); PK4(p, 8, pb1); SBAR();
            pv_two<0, 1>(o0[0], o1[0], vb_, pa0, pa1, pb0, pb1); pv_two<1, 1>(o0[1], o1[1], vb_, pa0, pa1, pb0, pb1); pv_two<2, 1>(o0[2], o1[2], vb_, pa0, pa1, pb0, pb1); pv_two<3, 1>(o0[3], o1[3], vb_, pa0, pa1, pb0, pb1); }
        __syncthreads();
    }
#undef TROW
#undef SLOAD
#undef SWRITE
#undef EXPSUM
#undef PK4
    int tid2 = tid_; asm volatile("" : "+v"(tid2));
    const int wid2 = tid2 >> 6, lane2 = tid2 & 63, r32e = lane2 & 31, hie = lane2 >> 5;
    { auto rr = __builtin_amdgcn_permlane32_swap(__float_as_uint(l0), __float_as_uint(l0), false, false); l0 = __uint_as_float(rr[0]) + __uint_as_float(rr[1]); }
    { auto rr = __builtin_amdgcn_permlane32_swap(__float_as_uint(l1), __float_as_uint(l1), false, false); l1 = __uint_as_float(rr[0]) + __uint_as_float(rr[1]); }
    const bf16_t* Z = (const bf16_t*)(a->ws + WS_Z); bf16_t* Y = (bf16_t*)(a->ws + WS_RW);
    const float* SCAL = (const float*)(a->ws + WS_SCAL) + l * 8;
    const float lam = SCAL[0], oml = SCAL[2];
    const float* sg = a->in[15] + l * 128;
    float* li_l = (float*)(lds + OFF_WS2) + wid2 * 128;
    if (hie == 0) { li_l[r32e] = l0; li_l[64 + r32e] = l1; } asm volatile("s_waitcnt lgkmcnt(0)" ::: "memory");
    float ss[16];
#pragma unroll
    for (int r = 0; r < 16; ++r) { const float ra = __builtin_amdgcn_rcpf(li_l[crow(r, hie)]), rb_ = lam * __builtin_amdgcn_rcpf(li_l[64 + crow(r, hie)]); float s = 0.f;
#pragma unroll
        for (int d0 = 0; d0 < 4; ++d0) { const float v = o0[d0][r] * ra - o1[d0][r] * rb_; o0[d0][r] = v; s += v * v; }
        s += __shfl_xor(s, 1); s += __shfl_xor(s, 2); s += __shfl_xor(s, 4); s += __shfl_xor(s, 8); s += __shfl_xor(s, 16);
        ss[r] = oml / sqrtf(s * (1.0f / 128.0f) + NORM_EPS); }
    const GAS bf16_t* Z_ = (const GAS bf16_t*)Z; GAS bf16_t* Y_ = (GAS bf16_t*)Y;
#pragma unroll
    for (int d0 = 0; d0 < 4; ++d0) { const int col = h * 128 + d0 * 32 + r32e; const float g = sg[d0 * 32 + r32e];
        const size_t rb = (size_t)(qrow0 + wid2 * 32 + 4 * hie) * 1536 + 512 + col;
        unsigned short zq[16];
#pragma unroll
        for (int r = 0; r < 16; ++r) zq[r] = Z_[rb + (size_t)((r & 3) + 8 * (r >> 2)) * 1536];
#pragma unroll
        for (int r = 0; r < 16; ++r) { const size_t idx = rb + (size_t)((r & 3) + 8 * (r >> 2)) * 1536;
            const float y = o0[d0][r] * ss[r] * g * bf2f(zq[r]);
            Y_[idx] = (bf16_t)(cvt_pk_bf16(y, 0.f) & 0xffffu); }
        asm volatile("" ::: "memory"); }
    asm volatile("s_waitcnt vmcnt(0) lgkmcnt(0)" ::: "memory");
    __syncthreads();
}
}

__device__ __forceinline__ void gmlp_unit(ArgP a, int l, int unit, char* lds, const int tid) {
    const int wid = tid >> 6, lane = tid & 63, r32 = lane & 31, hi = lane >> 5;
    const int chunk = unit >> 2, g = unit & 3; const size_t row0 = (size_t)chunk * 128;
    const bf16_t* VA = (const bf16_t*)(a->ws + WS_VA); const bf16_t* GU = (const bf16_t*)(a->ws + WS_GU); const bf16_t* Z = (const bf16_t*)(a->ws + WS_Z); bf16_t* Y = (bf16_t*)(a->ws + WS_RW);
    const float* Ws = a->in[10] + ((size_t)l * 4 + g) * 128 * 128; const float* bs = a->in[11] + (l * 4 + g) * 128;
    const int sr = tid >> 4, sc = (tid & 15) * 8;
#pragma unroll
    for (int t = 0; t < 2; ++t) {
        const bf16x8 v0 = *reinterpret_cast<const bf16x8*>(VA + (row0 + t * 64 + sr) * 512 + g * 128 + sc);
        const bf16x8 v1 = *reinterpret_cast<const bf16x8*>(VA + (row0 + t * 64 + 32 + sr) * 512 + g * 128 + sc);
        *(bf16x8*)(lds + t * 16384 + v_st(sr, sc)) = v0; *(bf16x8*)(lds + t * 16384 + v_st(32 + sr, sc)) = v1; }
    __syncthreads();
    const int pb = (wid & 3) * 32, ch = wid >> 2;
    const int vb0 = (int)(uintptr_t)lds + v_rd_base(lane);
    f32x16 o0 = {}, o1 = {};
#pragma unroll
    for (int t = 0; t < 2; ++t) {
        bf16x8 pa[4];
#pragma unroll
        for (int ks = 0; ks < 4; ++ks) { const float* wp = Ws + (size_t)(pb + r32) * 128 + t * 64 + ks * 16 + hi * 8;
            const f32x4 w0 = *(const f32x4*)wp, w1 = *(const f32x4*)(wp + 4);
            u32x4 w = {cvt_pk_bf16(w0.x, w0.y), cvt_pk_bf16(w0.z, w0.w), cvt_pk_bf16(w1.x, w1.y), cvt_pk_bf16(w1.z, w1.w)}; pa[ks] = *reinterpret_cast<bf16x8*>(&w); }
        if (ch == 0) { pv_one<0>(o0, vb0 + t * 16384, pa[0], pa[1], pa[2], pa[3]); pv_one<1>(o1, vb0 + t * 16384, pa[0], pa[1], pa[2], pa[3]); }
        else         { pv_one<2>(o0, vb0 + t * 16384, pa[0], pa[1], pa[2], pa[3]); pv_one<3>(o1, vb0 + t * 16384, pa[0], pa[1], pa[2], pa[3]); }
    }
    {   unsigned short gq[32], zq[32]; float bq[16];
#pragma unroll
        for (int r = 0; r < 16; ++r) { const int p = pb + crow(r, hi); bq[r] = bs[p]; const size_t row = row0 + p;
#pragma unroll
            for (int d = 0; d < 2; ++d) { const int col = g * 128 + ch * 64 + d * 32 + r32; gq[2 * r + d] = GU[row * 512 + col]; zq[2 * r + d] = Z[row * 1536 + col]; } }
#pragma unroll
        for (int r = 0; r < 16; ++r) { const int p = pb + crow(r, hi); const size_t row = row0 + p;
#pragma unroll
            for (int d = 0; d < 2; ++d) { const int col = g * 128 + ch * 64 + d * 32 + r32;
                const float s = (d == 0 ? o0[r] : o1[r]) + bq[r];
                const float y = bf2f(gq[2 * r + d]) * s * bf2f(zq[2 * r + d]);
                Y[row * 1536 + col] = (bf16_t)(cvt_pk_bf16(y, 0.f) & 0xffffu); } } }
    __syncthreads();
}

template <int CTRL> __device__ __forceinline__ float dppf(float v) { return __builtin_bit_cast(float, __builtin_amdgcn_update_dpp(0, __builtin_bit_cast(int, v), CTRL, 0xF, 0xF, true)); }
__device__ __forceinline__ float allreduce16(float x) { x += dppf<0xB1>(x); x += dppf<0x4E>(x); x += dppf<0x141>(x); x += dppf<0x140>(x); return x; }
namespace scanc {
constexpr int CS = 16, NBLK = (256 + 4096) / CS;
constexpr int RS = 144;
constexpr int O_AK = 0, O_KHB = 32 * RS, O_V = 64 * RS, O_T = 80 * RS, O_X = O_T + 1024, O_BK = O_X + 1024, O_NBB = O_BK + 1024, O_GC = O_NBB + 1024, O_F = O_GC + 256, SLOT = O_F + 2048, NSLOT = 6;
constexpr int O_CTL = NSLOT * SLOT;
__device__ __forceinline__ int perm16(int m) { return 8 * ((m >> 2) & 1) + 4 * (m >> 3) + (m & 3); }
__device__ __forceinline__ bf16x8 pack_tile8(const f32x16& x, int base) {
    u32x4 w = {cvt_pk_bf16(x[base + 0], x[base + 1]), cvt_pk_bf16(x[base + 2], x[base + 3]), cvt_pk_bf16(x[base + 4], x[base + 5]), cvt_pk_bf16(x[base + 6], x[base + 7])};
    return __builtin_bit_cast(bf16x8, w);
}
__device__ __forceinline__ unsigned short f2bf_s(float f) { return (unsigned short)(cvt_pk_bf16(f, 0.f) & 0xffffu); }
constexpr int O_ID = O_CTL + 1024;
__device__ __forceinline__ void scan_unit(ArgP a, int l, int chain, LAS char* lds, const int tid, unsigned* ctxflag) {
    const int wid = __builtin_amdgcn_readfirstlane(tid >> 6), lane = tid & 63, r32 = lane & 31, hi = lane >> 5;
    const int d = chain >> 5, b = (chain >> 3) & 3, h = chain & 7;
    const bf16_t* RWP = (const bf16_t*)(a->ws + WS_RWP); const bf16_t* WA = (const bf16_t*)(a->ws + WS_WA); bf16_t* YD = (bf16_t*)(a->ws + WS_YD) + (size_t)d * MT * 512;
    volatile LAS unsigned* ctl = (volatile LAS unsigned*)(lds + O_CTL);
    if (tid < 8) ctl[tid] = 0u;
    *(LAS float*)(lds + O_ID + (tid >> 5) * 128 + (tid & 31) * 4) = (tid >> 5) == (tid & 31) ? 1.0f : 0.f;
    __syncthreads();
#define ROWOF(s) ((s) < 256 ? (size_t)ML + (size_t)b * 256 + (size_t)(d ? 255 - (s) : (s)) : (size_t)b * 4096 + (size_t)(d ? 4095 - ((s) - 256) : (s) - 256))
    if (wid >= 2) {
        const int sw = wid - 2; LAS char* sl = lds + sw * SLOT;
        const int st = lane & 15, cq = lane >> 4, ps = perm16(st);
        const float* kap = a->in[22] + l * 512 + h * 64 + cq * 16;
        const f32x4 ka0 = *(const f32x4*)kap, ka1 = *(const f32x4*)(kap + 4), ka2 = *(const f32x4*)(kap + 8), ka3 = *(const f32x4*)(kap + 12);
        const int hig = lane >> 5, jj = (r32 & 15) - 4 * hig;
        const int goff = O_F + hig * 512 + r32 * 4;
        const int boff = (r32 < 16 ? O_BK + (r32 & 15) * 2 : O_NBB + perm16(r32 & 15) * 2) + hig * 128;
        const int sc_ = lane & 15; const bool isT = lane < 16;
        const int ooff = isT ? O_T + perm16(sc_) * 2 : O_X + sc_ * 2;
        u32x4 W[12];
#define LOADRAW(bb_) do { const size_t rw = ROWOF((bb_) * CS + st); const bf16_t* p = RWP + rw * 2048 + h * 64 + cq * 16; const bf16_t* q = WA + rw * 2048 + d * 512 + h * 64 + cq * 16; \
            W[0] = *(const u32x4*)p; W[1] = *(const u32x4*)(p + 8); W[2] = *(const u32x4*)(p + 512); W[3] = *(const u32x4*)(p + 520); W[4] = *(const u32x4*)(p + 1024); W[5] = *(const u32x4*)(p + 1032); \
            W[6] = *(const u32x4*)(p + 1536); W[7] = *(const u32x4*)(p + 1544); W[8] = *(const u32x4*)q; W[9] = *(const u32x4*)(q + 8); W[10] = *(const u32x4*)(q + 1024); W[11] = *(const u32x4*)(q + 1032); } while (0)
        LOADRAW(sw);
        for (int bi = sw; bi < NBLK; bi += NSLOT) {
            if (bi >= NSLOT) { const unsigned need = (unsigned)(bi - NSLOT + 1); while (ctl[6] < need || ctl[7] < need) __builtin_amdgcn_s_sleep(1); }
            asm volatile("" ::: "memory");
            {
                *(LAS u32x4*)(sl + O_V + st * RS + cq * 32) = W[4]; *(LAS u32x4*)(sl + O_V + st * RS + cq * 32 + 16) = W[5];
                float kk[16], kx[16], rr[16], om[16], aa[16];
                unpack8(W[0], *(float(*)[8])&kk[0]); unpack8(W[1], *(float(*)[8])&kk[8]); unpack8(W[2], *(float(*)[8])&kx[0]); unpack8(W[3], *(float(*)[8])&kx[8]);
                unpack8(W[6], *(float(*)[8])&rr[0]); unpack8(W[7], *(float(*)[8])&rr[8]);
                unpack8(W[8], *(float(*)[8])&om[0]); unpack8(W[9], *(float(*)[8])&om[8]); unpack8(W[10], *(float(*)[8])&aa[0]); unpack8(W[11], *(float(*)[8])&aa[8]);
                { const int bn = bi + NSLOT < NBLK ? bi + NSLOT : NBLK - 1; LOADRAW(bn); }
                unsigned ktp[8], rtp[8], khp[8], bhp[8]; float G[16];
#pragma unroll
                for (int c = 0; c < 16; ++c) G[c] = 1.0f - om[c];
#define DPPL(S) "v_mul_f32_dpp %0, %0, %0 " S " row_mask:0xf bank_mask:0xf\n v_mul_f32_dpp %1, %1, %1 " S " row_mask:0xf bank_mask:0xf\n v_mul_f32_dpp %2, %2, %2 " S " row_mask:0xf bank_mask:0xf\n v_mul_f32_dpp %3, %3, %3 " S " row_mask:0xf bank_mask:0xf\n" \
                "v_mul_f32_dpp %4, %4, %4 " S " row_mask:0xf bank_mask:0xf\n v_mul_f32_dpp %5, %5, %5 " S " row_mask:0xf bank_mask:0xf\n v_mul_f32_dpp %6, %6, %6 " S " row_mask:0xf bank_mask:0xf\n v_mul_f32_dpp %7, %7, %7 " S " row_mask:0xf bank_mask:0xf\n" \
                "v_mul_f32_dpp %8, %8, %8 " S " row_mask:0xf bank_mask:0xf\n v_mul_f32_dpp %9, %9, %9 " S " row_mask:0xf bank_mask:0xf\n v_mul_f32_dpp %10, %10, %10 " S " row_mask:0xf bank_mask:0xf\n v_mul_f32_dpp %11, %11, %11 " S " row_mask:0xf bank_mask:0xf\n" \
                "v_mul_f32_dpp %12, %12, %12 " S " row_mask:0xf bank_mask:0xf\n v_mul_f32_dpp %13, %13, %13 " S " row_mask:0xf bank_mask:0xf\n v_mul_f32_dpp %14, %14, %14 " S " row_mask:0xf bank_mask:0xf\n v_mul_f32_dpp %15, %15, %15 " S " row_mask:0xf bank_mask:0xf\n"
                asm volatile("s_nop 1\n" DPPL("row_shr:1") DPPL("row_shr:2") DPPL("row_shr:4") DPPL("row_shr:8") "s_nop 1\n"
                    : "+v"(G[0]), "+v"(G[1]), "+v"(G[2]), "+v"(G[3]), "+v"(G[4]), "+v"(G[5]), "+v"(G[6]), "+v"(G[7]), "+v"(G[8]), "+v"(G[9]), "+v"(G[10]), "+v"(G[11]), "+v"(G[12]), "+v"(G[13]), "+v"(G[14]), "+v"(G[15]));
#undef DPPL
#pragma unroll
                for (int m = 0; m < 8; ++m) { float v4[8];
#pragma unroll
                    for (int e = 0; e < 2; ++e) { const int c = 2 * m + e; const float g = G[c];
                        const float gp = __builtin_bit_cast(float, __builtin_amdgcn_update_dpp(0x3f800000, __builtin_bit_cast(int, g), 0x111, 0xF, 0xF, false));
                        const float ig = __builtin_amdgcn_rcpf(g);
                        const float kac = c < 4 ? ka0[c & 3] : c < 8 ? ka1[c & 3] : c < 12 ? ka2[c & 3] : ka3[c & 3];
                        const float kd = kx[c] * (1.0f + (aa[c] - 1.0f) * kac), be = kk[c] * aa[c];
                        v4[e] = kk[c] * gp; v4[2 + e] = rr[c] * g; v4[4 + e] = kd * ig; v4[6 + e] = be * ig; }
                    ktp[m] = cvt_pk_bf16(v4[0], v4[1]); rtp[m] = cvt_pk_bf16(v4[2], v4[3]); khp[m] = cvt_pk_bf16(v4[4], v4[5]); bhp[m] = cvt_pk_bf16(v4[6], v4[7]); }
                *(LAS u32x4*)(sl + O_AK + st * RS + cq * 32) = (u32x4){ktp[0], ktp[1], ktp[4], ktp[5]}; *(LAS u32x4*)(sl + O_AK + st * RS + cq * 32 + 16) = (u32x4){ktp[2], ktp[3], ktp[6], ktp[7]};
                *(LAS u32x4*)(sl + O_AK + (16 + st) * RS + cq * 32) = (u32x4){rtp[0], rtp[1], rtp[4], rtp[5]}; *(LAS u32x4*)(sl + O_AK + (16 + st) * RS + cq * 32 + 16) = (u32x4){rtp[2], rtp[3], rtp[6], rtp[7]};
                *(LAS u32x4*)(sl + O_KHB + st * RS + cq * 32) = (u32x4){khp[0], khp[1], khp[2], khp[3]}; *(LAS u32x4*)(sl + O_KHB + st * RS + cq * 32 + 16) = (u32x4){khp[4], khp[5], khp[6], khp[7]};
                *(LAS u32x4*)(sl + O_KHB + (16 + st) * RS + cq * 32) = (u32x4){bhp[0] ^ 0x80008000u, bhp[1] ^ 0x80008000u, bhp[2] ^ 0x80008000u, bhp[3] ^ 0x80008000u};
                *(LAS u32x4*)(sl + O_KHB + (16 + st) * RS + cq * 32 + 16) = (u32x4){bhp[4] ^ 0x80008000u, bhp[5] ^ 0x80008000u, bhp[6] ^ 0x80008000u, bhp[7] ^ 0x80008000u};
                if (st == 15) {
                    *(LAS f32x4*)(sl + O_GC + cq * 64) = (f32x4){G[0], G[1], G[2], G[3]}; *(LAS f32x4*)(sl + O_GC + cq * 64 + 16) = (f32x4){G[4], G[5], G[6], G[7]};
                    *(LAS f32x4*)(sl + O_GC + cq * 64 + 32) = (f32x4){G[8], G[9], G[10], G[11]}; *(LAS f32x4*)(sl + O_GC + cq * 64 + 48) = (f32x4){G[12], G[13], G[14], G[15]}; }
            }
            asm volatile("s_waitcnt lgkmcnt(0)" ::: "memory");
            f32x16 gr = {};
            {   const LAS char* ga = sl + O_AK + r32 * RS + hig * 16; const LAS char* gb = sl + O_KHB + r32 * RS + hig * 8;
                bf16x8 fa[4]; u32x2 fl[4], fh[4];
#pragma unroll
                for (int q = 0; q < 4; ++q) { fa[q] = *(const LAS bf16x8*)(ga + q * 32); fl[q] = *(const LAS u32x2*)(gb + q * 32); fh[q] = *(const LAS u32x2*)(gb + q * 32 + 16); }
#pragma unroll
                for (int q = 0; q < 4; ++q) { const u32x4 fb = {fl[q][0], fl[q][1], fh[q][0], fh[q][1]};
                    gr = __builtin_amdgcn_mfma_f32_32x32x16_bf16(fa[q], __builtin_bit_cast(bf16x8, fb), gr, 0, 0, 0); } }
#pragma unroll
            for (int r = 0; r < 16; ++r) { const int cr = (r & 3) + 8 * (r >> 2);
                const bool keep = r < 8 ? (jj < cr) : (jj <= cr - 16); const float g = keep ? gr[r] : 0.f;
                if (r < 8) *(LAS float*)(sl + goff + cr * 128) = g;
                else *(LAS unsigned short*)(sl + boff + (cr - 16) * 32) = f2bf_s(g); }
            asm volatile("s_waitcnt lgkmcnt(0)" ::: "memory");
            if (lane < 32) { const LAS char* rhs = isT ? lds + O_ID + sc_ * 4 : sl + O_F + sc_ * 4; float t[CS];
#pragma unroll
                for (int i = 0; i < CS; ++i) t[i] = *(const LAS float*)(rhs + i * 128);
#define ABQ(i, q) (*(const LAS f32x4*)(sl + O_F + (i) * 128 + 64 + (q) * 16))
#define SROW(i, Q0, Q1, Q2, Q3) do { const f32x4 qq_[4] = {Q0, Q1, Q2, Q3}; f32x2 acc2 = {t[i], 0.f}; \
                    _Pragma("unroll") for (int j = 0; j + 1 < (i); j += 2) acc2 += (f32x2){qq_[j >> 2][j & 3], qq_[(j + 1) >> 2][(j + 1) & 3]} * (f32x2){t[j], t[j + 1]}; \
                    float acc = acc2[0] + acc2[1]; if ((i) & 1) acc += qq_[((i) - 1) >> 2][((i) - 1) & 3] * t[(i) - 1]; t[i] = acc; } while (0)
                {   const f32x4 a1 = ABQ(1, 0), a2 = ABQ(2, 0), a3 = ABQ(3, 0), a4 = ABQ(4, 0), a50 = ABQ(5, 0), a51 = ABQ(5, 1), a60 = ABQ(6, 0), a61 = ABQ(6, 1), a70 = ABQ(7, 0), a71 = ABQ(7, 1), a80 = ABQ(8, 0), a81 = ABQ(8, 1);
                    SBAR();
                    SROW(1, a1, a1, a1, a1); SROW(2, a2, a2, a2, a2); SROW(3, a3, a3, a3, a3); SROW(4, a4, a4, a4, a4);
                    SROW(5, a50, a51, a51, a51); SROW(6, a60, a61, a61, a61); SROW(7, a70, a71, a71, a71); SROW(8, a80, a81, a81, a81); }
                SBAR();
                {   const f32x4 a90 = ABQ(9, 0), a91 = ABQ(9, 1), a92 = ABQ(9, 2), aa0 = ABQ(10, 0), aa1 = ABQ(10, 1), aa2 = ABQ(10, 2), ab0 = ABQ(11, 0), ab1 = ABQ(11, 1), ab2 = ABQ(11, 2), ac0 = ABQ(12, 0), ac1 = ABQ(12, 1), ac2 = ABQ(12, 2);
                    SBAR();
                    SROW(9, a90, a91, a92, a92); SROW(10, aa0, aa1, aa2, aa2); SROW(11, ab0, ab1, ab2, ab2); SROW(12, ac0, ac1, ac2, ac2); }
                SBAR();
                {   const f32x4 ad0 = ABQ(13, 0), ad1 = ABQ(13, 1), ad2 = ABQ(13, 2), ad3 = ABQ(13, 3), ae0 = ABQ(14, 0), ae1 = ABQ(14, 1), ae2 = ABQ(14, 2), ae3 = ABQ(14, 3), af0 = ABQ(15, 0), af1 = ABQ(15, 1), af2 = ABQ(15, 2), af3 = ABQ(15, 3);
                    SBAR();
                    SROW(13, ad0, ad1, ad2, ad3); SROW(14, ae0, ae1, ae2, ae3); SROW(15, af0, af1, af2, af3); }
#undef SROW
#undef ABQ
#pragma unroll
                for (int i = 0; i < CS; ++i) *(LAS unsigned short*)(sl + ooff + i * 32) = f2bf_s(t[i]); }
            asm volatile("s_waitcnt lgkmcnt(0)" ::: "memory");
            if (lane == 0) ctl[sw] = (unsigned)(bi + 1);
        }
    } else {
        f32x16 Z0 = {}, Z1 = {};
        const int rho = wid * 32 + r32;
        const int trb = (int)(uintptr_t)lds + ((lane >> 2) & 3) * RS + (16 * ((lane >> 4) & 1) + 4 * (lane & 3)) * 2;
        const int trk = trb + 8 * hi * RS, trn = trb + 4 * hi * RS;
        const unsigned yoff = (unsigned)(((d ? 15 - 4 * hi : 4 * hi) * 512 + h * 64 + rho) * 2);
        for (int bi = 0; bi < NBLK; ++bi) {
            const int sw = bi % NSLOT; const LAS char* sl = lds + sw * SLOT;
            while (ctl[sw] != (unsigned)(bi + 1)) __builtin_amdgcn_s_sleep(1);
            asm volatile("" ::: "memory");
            const LAS char* ra = sl + r32 * RS + hi * 16; const LAS char* rb = sl + r32 * 32 + hi * 16;
            const bf16x8 ak0 = *(const LAS bf16x8*)(ra + O_AK), ak1 = *(const LAS bf16x8*)(ra + O_AK + 32), ak2 = *(const LAS bf16x8*)(ra + O_AK + 64), ak3 = *(const LAS bf16x8*)(ra + O_AK + 96);
            const bf16x8 tq = *(const LAS bf16x8*)(rb + O_T), xq = *(const LAS bf16x8*)(rb + O_X), bkq = *(const LAS bf16x8*)(rb + O_BK), nbbq = *(const LAS bf16x8*)(rb + O_NBB);
            const int tk = trk + sw * SLOT, tn = trn + sw * SLOT;
            const s16x4 kb0l = tr_read<O_KHB>(tk), kb0h = tr_read<O_KHB + 4 * RS>(tk), kb1l = tr_read<O_KHB + 64>(tk), kb1h = tr_read<O_KHB + 4 * RS + 64>(tk);
            const s16x4 nb0l = tr_read<O_KHB + 16 * RS>(tn), nb0h = tr_read<O_KHB + 24 * RS>(tn), nb1l = tr_read<O_KHB + 16 * RS + 64>(tn), nb1h = tr_read<O_KHB + 24 * RS + 64>(tn);
            const s16x4 vfl = tr_read<O_V>(tk + wid * 64), vfh = tr_read<O_V + 4 * RS>(tk + wid * 64);
            f32x4 gc0[4], gc1[4];
            {   const LAS float* gc = (const LAS float*)(sl + O_GC) + 4 * hi;
#pragma unroll
                for (int g4 = 0; g4 < 4; ++g4) { gc0[g4] = *(const LAS f32x4*)(gc + 8 * g4); gc1[g4] = *(const LAS f32x4*)(gc + 32 + 8 * g4); } }
            asm volatile("s_waitcnt lgkmcnt(0)" ::: "memory"); SBAR();
#define PK(L, H) (bf16x8){L[0], L[1], L[2], L[3], H[0], H[1], H[2], H[3]}
            const bf16x8 kb0 = PK(kb0l, kb0h), kb1 = PK(kb1l, kb1h), nb0 = PK(nb0l, nb0h), nb1 = PK(nb1l, nb1h), vf = PK(vfl, vfh);
#undef PK
            f32x16 a1 = {};
            a1 = __builtin_amdgcn_mfma_f32_32x32x16_bf16(ak0, pack_tile8(Z0, 0), a1, 0, 0, 0);
            a1 = __builtin_amdgcn_mfma_f32_32x32x16_bf16(ak1, pack_tile8(Z0, 8), a1, 0, 0, 0);
            a1 = __builtin_amdgcn_mfma_f32_32x32x16_bf16(ak2, pack_tile8(Z1, 0), a1, 0, 0, 0);
            a1 = __builtin_amdgcn_mfma_f32_32x32x16_bf16(ak3, pack_tile8(Z1, 8), a1, 0, 0, 0);
            f32x16 a2 = {};
            a2 = __builtin_amdgcn_mfma_f32_32x32x16_bf16(xq, vf, a2, 0, 0, 0);
            a2 = __builtin_amdgcn_mfma_f32_32x32x16_bf16(tq, pack_tile8(a1, 0), a2, 0, 0, 0);
            f32x16 a3 = {};
            a3 = __builtin_amdgcn_mfma_f32_32x32x16_bf16(bkq, vf, a3, 0, 0, 0);
            Z0 = __builtin_amdgcn_mfma_f32_32x32x16_bf16(kb0, vf, Z0, 0, 0, 0);
            Z1 = __builtin_amdgcn_mfma_f32_32x32x16_bf16(kb1, vf, Z1, 0, 0, 0);
            const bf16x8 sf = pack_tile8(a2, 0);
            Z0 = __builtin_amdgcn_mfma_f32_32x32x16_bf16(nb0, sf, Z0, 0, 0, 0);
            Z1 = __builtin_amdgcn_mfma_f32_32x32x16_bf16(nb1, sf, Z1, 0, 0, 0);
            a3 = __builtin_amdgcn_mfma_f32_32x32x16_bf16(nbbq, sf, a3, 0, 0, 0);
            if (lane == 0) ctl[6 + wid] = (unsigned)(bi + 1);
#pragma unroll
            for (int g4 = 0; g4 < 4; ++g4) {
#pragma unroll
                for (int e = 0; e < 4; ++e) { Z0[4 * g4 + e] *= gc0[g4][e]; Z1[4 * g4 + e] *= gc1[g4][e]; } }
            {   const int s0 = bi * CS; const int rlo = s0 < 256 ? ML + b * 256 + (d ? 240 - s0 : s0) : b * 4096 + (d ? 4080 - (s0 - 256) : s0 - 256);
                const char* yb = (const char*)YD + (size_t)rlo * 1024;
                if (bi < 16) {
#pragma unroll
                    for (int r = 0; r < 8; ++r) { const int cr = (r & 3) + 8 * (r >> 2);
                        __hip_atomic_store((unsigned short*)(yb + (d ? -cr : cr) * 1024 + yoff), f2bf_s(a3[r] + a1[8 + r]), __ATOMIC_RELAXED, __HIP_MEMORY_SCOPE_AGENT); }
                    if (bi == 15) { asm volatile("s_waitcnt vmcnt(0)" ::: "memory"); if (lane == 0) (void)__hip_atomic_fetch_add(ctxflag, 1u, __ATOMIC_RELAXED, __HIP_MEMORY_SCOPE_AGENT); }
                } else {
#pragma unroll
                    for (int r = 0; r < 8; ++r) { const int cr = (r & 3) + 8 * (r >> 2);
                        *(unsigned short*)(yb + (d ? -cr : cr) * 1024 + yoff) = f2bf_s(a3[r] + a1[8 + r]); } } }
        }
    }
#undef ROWOF
#undef LOADRAW
    __syncthreads();
}
}

__device__ __forceinline__ void phase_readout(ArgP a, int l, int lane, int m0, int m1, int gw, int NGW) {
    const bf16_t* YD = (const bf16_t*)(a->ws + WS_YD); const bf16_t* RWP = (const bf16_t*)(a->ws + WS_RWP); const bf16_t* Z = (const bf16_t*)(a->ws + WS_Z); bf16_t* Y = (bf16_t*)(a->ws + WS_RW);
    const float* lng = a->in[24] + l * 512 + lane * 8; const float* lnb = a->in[25] + l * 512 + lane * 8; const float* rk = a->in[23] + l * 512 + lane * 8;
    for (int m = m0 + gw; m < m1; m += NGW) {
        float y0[8], y1[8], k[8], v[8], r[8], zc[8];
        unpack8(*(const u32x4*)(YD + (size_t)m * 512 + lane * 8), y0); unpack8(*(const u32x4*)(YD + ((size_t)MT + m) * 512 + lane * 8), y1);
        const bf16_t* rp = RWP + (size_t)m * 2048 + lane * 8;
        unpack8(*(const u32x4*)(rp + 512), k); unpack8(*(const u32x4*)(rp + 1024), v); unpack8(*(const u32x4*)(rp + 1536), r);
        unpack8(*(const u32x4*)(Z + (size_t)m * 1536 + 1024 + lane * 8), zc);
        float s = 0.f, rks = 0.f; const f32x4 rka = *(const f32x4*)rk, rkb = *(const f32x4*)(rk + 4);
#pragma unroll
        for (int e = 0; e < 8; ++e) { y0[e] += y1[e]; s += y0[e]; rks += r[e] * k[e] * ((e < 4) ? rka[e & 3] : rkb[e & 3]); }
        s += __shfl_xor(s, 1); s += __shfl_xor(s, 2); s += __shfl_xor(s, 4);
        rks += __shfl_xor(rks, 1); rks += __shfl_xor(rks, 2); rks += __shfl_xor(rks, 4);
        const float mu = s * (1.0f / 64.0f); float q = 0.f;
#pragma unroll
        for (int e = 0; e < 8; ++e) { y0[e] -= mu; q += y0[e] * y0[e]; }
        q += __shfl_xor(q, 1); q += __shfl_xor(q, 2); q += __shfl_xor(q, 4);
        const float rstd = 1.0f / sqrtf(q * (1.0f / 64.0f) + GN_EPS);
        float o[8]; const f32x4 g0 = *(const f32x4*)lng, g1 = *(const f32x4*)(lng + 4), b0 = *(const f32x4*)lnb, b1 = *(const f32x4*)(lnb + 4);
#pragma unroll
        for (int e = 0; e < 4; ++e) { o[e] = (y0[e] * rstd * g0[e] + b0[e] + rks * v[e]) * zc[e]; o[4 + e] = (y0[4 + e] * rstd * g1[e] + b1[e] + rks * v[4 + e]) * zc[4 + e]; }
        *(u32x4*)(Y + (size_t)m * 1536 + 1024 + lane * 8) = pack8(o);
    }
}


#define XB_TMO      128
#define XB_XCNT(j)  (256  + 64 * (j))
#define XB_XSUB(j)  (1280 + 64 * (j))
#define XB_XGEN(j)  (2304 + 64 * (j))
#define XB_TOP      3328
#define XB_TOPGEN   3392
#define XCD_BAR_WORDS 3456
#define XB_SPIN_CAP (1u << 22)
__device__ __forceinline__ unsigned xb_ld(unsigned* p)              { return __hip_atomic_load(p, __ATOMIC_RELAXED, __HIP_MEMORY_SCOPE_AGENT); }
__device__ __forceinline__ unsigned xb_add(unsigned* p, unsigned v) { return __hip_atomic_fetch_add(p, v, __ATOMIC_RELAXED, __HIP_MEMORY_SCOPE_AGENT); }
__device__ __forceinline__ unsigned xb_xcc_id() { return (unsigned)__builtin_amdgcn_s_getreg((3 << 11) | 20) & 0xFu; }
#define XB_SPIN(cond, bar) do { unsigned _sp = 0; while (cond) { __builtin_amdgcn_s_sleep(1); \
    if ((++_sp & 255u) == 0u) { if (xb_ld(&(bar)[XB_TMO])) break; if (_sp > XB_SPIN_CAP) { atomicAdd(&(bar)[XB_TMO], 1u); break; } } } } while (0)
struct XcdBarrier { unsigned* bar; unsigned x; volatile LAS unsigned* st; };
__device__ __forceinline__ XcdBarrier xcd_barrier_post(unsigned* bar, volatile LAS unsigned* st) {
    XcdBarrier b; b.bar = bar; b.x = xb_xcc_id(); b.st = st;
    if (threadIdx.x == 0) (void)xb_add(&bar[XB_XCNT(b.x)], 1u);
    return b;
}
__device__ __forceinline__ void xcd_barrier_complete(unsigned* bar, unsigned x, unsigned& nloc, unsigned& nx) {
    const unsigned G = gridDim.x * gridDim.y * gridDim.z;
    unsigned sum, cnt, mine, sp = 0u;
    for (;;) {
        sum = 0u; cnt = 0u; mine = 0u;
#pragma unroll
        for (unsigned j = 0; j < 16; ++j) { const unsigned c = xb_ld(&bar[XB_XCNT(j)]); sum += c; cnt += (c > 0u) ? 1u : 0u; mine = (j == x) ? c : mine; }
        if (sum == G) break;
        __builtin_amdgcn_s_sleep(1);
        if ((++sp & 255u) == 0u) { if (xb_ld(&bar[XB_TMO])) break; if (sp > XB_SPIN_CAP) { atomicAdd(&bar[XB_TMO], 1u); break; } }
    }
    nloc = mine > 0u ? mine : 1u; nx = cnt > 0u ? cnt : 1u;
}
__device__ __forceinline__ void xcd_barrier(const XcdBarrier& b) {
    asm volatile("s_waitcnt vmcnt(0)" ::: "memory");
    __syncthreads();
    if (threadIdx.x == 0) {
        unsigned* bar = b.bar;
        __builtin_amdgcn_s_waitcnt(0);
        unsigned nloc = b.st[0], nx = b.st[1];
        if (nloc == 0u) { xcd_barrier_complete(bar, b.x, nloc, nx); b.st[0] = nloc; b.st[1] = nx; }
        const unsigned old = xb_add(&bar[XB_XSUB(b.x)], 1u);
        const unsigned gen = old / nloc;
        if (old + 1u == (gen + 1u) * nloc) {
            __builtin_amdgcn_fence(__ATOMIC_RELEASE, "agent");
            asm volatile("s_waitcnt vmcnt(0)" ::: "memory");
            const unsigned og = xb_add(&bar[XB_TOP], 1u);
            const unsigned tg = og / nx;
            if (og + 1u == (tg + 1u) * nx) xb_add(&bar[XB_TOPGEN], 1u);
            else XB_SPIN(xb_ld(&bar[XB_TOPGEN]) == tg, bar);
            __builtin_amdgcn_fence(__ATOMIC_ACQUIRE, "agent");
            xb_add(&bar[XB_XGEN(b.x)], 1u);
            asm volatile("s_waitcnt vmcnt(0)" ::: "memory");
        } else {
            XB_SPIN(xb_ld(&bar[XB_XGEN(b.x)]) == gen, bar);
            __builtin_amdgcn_fence(__ATOMIC_ACQUIRE, "agent");
            asm volatile("s_waitcnt vmcnt(0)" ::: "memory");
        }
    }
    __syncthreads();
}
constexpr int LDS_MISC = 139264;
constexpr size_t WS_BAR = 4096;
constexpr size_t CTL_ZERO_BYTES = 65536;

__device__ __forceinline__ void group_barrier(unsigned* ctr, unsigned nblk) {
    asm volatile("s_waitcnt vmcnt(0)" ::: "memory");
    __syncthreads();
    if (threadIdx.x == 0) {
        __builtin_amdgcn_fence(__ATOMIC_RELEASE, "agent");
        asm volatile("s_waitcnt vmcnt(0)" ::: "memory");
        (void)xb_add(ctr, 1u);
        unsigned sp = 0u;
        while (xb_ld(ctr) < nblk) { __builtin_amdgcn_s_sleep(1); if (++sp > XB_SPIN_CAP) break; }
        __builtin_amdgcn_fence(__ATOMIC_ACQUIRE, "agent");
        asm volatile("s_waitcnt vmcnt(0)" ::: "memory");
    }
    __syncthreads();
}
constexpr size_t WS_GBAR = 32768;

constexpr int NPH_L = 8;
constexpr int NPHASES = 1 + NL * NPH_L;

template <int ONLY>
__global__ void __launch_bounds__(512, 2) mk_fwd(Args args) {
    extern __shared__ __attribute__((aligned(16))) unsigned char lds_raw[];
    LAS unsigned char* lds = (LAS unsigned char*)lds_raw;
    const int G = gridDim.x;
#if MK_ONE_LAUNCH
    if (threadIdx.x < 2) ((volatile LAS unsigned*)(lds + LDS_MISC))[threadIdx.x] = 0u;
    __syncthreads();
    XcdBarrier xbar = xcd_barrier_post((unsigned*)(args.ws + WS_BAR), (volatile LAS unsigned*)(lds + LDS_MISC));
    if (args.ph_hi > 100000) cg::this_grid().sync();
#endif
    for (int ph = args.ph_lo; ph < args.ph_hi; ++ph) {
        int tid = threadIdx.x; asm volatile("" : "+v"(tid));
        int bid = blockIdx.x; asm volatile("" : "+s"(bid));
        ArgP A = (ArgP)__builtin_amdgcn_kernarg_segment_ptr(); asm volatile("" : "+s"(A));
        const int lane = tid & 63, wave = __builtin_amdgcn_readfirstlane(tid >> 6);
        unsigned char* ws = A->ws;
        if (ph == 0) { if (ONLY == -1 || ONLY == 100) { phase_A(A, lds, tid, wave, lane, bid, G); __syncthreads(); convert_weights(A, 0, lds, wave, lane, bid * 8 + wave, G * 8); } }
        else {
            const int l = (ph - 1) / NPH_L; int sp = (int)((0x98764210ull >> (4 * ((ph - 1) % NPH_L))) & 15ull);
            if (ONLY >= 0) { if (ONLY == 100 || sp != ONLY) continue; sp = ONLY; }
            if (sp == 0) phase_B(A, l, lds, tid, wave, lane, bid, G);
            else if (sp == 1) {
                pg8::Gemm g{(const bf16_t*)(ws + WS_H), (const bf16_t*)(ws + (size_t)(l & 1) * WS_WSET2 + WS_WIN), 1024, 1024, 1024, 0, 0};
                pg8::Sched S; if (l == NL - 1) S.init(ML / 256, INC / 256, 1, G, bid, MC / 256, 9); else S.init_gemm1_holes(G, bid);
                pg8::Epi1 E{(bf16_t*)(ws + WS_KB), (bf16_t*)(ws + WS_VB), (bf16_t*)(ws + WS_RW), (bf16_t*)(ws + WS_YD), (bf16_t*)(ws + WS_QB), (bf16_t*)(ws + WS_GU), (bf16_t*)(ws + WS_VA), (bf16_t*)(ws + WS_Z), (bf16_t*)(ws + WS_G)};
                pg8::gemm_phase<pg8::Epi1>(lds, g, S, E, tid);
            } else if (sp == 2) {
                pg8::Gemm g{(const bf16_t*)(ws + WS_YD), (const bf16_t*)(ws + (size_t)(l & 1) * WS_WSET2 + WS_WLORA), 256, 256, 256, 0, 0};
                pg8::Sched S; S.init(MT / 256, 2048 / 256, 1, G, bid);
                pg8::EpiLora E{(bf16_t*)(ws + WS_WA), A->in[17] + l * 1024, A->in[19] + l * 1024};
                pg8::gemm_phase<pg8::EpiLora>(lds, g, S, E, tid);
                phase_prep(A, l, tid, wave, lane, bid, G);
            }
            else if (sp == 4) { for (int u = bid; u < 256; u += G) { const int x = u & 7, s = u >> 3; att::attn_unit(A, l, ((x * 2 + (s >> 4)) << 4) | (s & 15), (char*)lds_raw, tid); } }
            else if (sp == 5) { for (int u = bid; u < (MT / 128) * 4; u += G) gmlp_unit(A, l, u, (char*)lds_raw, tid); }
            else if (sp == 6) {
                if (l < NL - 1 && bid >= 64 && bid < 80) {
                    att::attn_unit(A, l, 256 + (bid - 64), (char*)lds_raw, tid);
                    asm volatile("s_waitcnt vmcnt(0)" ::: "memory"); __syncthreads();
                    if (tid == 0) (void)xb_add((unsigned*)(ws + WS_GBAR) + l * 512 + 6 * 64, 1u);
                }
                unsigned* gb = (unsigned*)(ws + WS_GBAR) + l * 512;
                const bool crewl = l < NL - 1;
                const bf16_t* wbr = (const bf16_t*)(ws + (size_t)(l & 1) * WS_WSET2 + WS_WBR);
                if (bid < 64) scanc::scan_unit(A, l, bid, (LAS char*)lds, tid, gb + 4 * 64);
                else if (crewl && bid < 80) {
                    const int c = bid - 64;
                    gmlp_unit(A, l, 512 + 2 * c, (char*)lds_raw, tid); gmlp_unit(A, l, 513 + 2 * c, (char*)lds_raw, tid);
                    group_barrier(gb + 1 * 64, 16u);
                    pg8::Sched S; S.init(ML / 256, 0, 1, 16, c, MC / 256, 4);
                    {   pg8::Gemm g{(const bf16_t*)(ws + WS_RW) + 512, wbr + (size_t)1024 * 512, 1536, 512, 512, 0, 0};
                        pg8::EpiMerge E{(const bf16_t*)(ws + WS_G), (bf16_t*)(ws + WS_MB), 1, true};
                        pg8::gemm_phase<pg8::EpiMerge>(lds, g, S, E, tid); }
                    asm volatile("s_waitcnt vmcnt(0)" ::: "memory"); __syncthreads();
                    {   pg8::Gemm g{(const bf16_t*)(ws + WS_RW), wbr, 1536, 512, 512, 0, 0};
                        pg8::EpiMerge E{(const bf16_t*)(ws + WS_G), (bf16_t*)(ws + WS_MB), 0, false};
                        pg8::gemm_phase<pg8::EpiMerge>(lds, g, S, E, tid); }
                    if (tid == 0) { unsigned sp_ = 0u; while (xb_ld(gb + 4 * 64) < 128u) { __builtin_amdgcn_s_sleep(2); if (++sp_ > XB_SPIN_CAP) break; } __builtin_amdgcn_fence(__ATOMIC_ACQUIRE, "agent"); }
                    __syncthreads();
                    phase_readout(A, l, lane, ML, MT, c * 8 + wave, 16 * 8);
                    group_barrier(gb + 2 * 64, 16u);
                    {   pg8::Gemm g{(const bf16_t*)(ws + WS_RW) + 1024, wbr + (size_t)2 * 1024 * 512, 1536, 512, 512, 0, 0};
                        pg8::EpiMerge E{(const bf16_t*)(ws + WS_G), (bf16_t*)(ws + WS_MB), 2, false};
                        pg8::gemm_phase<pg8::EpiMerge>(lds, g, S, E, tid); }
                    group_barrier(gb + 3 * 64, 16u);
                    {   pg8::Gemm g{(const bf16_t*)(ws + WS_MB), (const bf16_t*)(ws + (size_t)(l & 1) * WS_WSET2 + WS_WOUT), 1024, 1024, 1024, 0, 0};
                        pg8::EpiOut E{l == 0 ? A->in[0] : A->out, A->out, l == 0 ? A->in[2] : (const float*)(ws + WS_XC), (float*)(ws + WS_XC), (const float*)(ws + WS_MODB) + (size_t)l * 5 * 3072};
                        pg8::gemm_phase<pg8::EpiOut>(lds, g, S, E, tid); }
                } else { const int b0 = crewl ? 80 : 64, nb = G - b0, ob = bid - b0;
                    if (crewl && ob >= 80 && ob < 156) {
                        const int dt = ob - 80;
                        pg8::Gemm g1{(const bf16_t*)(ws + WS_H), (const bf16_t*)(ws + (size_t)(l & 1) * WS_WSET2 + WS_WIN), 1024, 1024, 1024, 0, 0};
                        pg8::Sched S1; S1.init_single(dt < 64 ? dt : dt - 64, dt < 64 ? 23 : 24);
                        pg8::Epi1 E1{(bf16_t*)(ws + WS_KB), (bf16_t*)(ws + WS_VB), (bf16_t*)(ws + WS_RW), (bf16_t*)(ws + WS_YD), (bf16_t*)(ws + WS_QB), (bf16_t*)(ws + WS_GU), (bf16_t*)(ws + WS_VA), (bf16_t*)(ws + WS_Z), (bf16_t*)(ws + WS_G)};
                        pg8::gemm_phase<pg8::Epi1>(lds, g1, S1, E1, tid);
                        asm volatile("s_waitcnt vmcnt(0)" ::: "memory"); __syncthreads(); }
                    for (int u = ob; u < (ML / 128) * 4; u += nb) gmlp_unit(A, l, u, (char*)lds_raw, tid);
                    if (crewl) { if (tid == 0) { unsigned sp_ = 0u; while (xb_ld(gb + 6 * 64) < 16u) { __builtin_amdgcn_s_sleep(2); if (++sp_ > XB_SPIN_CAP) break; } } }
                    __syncthreads();
                    pg8::Sched S; S.init(ML / 256, 1024 / 256, 1, nb, ob);
                    {   pg8::Gemm g{(const bf16_t*)(ws + WS_RW) + 512, wbr + (size_t)1024 * 512, 1536, 512, 512, 0, 0};
                        pg8::EpiMerge E{(const bf16_t*)(ws + WS_G), (bf16_t*)(ws + WS_MB), 1, true};
                        pg8::gemm_phase<pg8::EpiMerge>(lds, g, S, E, tid); }
                    __syncthreads();
                    if (l + 1 < NL) convert_weights(A, l + 1, lds, wave, lane, ob * 8 + wave, nb * 8);
                    group_barrier(gb, (unsigned)nb);
                    {   pg8::Gemm g{(const bf16_t*)(ws + WS_RW), wbr, 1536, 512, 512, 0, 0};
                        pg8::EpiMerge E{(const bf16_t*)(ws + WS_G), (bf16_t*)(ws + WS_MB), 0, false};
                        pg8::gemm_phase<pg8::EpiMerge>(lds, g, S, E, tid); } }
            }
            else if (sp == 7) phase_readout(A, l, lane, 0, ML, bid * 8 + wave, G * 8);
            else if (sp == 8) {
                pg8::Gemm g{(const bf16_t*)(ws + WS_RW) + 1024, (const bf16_t*)(ws + (size_t)(l & 1) * WS_WSET2 + WS_WBR) + (size_t)2 * 1024 * 512, 1536, 512, 512, 0, 0};
                pg8::Sched S; S.init(ML / 256, 1024 / 256, 1, G, bid);
                pg8::EpiMerge E{(const bf16_t*)(ws + WS_G), (bf16_t*)(ws + WS_MB), 2, false};
                pg8::gemm_phase<pg8::EpiMerge>(lds, g, S, E, tid);
            } else {
                pg8::Gemm g{(const bf16_t*)(ws + WS_MB), (const bf16_t*)(ws + (size_t)(l & 1) * WS_WSET2 + WS_WOUT), 1024, 1024, 1024, 0, 0};
                pg8::Sched S; S.init(ML / 256, 1024 / 256, 1, G, bid);
                pg8::EpiOut E{l == 0 ? A->in[0] : A->out, A->out, l == 0 ? A->in[2] : (const float*)(ws + WS_XC), (float*)(ws + WS_XC), (const float*)(ws + WS_MODB) + (size_t)l * 5 * 3072};
                pg8::gemm_phase<pg8::EpiOut>(lds, g, S, E, tid);
            }
        }
#if MK_ONE_LAUNCH
        if (ph + 1 < args.ph_hi) xcd_barrier(xbar);
#endif
    }
}


extern "C" void kernel_launch(void* const* d_in, const int* in_sizes, int n_in, void* d_out, int out_size, void* d_ws, size_t ws_size, hipStream_t stream) {
    static int state = 0;
    if (state == 0) {
        if (n_in != 28 || out_size != ML * DM || ws_size < WS_END) { fprintf(stderr, "kernel_launch: unexpected shapes (n_in %d out %d ws %zu)\n", n_in, out_size, ws_size); state = -1; return; }
        state = 1;
    }
    if (state < 0) return;
    Args a{};
    for (int i = 0; i < 28; ++i) a.in[i] = (const float*)d_in[i];
    a.out = (float*)d_out; a.ws = (unsigned char*)d_ws;
#if MK_ONE_LAUNCH
    static int grid = 0;
    if (grid == 0) {
        if (hipFuncSetAttribute((const void*)mk_fwd<-1>, hipFuncAttributeMaxDynamicSharedMemorySize, LDS_BYTES) != hipSuccess) fprintf(stderr, "kernel_launch: hipFuncSetAttribute failed\n");
        int dev = 0, cus = 0, per_cu = 0;
        hipGetDevice(&dev); hipDeviceGetAttribute(&cus, hipDeviceAttributeMultiprocessorCount, dev);
        if (hipOccupancyMaxActiveBlocksPerMultiprocessor(&per_cu, (const void*)mk_fwd<-1>, 512, LDS_BYTES) != hipSuccess || per_cu < 1) { fprintf(stderr, "kernel_launch: occupancy query says %d blocks per CU\n", per_cu); per_cu = 1; }
        (void)hipGetLastError();
        grid = cus * (per_cu < 1 ? 1 : 1);
        if (grid > 256) grid = 256;
    }
    (void)hipMemsetAsync(d_ws, 0, CTL_ZERO_BYTES, stream);
    a.ph_lo = 0; a.ph_hi = NPHASES;
    void* kargs[] = {&a};
    hipError_t e = hipLaunchCooperativeKernel((const void*)mk_fwd<-1>, dim3(grid), dim3(512), kargs, LDS_BYTES, stream);
    if (e != hipSuccess) fprintf(stderr, "cooperative launch failed: %s\n", hipGetErrorString(e));
#endif
}
```

```cpp
#include <hip/hip_runtime.h>
#include <hip/hip_cooperative_groups.h>
#include <cstdint>
#include <cstdio>
namespace cg = cooperative_groups;

#ifndef MK_ONE_LAUNCH
#define MK_ONE_LAUNCH 1
#endif

#define LAS __attribute__((address_space(3)))
#define GAS __attribute__((address_space(1)))
typedef unsigned short bf16_t;
typedef short bf16x8 __attribute__((ext_vector_type(8)));
typedef short s16x4 __attribute__((ext_vector_type(4)));
typedef float f32x2 __attribute__((ext_vector_type(2)));
typedef float f32x4 __attribute__((ext_vector_type(4)));
typedef float f32x16 __attribute__((ext_vector_type(16)));
typedef unsigned u32x2 __attribute__((ext_vector_type(2)));
typedef unsigned u32x4 __attribute__((ext_vector_type(4)));

constexpr int DM = 1024, NB = 4, SEQ = 4096, NL = 4, CTX = 256;
constexpr int ML = NB * SEQ;
constexpr int MC = NB * CTX;
constexpr int MT = ML + MC;
constexpr int INC = 8960;
constexpr float NORM_EPS = 1e-6f, LN_EPS = 1e-5f, GN_EPS = 64e-5f;
constexpr float LOG2E = 1.4426950408889634f;
constexpr float QSCALE = 0.125f * LOG2E;

constexpr size_t MiB = 1u << 20;
constexpr size_t WS_MODB = 1 * MiB;
constexpr size_t WS_ROPE = WS_MODB + 256 * 1024;
constexpr size_t WS_SCAL = WS_ROPE + 16 * 1024;
constexpr size_t WS_WIN  = 2 * MiB;
constexpr size_t WS_WBR  = 20 * MiB;
constexpr size_t WS_WOUT = 23 * MiB;
constexpr size_t WS_WLORA = 25 * MiB;
constexpr size_t WS_XC   = 26 * MiB;
constexpr size_t WS_H    = 30 * MiB;
constexpr size_t WS_MB   = 64 * MiB;
constexpr size_t WS_KB   = 64 * MiB;
constexpr size_t WS_QB   = 81 * MiB;
constexpr size_t WS_VB   = 98 * MiB;
constexpr size_t WS_RW   = 115 * MiB;
constexpr size_t WS_GU   = 166 * MiB;
constexpr size_t WS_VA   = 183 * MiB;
constexpr size_t WS_Z    = 200 * MiB;
constexpr size_t WS_G    = 251 * MiB;
constexpr size_t WS_WA   = 353 * MiB;
constexpr size_t WS_RWP  = 421 * MiB;
constexpr size_t WS_YD   = 489 * MiB;
constexpr size_t WS_WSET2 = 521 * MiB;
constexpr size_t WS_END  = 547 * MiB;

constexpr int LDS_BYTES = 147456;

__device__ __forceinline__ float bf2f(unsigned short h) { return __uint_as_float(((unsigned)h) << 16); }
typedef __bf16 bf16x2_t __attribute__((ext_vector_type(2)));
__device__ __forceinline__ unsigned cvt_pk_bf16(float lo, float hi) { f32x2 v = {lo, hi}; bf16x2_t b = __builtin_convertvector(v, bf16x2_t); return __builtin_bit_cast(unsigned, b); }
__device__ __forceinline__ float fast_sig(float z) { return __builtin_amdgcn_rcpf(1.0f + __builtin_amdgcn_exp2f(-z * LOG2E)); }
__device__ __forceinline__ float wave_sum(float v) {
#pragma unroll
    for (int o = 1; o < 64; o <<= 1) v += __shfl_xor(v, o);
    return v;
}
__device__ __forceinline__ void unpack8(const u32x4 w, float (&f)[8]) {
    f[0] = __uint_as_float(w.x << 16); f[1] = __uint_as_float(w.x & 0xffff0000u);
    f[2] = __uint_as_float(w.y << 16); f[3] = __uint_as_float(w.y & 0xffff0000u);
    f[4] = __uint_as_float(w.z << 16); f[5] = __uint_as_float(w.z & 0xffff0000u);
    f[6] = __uint_as_float(w.w << 16); f[7] = __uint_as_float(w.w & 0xffff0000u);
}
__device__ __forceinline__ u32x4 pack8(const float (&f)[8]) {
    u32x4 w; w.x = cvt_pk_bf16(f[0], f[1]); w.y = cvt_pk_bf16(f[2], f[3]); w.z = cvt_pk_bf16(f[4], f[5]); w.w = cvt_pk_bf16(f[6], f[7]); return w;
}

struct Args {
    const float* in[28];
    float* out; unsigned char* ws;
    int ph_lo, ph_hi;
};
typedef const __attribute__((address_space(4))) Args* ArgP;

namespace pg8 {
constexpr int BM = 256, BK = 64, HALF = 128, HTB = HALF * BK * 2, STAGE_BYTES = 8 * HTB, NXCD = 8, WGM = 8;
__host__ __device__ __forceinline__ int lds_byte(int r, int c) { const int st = (r >> 4) * 2 + (c >> 5), rr = r & 15, cc = c & 31, ob = rr * 64 + cc * 2; return st * 1024 + (ob ^ (((ob >> 9) & 1) << 5)); }
__host__ __device__ __forceinline__ void stage_rc(int b, int& R, int& C) { const int st = b / 1024, sb = b % 1024, swz = sb ^ (((sb >> 9) & 1) << 5); R = (st >> 1) * 16 + swz / 64; C = (st & 1) * 32 + (swz % 64) / 2; }
__host__ __device__ __forceinline__ int perm32(int rho) { const int n = rho >> 4, i = rho & 15; return 8 * (i >> 2) + 4 * n + (i & 3); }

struct Unit { int pm, pn, pz; };
struct Gemm { const bf16_t* A; const bf16_t* Bt; int lda, ldb, K; size_t zA, zB; };

struct Sched {
    int nM, nN, nZ, nwg, G, c, nM2, nN2;
    int mode = 0, spm = 0, spn = 0;
    __device__ void init(int nM_, int nN_, int nZ_, int G_, int c_, int nM2_ = 0, int nN2_ = 0) { nM = nM_; nN = nN_; nZ = nZ_; nwg = nM * nN; G = G_; c = c_; nM2 = nM2_; nN2 = nN2_; }
    __device__ void init_gemm1_holes(int G_, int c_) { init(MT / 256, 33, 1, G_, c_); mode = 1; }
    __device__ void init_single(int pm_, int pn_) { init(1, 1, 1, 1, 0); mode = 2; spm = pm_; spn = pn_; }
    __device__ bool next(int i, Unit& u) const {
        if (mode == 2) { if (i > 0) return false; u.pm = spm; u.pn = spn; u.pz = 0; return true; }
        if (mode == 1) { const long L1 = (long)i * G + c;
            if (L1 >= nwg) { const int e = (int)(L1 - nwg); if (e >= 60) return false; if (e < 4) { u.pm = 64 + e; u.pn = 23; } else { u.pm = 12 + (e - 4); u.pn = 24; } u.pz = 0; return true; } }
        const int ti = i / nZ, z = i - ti * nZ;
        const long L = (long)ti * G + c;
        if (L >= nwg) { const int e = (int)(L - nwg); if (e >= nM2 * nN2) return false; u.pm = nM + e % nM2; u.pn = e / nM2; u.pz = 0; return true; }
        int wgid = (int)L; { const int q = nwg / NXCD, r = nwg % NXCD, xcd = wgid % NXCD, off = wgid / NXCD; wgid = (xcd < r ? xcd * (q + 1) : r * (q + 1) + (xcd - r) * q) + off; }
        const int nig = WGM * nN, gid = wgid / nig, fm = gid * WGM, gsz = (nM - fm) < WGM ? (nM - fm) : WGM;
        u.pm = fm + ((wgid % nig) % gsz); u.pn = (wgid % nig) / gsz; u.pz = z; if (mode == 1 && u.pn >= 23) u.pn += 2; return true;
    }
};

template <class Epi>
__device__ __forceinline__ void gemm_phase(LAS unsigned char* lds, const Gemm g, const Sched& S, const Epi& E, const int tid_) {
    int tid = tid_; asm volatile("" : "+v"(tid));
    const int wid = __builtin_amdgcn_readfirstlane(tid >> 6), lane = tid & 63, wr = wid >> 2, wc = wid & 3, fr = lane & 15, fq = lane >> 4;
    int Kl = g.K; asm volatile("" : "+s"(Kl));
    const int K = Kl, nt = K / BK;
    unsigned voffA[2], voffB[2];
#pragma unroll
    for (int i = 0; i < 2; ++i) { int R, C; stage_rc(tid * 16 + i * 8192, R, C); const int Rb = Epi::PERM ? ((R & ~31) + perm32(R & 31)) : R;
        voffA[i] = (unsigned)(R * g.lda + C) * 2u; voffB[i] = (unsigned)(Rb * g.ldb + C) * 2u; }
    const size_t kstep = (size_t)(BK * 2);
    const size_t hstepA = (size_t)HALF * g.lda * 2, hstepB = (size_t)HALF * g.ldb * 2;
    const size_t tstepA = 2 * hstepA, tstepB = 2 * hstepB;
    const unsigned ldsw = (unsigned)wid * 1024u;
    const int aoff = lds_byte(wr * 64 + fr, fq * 8), boff = lds_byte(wc * 32 + fr, fq * 8);
#define PG8_SA(b, h) (((b) * 2 + (h)) * HTB)
#define PG8_SB(b, h) ((4 + (b) * 2 + (h)) * HTB)
#define PG8_STAGE(bufoff, gbase, voff) do { _Pragma("unroll") for (int _i = 0; _i < 2; ++_i) \
        __builtin_amdgcn_global_load_lds((const unsigned*)((const char*)(gbase) + (voff)[_i]), (LAS unsigned*)(lds + (bufoff) + ldsw + _i * 8192), 16, 0, 0); } while (0)
#define PG8_LDA(dst, b, h) do { _Pragma("unroll") for (int m = 0; m < 4; ++m) _Pragma("unroll") for (int k = 0; k < 2; ++k) dst[m][k] = *(const LAS bf16x8*)(lds + PG8_SA(b, h) + aoff + m * 2048 + k * 1024); } while (0)
#define PG8_LDB(dst, b, h) do { _Pragma("unroll") for (int n = 0; n < 2; ++n) _Pragma("unroll") for (int k = 0; k < 2; ++k) dst[n][k] = *(const LAS bf16x8*)(lds + PG8_SB(b, h) + boff + n * 2048 + k * 1024); } while (0)
#define PG8_MMA(ai, bj, At, Bt) do { __builtin_amdgcn_s_setprio(1); _Pragma("unroll") for (int m = 0; m < 4; ++m) _Pragma("unroll") for (int n = 0; n < 2; ++n) _Pragma("unroll") for (int k = 0; k < 2; ++k) \
        acc[ai][bj][m][n] = __builtin_amdgcn_mfma_f32_16x16x32_bf16(Bt[n][k], At[m][k], acc[ai][bj][m][n], 0, 0, 0); __builtin_amdgcn_s_setprio(0); } while (0)
#define PG8_WAIT_V(n) asm volatile("s_waitcnt vmcnt(" #n ")" ::: "memory")
#define PG8_WAIT_L(n) asm volatile("s_waitcnt lgkmcnt(" #n ")" ::: "memory")
#define PG8_BAR __builtin_amdgcn_s_barrier()
#define PG8_SCHED __builtin_amdgcn_sched_barrier(0)
    Unit cur, nxt; int ui = 0;
    if (!S.next(0, cur)) return;
    f32x4 acc[2][2][4][2];
#pragma unroll
    for (int a = 0; a < 2; ++a)
#pragma unroll
        for (int b = 0; b < 2; ++b)
#pragma unroll
            for (int m = 0; m < 4; ++m)
#pragma unroll
                for (int n = 0; n < 2; ++n) acc[a][b][m][n] = (f32x4){0.f, 0.f, 0.f, 0.f};
    bf16x8 At[4][2], B0[2][2], B1[2][2];
    const char* cA = (const char*)g.A + (size_t)cur.pm * tstepA + (size_t)cur.pz * g.zA; const char* cB = (const char*)g.Bt + (size_t)cur.pn * tstepB + (size_t)cur.pz * g.zB;
    PG8_STAGE(PG8_SB(0, 0), cB, voffB); PG8_STAGE(PG8_SB(0, 1), cB + hstepB, voffB); PG8_STAGE(PG8_SA(0, 0), cA, voffA); PG8_STAGE(PG8_SA(0, 1), cA + hstepA, voffA);
    if (wr == 1) PG8_BAR;
    PG8_WAIT_V(2); PG8_BAR;
    PG8_STAGE(PG8_SB(1, 0), cB + kstep, voffB); PG8_STAGE(PG8_SA(1, 0), cA + kstep, voffA); PG8_STAGE(PG8_SB(1, 1), cB + hstepB + kstep, voffB);
    PG8_WAIT_V(6); PG8_BAR;
    for (;;) {
        const bool has_next = S.next(ui + 1, nxt);
        const char* nA = has_next ? (const char*)g.A + (size_t)nxt.pm * tstepA + (size_t)nxt.pz * g.zA : cA;
        const char* nB = has_next ? (const char*)g.Bt + (size_t)nxt.pn * tstepB + (size_t)nxt.pz * g.zB : cB;
        for (int t = 0; t < nt; t += 2) {
            const bool last = (t == nt - 2);
            const char* a1 = cA + (size_t)(t + 1) * kstep;
            const char* a2 = last ? nA : cA + (size_t)(t + 2) * kstep; const char* b2 = last ? nB : cB + (size_t)(t + 2) * kstep;
            const char* a3 = a2 + kstep; const char* b3 = b2 + kstep;
            PG8_LDB(B0, 0, 0); PG8_LDB(B1, 0, 1); PG8_SCHED; PG8_LDA(At, 0, 0); PG8_STAGE(PG8_SA(1, 1), a1 + hstepA, voffA);
            PG8_WAIT_V(8); PG8_WAIT_L(0); PG8_BAR; PG8_MMA(0, 0, At, B0); PG8_MMA(0, 1, At, B1); PG8_BAR; PG8_SCHED;
            PG8_LDA(At, 0, 1); PG8_STAGE(PG8_SB(0, 0), b2, voffB); PG8_STAGE(PG8_SB(0, 1), b2 + hstepB, voffB); PG8_STAGE(PG8_SA(0, 0), a2, voffA);
            PG8_WAIT_V(8); PG8_WAIT_L(0); PG8_BAR; PG8_MMA(1, 0, At, B0); PG8_MMA(1, 1, At, B1); PG8_BAR; PG8_SCHED;
            PG8_LDB(B0, 1, 0); PG8_LDB(B1, 1, 1); PG8_SCHED; PG8_LDA(At, 1, 0); PG8_STAGE(PG8_SA(0, 1), a2 + hstepA, voffA);
            PG8_WAIT_V(8); PG8_WAIT_L(0); PG8_BAR; PG8_MMA(0, 0, At, B0); PG8_MMA(0, 1, At, B1); PG8_BAR; PG8_SCHED;
            PG8_LDA(At, 1, 1); PG8_STAGE(PG8_SB(1, 0), b3, voffB); PG8_STAGE(PG8_SB(1, 1), b3 + hstepB, voffB); PG8_STAGE(PG8_SA(1, 0), a3, voffA);
            PG8_WAIT_V(8); PG8_WAIT_L(0); PG8_BAR; PG8_MMA(1, 0, At, B0); PG8_MMA(1, 1, At, B1); PG8_BAR; PG8_SCHED;
        }
        if (wr == 0) PG8_BAR;
        E(acc, cur, wr, wc, fr, fq);
        if (!has_next) break;
#pragma unroll
        for (int a = 0; a < 2; ++a)
#pragma unroll
            for (int b = 0; b < 2; ++b)
#pragma unroll
                for (int m = 0; m < 4; ++m)
#pragma unroll
                    for (int n = 0; n < 2; ++n) acc[a][b][m][n] = (f32x4){0.f, 0.f, 0.f, 0.f};
        cur = nxt; cA = nA; cB = nB; ++ui;
        if (wr == 1) PG8_BAR;
    }
    PG8_WAIT_V(0);
    PG8_BAR;
#undef PG8_SA
#undef PG8_SB
#undef PG8_STAGE
#undef PG8_LDA
#undef PG8_LDB
#undef PG8_MMA
#undef PG8_WAIT_V
#undef PG8_WAIT_L
#undef PG8_BAR
#undef PG8_SCHED
}

template <int ACT> __device__ __forceinline__ float act_f(float x) {
    if (ACT == 0) return x;
    if (ACT == 1) { const float z = x * (1.5957691216f + 0.0713548163f * x * x); return x * fast_sig(z); }
    if (ACT == 2) return x * fast_sig(x);
    if (ACT == 3) return fast_sig(x);
    return 2.0f * fast_sig(2.0f * x) - 1.0f;
}
template <int ACT0, int ACT1> __device__ __forceinline__ void epi_store_bf16(const f32x4 (&acc)[2][2][4][2], bf16_t* base, int ld, int row0, int col0) {
#pragma unroll
    for (int ai = 0; ai < 2; ++ai)
#pragma unroll
        for (int m = 0; m < 4; ++m) { bf16_t* rowp = base + (size_t)(row0 + ai * HALF + m * 16) * ld + col0;
#pragma unroll
            for (int bj = 0; bj < 2; ++bj) { const f32x4 v0 = acc[ai][bj][m][0], v1 = acc[ai][bj][m][1];
                float o[8];
                if (bj == 0) { o[0] = act_f<ACT0>(v0[0]); o[1] = act_f<ACT0>(v0[1]); o[2] = act_f<ACT0>(v0[2]); o[3] = act_f<ACT0>(v0[3]); o[4] = act_f<ACT0>(v1[0]); o[5] = act_f<ACT0>(v1[1]); o[6] = act_f<ACT0>(v1[2]); o[7] = act_f<ACT0>(v1[3]); }
                else         { o[0] = act_f<ACT1>(v0[0]); o[1] = act_f<ACT1>(v0[1]); o[2] = act_f<ACT1>(v0[2]); o[3] = act_f<ACT1>(v0[3]); o[4] = act_f<ACT1>(v1[0]); o[5] = act_f<ACT1>(v1[1]); o[6] = act_f<ACT1>(v1[2]); o[7] = act_f<ACT1>(v1[3]); }
                *(u32x4*)(rowp + bj * HALF) = pack8(o); } __builtin_amdgcn_sched_barrier(0); }
}
struct Epi1 {
    static constexpr bool PERM = true;
    bf16_t *Kb, *Vb, *RW, *LA, *Qb, *GU, *VA, *Z, *G;
    __device__ __forceinline__ void operator()(const f32x4 (&acc)[2][2][4][2], const Unit& u, int wr, int wc, int fr, int fq) const {
        const int pn = u.pn; bf16_t* base; int ld, colt, act;
        if (pn < 2)       { base = Kb; ld = 512;  colt = pn * 256;               act = 0; }
        else if (pn < 4)  { base = Vb; ld = 512;  colt = (pn - 2) * 256;         act = 0; }
        else if (pn < 8)  { base = RW; ld = 1536; colt = (pn - 4) * 256;         act = 0; }
        else if (pn == 8) { base = LA; ld = 256;  colt = 0;                      act = 4; }
        else if (pn < 11) { base = Qb; ld = 512;  colt = (pn - 9) * 256;         act = 0; }
        else if (pn < 13) { base = RW; ld = 1536; colt = 1024 + (pn - 11) * 256; act = 0; }
        else if (pn < 15) { base = GU; ld = 512;  colt = (pn - 13) * 256;        act = 1; }
        else if (pn < 17) { base = VA; ld = 512;  colt = (pn - 15) * 256;        act = 1; }
        else if (pn < 23) { base = Z;  ld = 1536; colt = (pn - 17) * 256;        act = 2; }
        else              { base = G;  ld = 3072; colt = (pn - 23) * 256;        act = 3; }
        const int row0 = u.pm * BM + wr * 64 + fr, col0 = colt + wc * 32 + 8 * fq;
        if (act == 0) epi_store_bf16<0, 0>(acc, base, ld, row0, col0);
        else if (act == 1) epi_store_bf16<1, 1>(acc, base, ld, row0, col0);
        else if (act == 2) epi_store_bf16<2, 2>(acc, base, ld, row0, col0);
        else if (act == 3) epi_store_bf16<3, 3>(acc, base, ld, row0, col0);
        else epi_store_bf16<4, 0>(acc, base, ld, row0, col0);
    }
};
template <bool ISW> __device__ __forceinline__ void epi_lora_store(const f32x4 (&acc)[2][2][4][2], bf16_t* WA, const float* bias, int row0, int col0) {
#pragma unroll
    for (int bj = 0; bj < 2; ++bj) {
        const f32x4 bv0 = *(const f32x4*)(bias + bj * HALF), bv1 = *(const f32x4*)(bias + bj * HALF + 4);
#pragma unroll
        for (int ai = 0; ai < 2; ++ai)
#pragma unroll
            for (int m = 0; m < 4; ++m) { bf16_t* rowp = WA + (size_t)(row0 + ai * HALF + m * 16) * 2048 + col0 + bj * HALF; float o[8];
#pragma unroll
                for (int e = 0; e < 4; ++e) { const float s0 = fast_sig(acc[ai][bj][m][0][e] + bv0[e]), s1 = fast_sig(acc[ai][bj][m][1][e] + bv1[e]);
                    o[e] = ISW ? (1.0f - __builtin_amdgcn_exp2f(-0.60653065971f * LOG2E * s0)) : s0;
                    o[4 + e] = ISW ? (1.0f - __builtin_amdgcn_exp2f(-0.60653065971f * LOG2E * s1)) : s1; }
                *(u32x4*)rowp = pack8(o); __builtin_amdgcn_sched_barrier(0); }
        asm volatile("" ::: "memory");
    }
}
struct EpiLora {
    static constexpr bool PERM = true;
    bf16_t* WA; const float* w0; const float* a0;
    __device__ __forceinline__ void operator()(const f32x4 (&acc)[2][2][4][2], const Unit& u, int wr, int wc, int fr, int fq) const {
        const int row0 = u.pm * BM + wr * 64 + fr, col0 = u.pn * BM + wc * 32 + 8 * fq;
        if (u.pn < 4) epi_lora_store<true>(acc, WA, w0 + col0, row0, col0);
        else epi_lora_store<false>(acc, WA, a0 + col0 - 1024, row0, col0);
    }
};
struct EpiMerge {
    static constexpr bool PERM = true;
    const bf16_t* G; bf16_t* MB; int z0; bool first;
    __device__ __forceinline__ void operator()(const f32x4 (&acc)[2][2][4][2], const Unit& u, int wr, int wc, int fr, int fq) const {
        const int row0 = u.pm * BM + wr * 64 + fr, col0 = u.pn * BM + wc * 32 + 8 * fq, z = z0; const bool accu = !first;
        u32x4 gc[2], gn[2], pc[2], pn_[2];
#define MLOAD(dg, dp, g_) do { const size_t row_ = (size_t)(row0 + ((g_) >> 2) * HALF + ((g_) & 3) * 16); \
        _Pragma("unroll") for (int bj = 0; bj < 2; ++bj) { const int c_ = col0 + bj * HALF; dg[bj] = *(const u32x4*)(G + row_ * 3072 + z * 1024 + c_); \
            if (accu) dp[bj] = *(const u32x4*)(MB + row_ * 1024 + c_); } } while (0)
        MLOAD(gc, pc, 0);
#pragma unroll
        for (int g = 0; g < 8; ++g) { const int ai = g >> 2, m = g & 3; const size_t row = (size_t)(row0 + ai * HALF + m * 16);
            if (g + 1 < 8) MLOAD(gn, pn_, g + 1);
#pragma unroll
            for (int bj = 0; bj < 2; ++bj) { const int c = col0 + bj * HALF; float gf[8]; unpack8(gc[bj], gf); float o[8];
#pragma unroll
                for (int n = 0; n < 2; ++n)
#pragma unroll
                    for (int e = 0; e < 4; ++e) o[n * 4 + e] = acc[ai][bj][m][n][e] * gf[n * 4 + e];
                if (accu) { float pf[8]; unpack8(pc[bj], pf);
#pragma unroll
                    for (int e = 0; e < 8; ++e) o[e] += pf[e]; }
                *(u32x4*)(MB + row * 1024 + c) = pack8(o); }
#pragma unroll
            for (int bj = 0; bj < 2; ++bj) { gc[bj] = gn[bj]; pc[bj] = pn_[bj]; } }
#undef MLOAD
    }
};
struct EpiOut {
    static constexpr bool PERM = false;
    const float* xin; float* xout; const float* xcin; float* xcout; const float* modl;
    __device__ __forceinline__ void operator()(const f32x4 (&acc)[2][2][4][2], const Unit& u, int wr, int wc, int fr, int fq) const {
        const bool lat = u.pm < (ML / BM);
        const int b = lat ? (u.pm >> 4) : 4;
        const float* src = lat ? xin : xcin; float* dst = lat ? xout : xcout;
        const int row0 = (lat ? u.pm * BM : u.pm * BM - ML) + wr * 64 + fr, col0 = u.pn * BM + wc * 32 + 4 * fq;
        const float* gate = modl + b * 3072 + 2048 + col0;
        f32x4 gv[2][2];
#pragma unroll
        for (int bj = 0; bj < 2; ++bj)
#pragma unroll
            for (int n = 0; n < 2; ++n) gv[bj][n] = *(const f32x4*)(gate + bj * HALF + n * 16);
        f32x4 xc[2][2], xn[2][2];
#define XLOAD(dst, g_) do { const size_t off_ = (size_t)(row0 + ((g_) >> 2) * HALF + ((g_) & 3) * 16) * 1024 + col0; \
        _Pragma("unroll") for (int bj = 0; bj < 2; ++bj) _Pragma("unroll") for (int n = 0; n < 2; ++n) dst[bj][n] = *(const f32x4*)(src + off_ + bj * HALF + n * 16); } while (0)
        XLOAD(xc, 0);
#pragma unroll
        for (int g = 0; g < 8; ++g) { const int ai = g >> 2, m = g & 3; const size_t off = (size_t)(row0 + ai * HALF + m * 16) * 1024 + col0;
            if (g + 1 < 8) XLOAD(xn, g + 1);
#pragma unroll
            for (int bj = 0; bj < 2; ++bj)
#pragma unroll
                for (int n = 0; n < 2; ++n) *(f32x4*)(dst + off + bj * HALF + n * 16) = xc[bj][n] + gv[bj][n] * acc[ai][bj][m][n];
#pragma unroll
            for (int bj = 0; bj < 2; ++bj)
#pragma unroll
                for (int n = 0; n < 2; ++n) xc[bj][n] = xn[bj][n]; }
#undef XLOAD
    }
};
}

__device__ __forceinline__ void phase_A(ArgP a, LAS unsigned char* lds, int tid, int wave, int lane, int bid, int G) {
    float* MODB = (float*)(a->ws + WS_MODB); f32x2* ROPE = (f32x2*)(a->ws + WS_ROPE); float* SCAL = (float*)(a->ws + WS_SCAL);
    for (int u = bid; u < 194; u += G) {
        if (u < 192) {
            const int l = u / 48, n0 = (u % 48) * 64;
            LAS float* act = (LAS float*)lds;
            for (int i = tid; i < 5120; i += 512) { const int b = i >> 10, k = i & 1023; const float v = b < 4 ? a->in[1][b * 1024 + k] : a->in[3][k]; act[i] = v / (1.0f + __expf(-v)); }
            __syncthreads();
            float acc[5] = {0.f, 0.f, 0.f, 0.f, 0.f};
            const float* W = a->in[4] + ((size_t)l * 1024 + wave * 128) * 3072 + n0 + lane;
#pragma unroll 16
            for (int k = 0; k < 128; ++k) { const float w = W[(size_t)k * 3072];
#pragma unroll
                for (int b = 0; b < 5; ++b) acc[b] += act[b * 1024 + wave * 128 + k] * w; }
            LAS float* part = (LAS float*)(lds + 20480);
#pragma unroll
            for (int b = 0; b < 5; ++b) part[(wave * 5 + b) * 64 + lane] = acc[b];
            __syncthreads();
            if (tid < 320) { const int b = tid >> 6, ln = tid & 63; float s = a->in[5][l * 3072 + n0 + ln];
#pragma unroll
                for (int w = 0; w < 8; ++w) s += part[(w * 5 + b) * 64 + ln];
                MODB[(size_t)(l * 5 + b) * 3072 + n0 + ln] = s; }
            __syncthreads();
        } else if (u == 192) {
            for (int i = tid; i < 1024; i += 512) { const int pos = i >> 4, f = i & 15;
                const float inv = exp2f(-(float)f * (13.287712379549449f / 16.0f)); const float ang = (float)pos * inv;
                ROPE[i] = (f32x2){cosf(ang), sinf(ang)}; }
        } else {
            if (tid < NL) { const int l = tid; const float* lp = a->in[14] + l * 256;
                float s1 = 0.f, s2 = 0.f; for (int i = 0; i < 64; ++i) { s1 += lp[i] * lp[64 + i]; s2 += lp[128 + i] * lp[192 + i]; }
                const float li = l == 0 ? 0.2f : l == 1 ? 0.35550907f : l == 2 ? 0.47071302f : 0.55605819f;
                float gq = 0.f, gk = 0.f; for (int i = 0; i < 64; ++i) { gq = fmaxf(gq, fabsf(a->in[12][l * 64 + i])); gk = fmaxf(gk, fabsf(a->in[13][l * 64 + i])); }
                SCAL[l * 8 + 0] = expf(s1) - expf(s2) + li;
                SCAL[l * 8 + 1] = -(64.0f * QSCALE * gq * gk * 1.001f);
                SCAL[l * 8 + 2] = 1.0f - li; }
        }
    }
}

__device__ __forceinline__ void transpose_item(const float* W, int K, int N, bf16_t* WT, LAS float* scr, int item, int lane) {
    const int nblk = N / 32, kb = item / nblk, nb = item % nblk, k0 = 64 * kb, n0 = 32 * nb;
#pragma unroll 8
    for (int i = 0; i < 32; ++i) { const int kk = 2 * i + (lane >> 5); scr[kk * 33 + (lane & 31)] = W[(size_t)(k0 + kk) * N + n0 + (lane & 31)]; }
    asm volatile("s_waitcnt lgkmcnt(0)" ::: "memory");
    const int c = lane & 7;
#pragma unroll
    for (int j = 0; j < 4; ++j) { const int n = (lane >> 3) + 8 * j; const LAS float* s = scr + (8 * c) * 33 + n;
        u32x4 o; o.x = cvt_pk_bf16(s[0 * 33], s[1 * 33]); o.y = cvt_pk_bf16(s[2 * 33], s[3 * 33]); o.z = cvt_pk_bf16(s[4 * 33], s[5 * 33]); o.w = cvt_pk_bf16(s[6 * 33], s[7 * 33]);
        *(u32x4*)(WT + (size_t)(n0 + n) * K + k0 + 8 * c) = o; }
    asm volatile("s_waitcnt lgkmcnt(0)" ::: "memory");
}
__device__ __forceinline__ void convert_weights(ArgP a, int l, LAS unsigned char* lds, int wave, int lane, int gw, int NGW) {
    LAS float* scr = (LAS float*)(lds + wave * 16384);
    unsigned char* wb = a->ws + (size_t)(l & 1) * WS_WSET2;
    bf16_t* WIN = (bf16_t*)(wb + WS_WIN); bf16_t* WBR = (bf16_t*)(wb + WS_WBR); bf16_t* WOUT = (bf16_t*)(wb + WS_WOUT); bf16_t* WLORA = (bf16_t*)(wb + WS_WLORA);
    constexpr int I_IN = (1024 / 64) * (INC / 32), I_BR = (512 / 64) * (1024 / 32), I_OUT = (1024 / 64) * (1024 / 32), I_LORA = 1024;
    constexpr int NITEMS = I_IN + 3 * I_BR + I_OUT + I_LORA;
    for (int it = gw; it < NITEMS; it += NGW) {
        int r = it;
        if (r < I_IN) { transpose_item(a->in[7] + (size_t)l * 1024 * INC, 1024, INC, WIN, scr, r, lane); continue; } r -= I_IN;
        if (r < 3 * I_BR) { const int i = r / I_BR; transpose_item(a->in[26] + ((size_t)l * 3 + i) * 512 * 1024, 512, 1024, WBR + (size_t)i * 1024 * 512, scr, r % I_BR, lane); continue; } r -= 3 * I_BR;
        if (r < I_OUT) { transpose_item(a->in[27] + (size_t)l * 1024 * 1024, 1024, 1024, WOUT, scr, r, lane); continue; } r -= I_OUT;
        {
            const int idx = r * 512 + lane * 8, n = idx >> 8, k = idx & 255, kb = k >> 6, rr = k & 63;
            const bool isw = n < 1024; const int nn = isw ? n : n - 1024, d = nn >> 9, c = nn & 511;
            const float* src = (isw ? a->in[18] : a->in[20]) + ((size_t)(l * 2 + d) * 64 + rr) * 512 + c;
            const bool nz = kb == (isw ? d : 2 + d);
            float f[8];
#pragma unroll
            for (int e = 0; e < 8; ++e) f[e] = nz ? src[(size_t)e * 512] : 0.f;
            *(u32x4*)(WLORA + idx) = pack8(f);
        }
    }
}
__device__ __forceinline__ void phase_B(ArgP a, int l, LAS unsigned char* lds, int tid, int wave, int lane, int bid, int G) {
    const int gw = bid * 8 + wave, NGW = G * 8;
    const float* xin = l == 0 ? a->in[0] : a->out; const float* xcin = l == 0 ? a->in[2] : (const float*)(a->ws + WS_XC);
    const float* modl = (const float*)(a->ws + WS_MODB) + (size_t)l * 5 * 3072; const float* ng = a->in[6] + l * 1024;
    bf16_t* H = (bf16_t*)(a->ws + WS_H);
    for (int m = gw; m < MT; m += NGW) {
        const bool lat = m < ML; const int b = lat ? (m >> 12) : 4;
        const f32x4* xr = (const f32x4*)(lat ? xin + (size_t)m * 1024 : xcin + (size_t)(m - ML) * 1024) + lane;
        f32x4 v[4]; float s = 0.f;
#pragma unroll
        for (int j = 0; j < 4; ++j) { v[j] = xr[64 * j]; s += (v[j].x * v[j].x + v[j].y * v[j].y) + (v[j].z * v[j].z + v[j].w * v[j].w); }
        const float rstd = 1.0f / sqrtf(wave_sum(s) * (1.0f / 1024.0f) + NORM_EPS);
        u32x2* o8 = (u32x2*)(H + (size_t)m * 1024) + lane;
#pragma unroll
        for (int j = 0; j < 4; ++j) { const int c = 4 * lane + 256 * j;
            const f32x4 g = *(const f32x4*)(ng + c), sh = *(const f32x4*)(modl + b * 3072 + c), sc = *(const f32x4*)(modl + b * 3072 + 1024 + c);
            const f32x4 h = v[j] * rstd * g * (1.0f + sc) + sh;
            o8[64 * j] = (u32x2){cvt_pk_bf16(h.x, h.y), cvt_pk_bf16(h.z, h.w)}; }
    }
}

__device__ __forceinline__ void qk_normrope(const u32x4 w, bf16_t* rowp, const float* gain, float oscale, bool rope, int ridx, int cidx, const f32x2* ROPE, int lane) {
    const int sub = lane & 7;
    float x[8]; unpack8(w, x);
    float ss = 0.f;
#pragma unroll
    for (int e = 0; e < 8; ++e) ss += x[e] * x[e];
    ss += __shfl_xor(ss, 1); ss += __shfl_xor(ss, 2); ss += __shfl_xor(ss, 4);
    const float rstd = 1.0f / sqrtf(ss * (1.0f / 64.0f) + NORM_EPS);
    const f32x4 g0 = *(const f32x4*)(gain + sub * 8), g1 = *(const f32x4*)(gain + sub * 8 + 4);
    x[0] *= rstd * g0.x; x[1] *= rstd * g0.y; x[2] *= rstd * g0.z; x[3] *= rstd * g0.w; x[4] *= rstd * g1.x; x[5] *= rstd * g1.y; x[6] *= rstd * g1.z; x[7] *= rstd * g1.w;
    float p[8];
#pragma unroll
    for (int e = 0; e < 8; ++e) p[e] = __shfl_xor(x[e], 2);
    if (rope) {
        const int pos = (sub < 4) ? ridx : cidx; const bool first = (sub & 2) == 0; const f32x4* tb = (const f32x4*)(ROPE + pos * 16 + 8 * (sub & 1));
#pragma unroll
        for (int e2 = 0; e2 < 4; ++e2) { const f32x4 cs = tb[e2];
            x[2 * e2] = first ? (x[2 * e2] * cs.x - p[2 * e2] * cs.y) : (p[2 * e2] * cs.y + x[2 * e2] * cs.x);
            x[2 * e2 + 1] = first ? (x[2 * e2 + 1] * cs.z - p[2 * e2 + 1] * cs.w) : (p[2 * e2 + 1] * cs.w + x[2 * e2 + 1] * cs.z); }
    }
#pragma unroll
    for (int e = 0; e < 8; ++e) x[e] *= oscale;
    *(u32x4*)(rowp + lane * 8) = pack8(x);
}
__device__ __forceinline__ void phase_prep(ArgP a, int l, int tid, int wave, int lane, int bid, int G) {
    const int gw = bid * 8 + wave, NGW = G * 8;
    bf16_t* Kb = (bf16_t*)(a->ws + WS_KB); bf16_t* Qb = (bf16_t*)(a->ws + WS_QB); bf16_t* VA = (bf16_t*)(a->ws + WS_VA);
    const bf16_t* RW = (const bf16_t*)(a->ws + WS_RW); bf16_t* RWP = (bf16_t*)(a->ws + WS_RWP);
    const f32x2* ROPE = (const f32x2*)(a->ws + WS_ROPE);
    const float* qg = a->in[12] + l * 64; const float* kg = a->in[13] + l * 64;
    const float* lng = a->in[8] + l * 512; const float* lnb = a->in[9] + l * 512;
    const float* conv = a->in[16] + (size_t)l * 9 * 512;
    const float* rkk = a->in[21] + l * 512;
    constexpr int PREP_R1 = 56 * 256;
    const int nlo = (PREP_R1 - gw + NGW - 1) / NGW;
    const int gw2 = gw - 32 * 8, NGW2 = NGW - 32 * 8;
    const int nhi = gw2 >= 0 ? (MT - PREP_R1 - gw2 + NGW2 - 1) / NGW2 : 0;
    for (int it = 0; it < nlo + nhi; ++it) {
        const int m = it < nlo ? gw + it * NGW : PREP_R1 + gw2 + (it - nlo) * NGW2;
        const bool lat = m < ML; const int t = lat ? (m & 4095) : ((m - ML) & 255); const int tlast = lat ? 4095 : 255;
        const bf16_t* r0 = RW + (size_t)m * 1536 + lane * 8; const bool hp = t > 0, hn = t < tlast;
        const u32x4 wk = *(const u32x4*)(Kb + (size_t)m * 512 + lane * 8), wq = *(const u32x4*)(Qb + (size_t)m * 512 + lane * 8), wva = *(const u32x4*)(VA + (size_t)m * 512 + lane * 8);
        u32x4 wc[3], wp[3], wn[3];
#pragma unroll
        for (int w = 0; w < 3; ++w) { wc[w] = *(const u32x4*)(r0 + w * 512); wp[w] = (u32x4){0u, 0u, 0u, 0u}; wn[w] = (u32x4){0u, 0u, 0u, 0u};
            if (hp) wp[w] = *(const u32x4*)(r0 + w * 512 - 1536);
            if (hn) wn[w] = *(const u32x4*)(r0 + w * 512 + 1536); }
        qk_normrope(wk, Kb + (size_t)m * 512, kg, 1.0f, lat, t >> 6, t & 63, ROPE, lane);
        qk_normrope(wq, Qb + (size_t)m * 512, qg, QSCALE, lat, t >> 6, t & 63, ROPE, lane);
        {   bf16_t* rp = VA + (size_t)m * 512 + lane * 8; float x[8]; unpack8(wva, x);
            float s = 0.f;
#pragma unroll
            for (int e = 0; e < 8; ++e) s += x[e];
            const float mu = wave_sum(s) * (1.0f / 512.0f); float q = 0.f;
#pragma unroll
            for (int e = 0; e < 8; ++e) { x[e] -= mu; q += x[e] * x[e]; }
            const float rstd = 1.0f / sqrtf(wave_sum(q) * (1.0f / 512.0f) + LN_EPS);
            const f32x4 g0 = *(const f32x4*)(lng + lane * 8), g1 = *(const f32x4*)(lng + lane * 8 + 4), b0 = *(const f32x4*)(lnb + lane * 8), b1 = *(const f32x4*)(lnb + lane * 8 + 4);
            x[0] = x[0] * rstd * g0.x + b0.x; x[1] = x[1] * rstd * g0.y + b0.y; x[2] = x[2] * rstd * g0.z + b0.z; x[3] = x[3] * rstd * g0.w + b0.w;
            x[4] = x[4] * rstd * g1.x + b1.x; x[5] = x[5] * rstd * g1.y + b1.y; x[6] = x[6] * rstd * g1.z + b1.z; x[7] = x[7] * rstd * g1.w + b1.w;
            *(u32x4*)rp = pack8(x); }
        {   float o[3][8];
#pragma unroll
            for (int w = 0; w < 3; ++w) {
                const int ci = (w == 0) ? 1 : (w == 1) ? 2 : 0; const float* tp = conv + (size_t)ci * 3 * 512 + lane * 8;
                float xc[8], xp[8], xn[8]; unpack8(wc[w], xc); unpack8(wp[w], xp); unpack8(wn[w], xn);
                const f32x4 t0a = *(const f32x4*)tp, t0b = *(const f32x4*)(tp + 4), t1a = *(const f32x4*)(tp + 512), t1b = *(const f32x4*)(tp + 516), t2a = *(const f32x4*)(tp + 1024), t2b = *(const f32x4*)(tp + 1028);
#pragma unroll
                for (int e = 0; e < 4; ++e) { o[w][e] = xp[e] * t0a[e] + xc[e] * t1a[e] + xn[e] * t2a[e]; o[w][4 + e] = xp[4 + e] * t0b[e] + xc[4 + e] * t1b[e] + xn[4 + e] * t2b[e]; } }
            float kq[8], ss = 0.f; const f32x4 rk0 = *(const f32x4*)(rkk + lane * 8), rk1 = *(const f32x4*)(rkk + lane * 8 + 4);
#pragma unroll
            for (int e = 0; e < 8; ++e) { kq[e] = o[0][e] * ((e < 4) ? rk0[e & 3] : rk1[e & 3]); ss += kq[e] * kq[e]; }
            ss += __shfl_xor(ss, 1); ss += __shfl_xor(ss, 2); ss += __shfl_xor(ss, 4);
            const float inv = 1.0f / fmaxf(sqrtf(ss), 1e-12f);
#pragma unroll
            for (int e = 0; e < 8; ++e) kq[e] *= inv;
            bf16_t* op = RWP + (size_t)m * 2048 + lane * 8;
            *(u32x4*)(op) = pack8(kq); *(u32x4*)(op + 512) = pack8(o[0]); *(u32x4*)(op + 1024) = pack8(o[1]); *(u32x4*)(op + 1536) = pack8(o[2]); }
    }
}

#define SBAR() __builtin_amdgcn_sched_barrier(0)
__device__ __forceinline__ int crow(int r, int hi) { return (r & 3) + 8 * (r >> 2) + 4 * hi; }
__device__ __forceinline__ int v_st(int k, int c) { const int kk = (k & ~0xC) | ((k & 4) << 1) | ((k & 8) >> 1); return ((kk >> 3) * 4 + (c >> 5)) * 512 + ((kk & 7) * 32 + (c & 31)) * 2; }
__device__ __forceinline__ int v_rd_base(int lane) { return ((lane & 3) << 3) | (((lane >> 2) & 3) << 6) | (((lane >> 4) & 1) << 5) | (((lane >> 5) & 1) << 8); }
constexpr int v_rd_off(int d0, int ks, int half) { return d0 * 512 + ks * 4096 + half * 2048; }
template <int OFF> __device__ __forceinline__ s16x4 tr_read(int vb) {
    s16x4 r; asm volatile("ds_read_b64_tr_b16 %0, %1 offset:%2" : "=&v"(r) : "v"(vb), "i"(OFF) : "memory"); return r;
}
template <int D0> __device__ __forceinline__ void pv_one(f32x16& od, int vb, bf16x8 pa0, bf16x8 pa1, bf16x8 pa2, bf16x8 pa3) {
    const s16x4 l0 = tr_read<v_rd_off(D0, 0, 0)>(vb), h0 = tr_read<v_rd_off(D0, 0, 1)>(vb), l1 = tr_read<v_rd_off(D0, 1, 0)>(vb), h1 = tr_read<v_rd_off(D0, 1, 1)>(vb);
    const s16x4 l2 = tr_read<v_rd_off(D0, 2, 0)>(vb), h2 = tr_read<v_rd_off(D0, 2, 1)>(vb), l3 = tr_read<v_rd_off(D0, 3, 0)>(vb), h3 = tr_read<v_rd_off(D0, 3, 1)>(vb);
    asm volatile("s_waitcnt lgkmcnt(0)" ::: "memory"); SBAR();
#define PK(L, H) (bf16x8){L[0], L[1], L[2], L[3], H[0], H[1], H[2], H[3]}
    od = __builtin_amdgcn_mfma_f32_32x32x16_bf16(pa0, PK(l0, h0), od, 0, 0, 0);
    od = __builtin_amdgcn_mfma_f32_32x32x16_bf16(pa1, PK(l1, h1), od, 0, 0, 0);
    od = __builtin_amdgcn_mfma_f32_32x32x16_bf16(pa2, PK(l2, h2), od, 0, 0, 0);
    od = __builtin_amdgcn_mfma_f32_32x32x16_bf16(pa3, PK(l3, h3), od, 0, 0, 0);
#undef PK
}

namespace att {
constexpr int SHM_V = 16384, SHM_K = 8192, OFF_K = 2 * SHM_V, OFF_WS = OFF_K + 2 * SHM_K;
#define KSWZ(row, colB) ((row) * 128 + ((colB) ^ (((row) & 7) << 4)))
__device__ __forceinline__ void qkt(f32x16& p0, f32x16& p1, const char* Ks, const bf16x8* qr, int r32, int hi) {
    p0 = f32x16{}; p1 = f32x16{};
#pragma unroll
    for (int d0 = 0; d0 < 4; ++d0) { const int cb = (d0 * 16 + hi * 8) * 2;
        const bf16x8 b0 = *reinterpret_cast<const bf16x8*>(Ks + KSWZ(r32, cb));
        const bf16x8 b1 = *reinterpret_cast<const bf16x8*>(Ks + KSWZ(32 + r32, cb));
        p0 = __builtin_amdgcn_mfma_f32_32x32x16_bf16(b0, qr[d0], p0, 0, 0, 0);
        p1 = __builtin_amdgcn_mfma_f32_32x32x16_bf16(b1, qr[d0], p1, 0, 0, 0); }
}
__device__ __forceinline__ void partialSM(f32x16& p0) {
#pragma unroll
    for (int r = 0; r < 16; ++r) p0[r] = __builtin_amdgcn_exp2f(p0[r]);
}
__device__ __forceinline__ void finishSM(f32x16& p0, f32x16& p1, float& l_reg, bf16x8& pa0, bf16x8& pa1, bf16x8& pa2, bf16x8& pa3) {
#pragma unroll
    for (int r = 0; r < 16; ++r) p1[r] = __builtin_amdgcn_exp2f(p1[r]);
    float ps = 0.f;
#pragma unroll
    for (int r = 0; r < 16; ++r) ps += p0[r];
#pragma unroll
    for (int r = 0; r < 16; ++r) ps += p1[r];
    l_reg += ps;
#define PK4(P, BASE, OUT) do { unsigned a0 = cvt_pk_bf16(P[BASE + 0], P[BASE + 1]), a1 = cvt_pk_bf16(P[BASE + 2], P[BASE + 3]);   \
    unsigned b0 = cvt_pk_bf16(P[BASE + 4], P[BASE + 5]), b1 = cvt_pk_bf16(P[BASE + 6], P[BASE + 7]);                              \
    auto r0 = __builtin_amdgcn_permlane32_swap(a0, b0, false, false); auto r1 = __builtin_amdgcn_permlane32_swap(a1, b1, false, false); \
    u32x4 w = {r0[0], r1[0], r0[1], r1[1]}; OUT = *reinterpret_cast<bf16x8*>(&w); } while (0)
    PK4(p0, 0, pa0); PK4(p0, 8, pa1); PK4(p1, 0, pa2); PK4(p1, 8, pa3);
#undef PK4
}
__device__ __forceinline__ void pv_d0(f32x16* o, int vb, bf16x8 pa0, bf16x8 pa1, bf16x8 pa2, bf16x8 pa3) {
    pv_one<0>(o[0], vb, pa0, pa1, pa2, pa3); pv_one<1>(o[1], vb, pa0, pa1, pa2, pa3); pv_one<2>(o[2], vb, pa0, pa1, pa2, pa3); pv_one<3>(o[3], vb, pa0, pa1, pa2, pa3);
}
constexpr int RSK = 272;
constexpr int SHM_K2 = 64 * RSK, OFF_K2 = 2 * SHM_V, OFF_Q2 = OFF_K2 + 2 * SHM_K2, OFF_WS2 = OFF_Q2 + 65536;
template <int S, int HALF_> __device__ __forceinline__ void qkt2(f32x16& p, const char* kr_, const char* qp_) {
    p = f32x16{};
#pragma unroll
    for (int d0 = 0; d0 < 4; ++d0) {
        const bf16x8 b0 = *reinterpret_cast<const bf16x8*>(kr_ + HALF_ * 32 * RSK + S * 128 + d0 * 32);
        const bf16x8 q = *reinterpret_cast<const bf16x8*>(qp_ + (S * 4 + d0) * 1024);
        p = __builtin_amdgcn_mfma_f32_32x32x16_bf16(b0, q, p, 0, 0, 0); }
}
template <int D0, int KH> __device__ __forceinline__ void pv_two(f32x16& oa, f32x16& ob, int vb, bf16x8 pa0, bf16x8 pa1, bf16x8 pb0, bf16x8 pb1) {
    const s16x4 l0 = tr_read<v_rd_off(D0, 2 * KH, 0)>(vb), h0 = tr_read<v_rd_off(D0, 2 * KH, 1)>(vb), l1 = tr_read<v_rd_off(D0, 2 * KH + 1, 0)>(vb), h1 = tr_read<v_rd_off(D0, 2 * KH + 1, 1)>(vb);
    asm volatile("s_waitcnt lgkmcnt(0)" ::: "memory"); SBAR();
#define PK(L, H) (bf16x8){L[0], L[1], L[2], L[3], H[0], H[1], H[2], H[3]}
    const bf16x8 v0 = PK(l0, h0), v1 = PK(l1, h1);
#undef PK
    oa = __builtin_amdgcn_mfma_f32_32x32x16_bf16(pa0, v0, oa, 0, 0, 0); ob = __builtin_amdgcn_mfma_f32_32x32x16_bf16(pb0, v0, ob, 0, 0, 0);
    oa = __builtin_amdgcn_mfma_f32_32x32x16_bf16(pa1, v1, oa, 0, 0, 0); ob = __builtin_amdgcn_mfma_f32_32x32x16_bf16(pb1, v1, ob, 0, 0, 0);
}
__device__ __forceinline__ void attn_unit(ArgP a, int l, int unit, char* lds, const int tid_) {
    int tid = tid_; asm volatile("" : "+v"(tid));
    const int wid = tid >> 6, lane = tid & 63, r32 = lane & 31, hi = lane >> 5;
    const bf16_t* Kb = (const bf16_t*)(a->ws + WS_KB); const bf16_t* Qb = (const bf16_t*)(a->ws + WS_QB); const bf16_t* Vb = (const bf16_t*)(a->ws + WS_VB);
    int b, h, qrow0, t0, NT;
    if (unit < 256) { b = unit >> 6; h = (unit >> 4) & 3; qrow0 = b * 4096 + (unit & 15) * 256; t0 = 0; NT = 68; }
    else { const int cu = unit - 256; b = cu >> 2; h = cu & 3; qrow0 = ML + b * 256; t0 = 64; NT = 4; }
    char* V_lds = lds; char* K_lds = lds + OFF_K2;
    char* qp = lds + OFF_Q2 + wid * 8192 + lane * 16;
    {   const bf16_t* Qw = Qb + (size_t)(qrow0 + wid * 32 + r32) * 512 + h * 128 + hi * 8;
#pragma unroll
        for (int f = 0; f < 8; ++f) *reinterpret_cast<bf16x8*>(qp + f * 1024) = *reinterpret_cast<const bf16x8*>(Qw + (f >> 2) * 64 + (f & 3) * 16); }
    const int kr = tid >> 3, kc = tid & 7;
    const int sr = tid >> 4, sc = (tid & 15) * 8, vst0 = v_st(sr, sc), vst1 = v_st(32 + sr, sc);
    const int vb0 = (int)(uintptr_t)V_lds + v_rd_base(lane);
    const int kst = kr * RSK + kc * 32;
    const char* krd = K_lds + r32 * RSK + hi * 16;
    bf16x8 s_v0, s_v1, s_k0, s_k1;
#define TROW(t) ((t) < 64 ? (size_t)b * 4096 + (size_t)(t) * 64 : (size_t)ML + (size_t)b * 256 + (size_t)((t) - 64) * 64)
    const unsigned voff_ = (unsigned)(sr * 512 + h * 128 + sc) * 2u, koff_ = (unsigned)(kr * 1024 + h * 256 + kc * 32);
#define SLOAD(t) do { const size_t r0_ = TROW(t) * 1024; const char* vt_ = (const char*)Vb + r0_; const char* kt_ = (const char*)Kb + r0_; \
    s_v0 = *reinterpret_cast<const bf16x8*>(vt_ + voff_); s_v1 = *reinterpret_cast<const bf16x8*>(vt_ + 32768 + voff_); \
    s_k0 = *reinterpret_cast<const bf16x8*>(kt_ + koff_); s_k1 = *reinterpret_cast<const bf16x8*>(kt_ + koff_ + 16); } while (0)
#define SWRITE(bb) do { *(bf16x8*)(V_lds + (bb) * SHM_V + vst0) = s_v0; *(bf16x8*)(V_lds + (bb) * SHM_V + vst1) = s_v1; \
    *(bf16x8*)(K_lds + (bb) * SHM_K2 + kst) = s_k0; *(bf16x8*)(K_lds + (bb) * SHM_K2 + kst + 16) = s_k1; } while (0)
#define EXPSUM(L_) do { float ps_ = 0.f; _Pragma("unroll") for (int r_ = 0; r_ < 16; ++r_) { p[r_] = __builtin_amdgcn_exp2f(p[r_]); ps_ += p[r_]; } L_ += ps_; } while (0)
#define PK4(P, BASE, OUT) do { unsigned a0 = cvt_pk_bf16(P[BASE + 0], P[BASE + 1]), a1 = cvt_pk_bf16(P[BASE + 2], P[BASE + 3]);   \
    unsigned b0 = cvt_pk_bf16(P[BASE + 4], P[BASE + 5]), b1 = cvt_pk_bf16(P[BASE + 6], P[BASE + 7]);                              \
    auto r0 = __builtin_amdgcn_permlane32_swap(a0, b0, false, false); auto r1 = __builtin_amdgcn_permlane32_swap(a1, b1, false, false); \
    u32x4 w = {r0[0], r1[0], r0[1], r1[1]}; OUT = *reinterpret_cast<bf16x8*>(&w); } while (0)
    f32x16 o0[4] = {}, o1[4] = {}; float l0 = 0.f, l1 = 0.f;
    SLOAD(t0); SWRITE(0); __syncthreads();
    if (1 < NT) SLOAD(t0 + 1);
#pragma nounroll
    for (int j = 0; j < NT; ++j) {
        int bb = j & 1; asm volatile("" : "+s"(bb));
        SBAR();
        const char* ks_ = krd + bb * SHM_K2; const int vb_ = vb0 + bb * SHM_V;
        {   f32x16 p; bf16x8 pa0, pa1, pb0, pb1;
            qkt2<0, 0>(p, ks_, qp); EXPSUM(l0); PK4(p, 0, pa0); PK4(p, 8, pa1); SBAR();
            qkt2<1, 0>(p, ks_, qp); EXPSUM(l1); PK4(p, 0, pb0); PK4(p, 8, pb1); SBAR();
            pv_two<0, 0>(o0[0], o1[0], vb_, pa0, pa1, pb0, pb1); pv_two<1, 0>(o0[1], o1[1], vb_, pa0, pa1, pb0, pb1); pv_two<2, 0>(o0[2], o1[2], vb_, pa0, pa1, pb0, pb1); pv_two<3, 0>(o0[3], o1[3], vb_, pa0, pa1, pb0, pb1); }
        SBAR();
        if (j + 1 < NT) { SWRITE(bb ^ 1); if (j + 2 < NT) SLOAD(t0 + j + 2); }
        SBAR();
        {   f32x16 p; bf16x8 pa0, pa1, pb0, pb1;
            qkt2<0, 1>(p, ks_, qp); EXPSUM(l0); PK4(p, 0, pa0); PK4(p, 8, pa1); SBAR();
            qkt2<1, 1>(p, ks_, qp); EXPSUM(l1); PK4(p, 0, pb0); PK4(p, 8, pb1); SBAR();
            pv_two<0, 1>(o0[0], o1[0], vb_, pa0, pa1, pb0, pb1); pv_two<1, 1>(o0[1], o1[1], vb_, pa0, pa1, pb0, pb1); pv_two<2, 1>(o0[2], o1[2], vb_, pa0, pa1, pb0, pb1); pv_two<3, 1>(o0[3], o1[3], vb_, pa0, pa1, pb0, pb1); }
        __syncthreads();
    }
#undef TROW
#undef SLOAD
#undef SWRITE
#undef EXPSUM
#undef PK4
    int tid2 = tid_; asm volatile("" : "+v"(tid2));
    const int wid2 = tid2 >> 6, lane2 = tid2 & 63, r32e = lane2 & 31, hie = lane2 >> 5;
    { auto rr = __builtin_amdgcn_permlane32_swap(__float_as_uint(l0), __float_as_uint(l0), false, false); l0 = __uint_as_float(rr[0]) + __uint_as_float(rr[1]); }
    { auto rr = __builtin_amdgcn_permlane32_swap(__float_as_uint(l1), __float_as_uint(l1), false, false); l1 = __uint_as_float(rr[0]) + __uint_as_float(rr[1]); }
    const bf16_t* Z = (const bf16_t*)(a->ws + WS_Z); bf16_t* Y = (bf16_t*)(a->ws + WS_RW);
    const float* SCAL = (const float*)(a->ws + WS_SCAL) + l * 8;
    const float lam = SCAL[0], oml = SCAL[2];
    const float* sg = a->in[15] + l * 128;
    float* li_l = (float*)(lds + OFF_WS2) + wid2 * 128;
    if (hie == 0) { li_l[r32e] = l0; li_l[64 + r32e] = l1; } asm volatile("s_waitcnt lgkmcnt(0)" ::: "memory");
    float ss[16];
#pragma unroll
    for (int r = 0; r < 16; ++r) { const float ra = __builtin_amdgcn_rcpf(li_l[crow(r, hie)]), rb_ = lam * __builtin_amdgcn_rcpf(li_l[64 + crow(r, hie)]); float s = 0.f;
#pragma unroll
        for (int d0 = 0; d0 < 4; ++d0) { const float v = o0[d0][r] * ra - o1[d0][r] * rb_; o0[d0][r] = v; s += v * v; }
        s += __shfl_xor(s, 1); s += __shfl_xor(s, 2); s += __shfl_xor(s, 4); s += __shfl_xor(s, 8); s += __shfl_xor(s, 16);
        ss[r] = oml / sqrtf(s * (1.0f / 128.0f) + NORM_EPS); }
    const GAS bf16_t* Z_ = (const GAS bf16_t*)Z; GAS bf16_t* Y_ = (GAS bf16_t*)Y;
#pragma unroll
    for (int d0 = 0; d0 < 4; ++d0) { const int col = h * 128 + d0 * 32 + r32e; const float g = sg[d0 * 32 + r32e];
        const size_t rb = (size_t)(qrow0 + wid2 * 32 + 4 * hie) * 1536 + 512 + col;
        unsigned short zq[16];
#pragma unroll
        for (int r = 0; r < 16; ++r) zq[r] = Z_[rb + (size_t)((r & 3) + 8 * (r >> 2)) * 1536];
#pragma unroll
        for (int r = 0; r < 16; ++r) { const size_t idx = rb + (size_t)((r & 3) + 8 * (r >> 2)) * 1536;
            const float y = o0[d0][r] * ss[r] * g * bf2f(zq[r]);
            __hip_atomic_store((unsigned short*)(Y + idx), (unsigned short)(cvt_pk_bf16(y, 0.f) & 0xffffu), __ATOMIC_RELAXED, __HIP_MEMORY_SCOPE_AGENT); }
        asm volatile("" ::: "memory"); }
    asm volatile("s_waitcnt vmcnt(0) lgkmcnt(0)" ::: "memory");
    __syncthreads();
}
}

__device__ __forceinline__ void gmlp_unit(ArgP a, int l, int unit, char* lds, const int tid) {
    const int wid = tid >> 6, lane = tid & 63, r32 = lane & 31, hi = lane >> 5;
    const int chunk = unit >> 2, g = unit & 3; const size_t row0 = (size_t)chunk * 128;
    const bf16_t* VA = (const bf16_t*)(a->ws + WS_VA); const bf16_t* GU = (const bf16_t*)(a->ws + WS_GU); const bf16_t* Z = (const bf16_t*)(a->ws + WS_Z); bf16_t* Y = (bf16_t*)(a->ws + WS_RW);
    const float* Ws = a->in[10] + ((size_t)l * 4 + g) * 128 * 128; const float* bs = a->in[11] + (l * 4 + g) * 128;
    const int sr = tid >> 4, sc = (tid & 15) * 8;
#pragma unroll
    for (int t = 0; t < 2; ++t) {
        const bf16x8 v0 = *reinterpret_cast<const bf16x8*>(VA + (row0 + t * 64 + sr) * 512 + g * 128 + sc);
        const bf16x8 v1 = *reinterpret_cast<const bf16x8*>(VA + (row0 + t * 64 + 32 + sr) * 512 + g * 128 + sc);
        *(bf16x8*)(lds + t * 16384 + v_st(sr, sc)) = v0; *(bf16x8*)(lds + t * 16384 + v_st(32 + sr, sc)) = v1; }
    __syncthreads();
    const int pb = (wid & 3) * 32, ch = wid >> 2;
    const int vb0 = (int)(uintptr_t)lds + v_rd_base(lane);
    f32x16 o0 = {}, o1 = {};
#pragma unroll
    for (int t = 0; t < 2; ++t) {
        bf16x8 pa[4];
#pragma unroll
        for (int ks = 0; ks < 4; ++ks) { const float* wp = Ws + (size_t)(pb + r32) * 128 + t * 64 + ks * 16 + hi * 8;
            const f32x4 w0 = *(const f32x4*)wp, w1 = *(const f32x4*)(wp + 4);
            u32x4 w = {cvt_pk_bf16(w0.x, w0.y), cvt_pk_bf16(w0.z, w0.w), cvt_pk_bf16(w1.x, w1.y), cvt_pk_bf16(w1.z, w1.w)}; pa[ks] = *reinterpret_cast<bf16x8*>(&w); }
        if (ch == 0) { pv_one<0>(o0, vb0 + t * 16384, pa[0], pa[1], pa[2], pa[3]); pv_one<1>(o1, vb0 + t * 16384, pa[0], pa[1], pa[2], pa[3]); }
        else         { pv_one<2>(o0, vb0 + t * 16384, pa[0], pa[1], pa[2], pa[3]); pv_one<3>(o1, vb0 + t * 16384, pa[0], pa[1], pa[2], pa[3]); }
    }
    {   unsigned short gq[32], zq[32]; float bq[16];
#pragma unroll
        for (int r = 0; r < 16; ++r) { const int p = pb + crow(r, hi); bq[r] = bs[p]; const size_t row = row0 + p;
#pragma unroll
            for (int d = 0; d < 2; ++d) { const int col = g * 128 + ch * 64 + d * 32 + r32; gq[2 * r + d] = GU[row * 512 + col]; zq[2 * r + d] = Z[row * 1536 + col]; } }
#pragma unroll
        for (int r = 0; r < 16; ++r) { const int p = pb + crow(r, hi); const size_t row = row0 + p;
#pragma unroll
            for (int d = 0; d < 2; ++d) { const int col = g * 128 + ch * 64 + d * 32 + r32;
                const float s = (d == 0 ? o0[r] : o1[r]) + bq[r];
                const float y = bf2f(gq[2 * r + d]) * s * bf2f(zq[2 * r + d]);
                Y[row * 1536 + col] = (bf16_t)(cvt_pk_bf16(y, 0.f) & 0xffffu); } } }
    __syncthreads();
}

template <int CTRL> __device__ __forceinline__ float dppf(float v) { return __builtin_bit_cast(float, __builtin_amdgcn_update_dpp(0, __builtin_bit_cast(int, v), CTRL, 0xF, 0xF, true)); }
__device__ __forceinline__ float allreduce16(float x) { x += dppf<0xB1>(x); x += dppf<0x4E>(x); x += dppf<0x141>(x); x += dppf<0x140>(x); return x; }
namespace scanc {
constexpr int CS = 16, NBLK = (256 + 4096) / CS;
constexpr int RS = 144;
constexpr int O_AK = 0, O_KHB = 32 * RS, O_V = 64 * RS, O_T = 80 * RS, O_X = O_T + 1024, O_BK = O_X + 1024, O_NBB = O_BK + 1024, O_GC = O_NBB + 1024, O_F = O_GC + 256, SLOT = O_F + 2048, NSLOT = 6;
constexpr int O_CTL = NSLOT * SLOT;
__device__ __forceinline__ int perm16(int m) { return 8 * ((m >> 2) & 1) + 4 * (m >> 3) + (m & 3); }
__device__ __forceinline__ bf16x8 pack_tile8(const f32x16& x, int base) {
    u32x4 w = {cvt_pk_bf16(x[base + 0], x[base + 1]), cvt_pk_bf16(x[base + 2], x[base + 3]), cvt_pk_bf16(x[base + 4], x[base + 5]), cvt_pk_bf16(x[base + 6], x[base + 7])};
    return __builtin_bit_cast(bf16x8, w);
}
__device__ __forceinline__ unsigned short f2bf_s(float f) { return (unsigned short)(cvt_pk_bf16(f, 0.f) & 0xffffu); }
constexpr int O_ID = O_CTL + 1024;
__device__ __forceinline__ void scan_unit(ArgP a, int l, int chain, LAS char* lds, const int tid, unsigned* ctxflag) {
    const int wid = __builtin_amdgcn_readfirstlane(tid >> 6), lane = tid & 63, r32 = lane & 31, hi = lane >> 5;
    const int d = chain >> 5, b = (chain >> 3) & 3, h = chain & 7;
    const bf16_t* RWP = (const bf16_t*)(a->ws + WS_RWP); const bf16_t* WA = (const bf16_t*)(a->ws + WS_WA); bf16_t* YD = (bf16_t*)(a->ws + WS_YD) + (size_t)d * MT * 512;
    volatile LAS unsigned* ctl = (volatile LAS unsigned*)(lds + O_CTL);
    if (tid < 8) ctl[tid] = 0u;
    *(LAS float*)(lds + O_ID + (tid >> 5) * 128 + (tid & 31) * 4) = (tid >> 5) == (tid & 31) ? 1.0f : 0.f;
    __syncthreads();
#define ROWOF(s) ((s) < 256 ? (size_t)ML + (size_t)b * 256 + (size_t)(d ? 255 - (s) : (s)) : (size_t)b * 4096 + (size_t)(d ? 4095 - ((s) - 256) : (s) - 256))
    if (wid >= 2) {
        const int sw = wid - 2; LAS char* sl = lds + sw * SLOT;
        const int st = lane & 15, cq = lane >> 4, ps = perm16(st);
        const float* kap = a->in[22] + l * 512 + h * 64 + cq * 16;
        const f32x4 ka0 = *(const f32x4*)kap, ka1 = *(const f32x4*)(kap + 4), ka2 = *(const f32x4*)(kap + 8), ka3 = *(const f32x4*)(kap + 12);
        const int hig = lane >> 5, jj = (r32 & 15) - 4 * hig;
        const int goff = O_F + hig * 512 + r32 * 4;
        const int boff = (r32 < 16 ? O_BK + (r32 & 15) * 2 : O_NBB + perm16(r32 & 15) * 2) + hig * 128;
        const int sc_ = lane & 15; const bool isT = lane < 16;
        const int ooff = isT ? O_T + perm16(sc_) * 2 : O_X + sc_ * 2;
        u32x4 W[12];
#define LOADRAW(bb_) do { const size_t rw = ROWOF((bb_) * CS + st); const bf16_t* p = RWP + rw * 2048 + h * 64 + cq * 16; const bf16_t* q = WA + rw * 2048 + d * 512 + h * 64 + cq * 16; \
            W[0] = *(const u32x4*)p; W[1] = *(const u32x4*)(p + 8); W[2] = *(const u32x4*)(p + 512); W[3] = *(const u32x4*)(p + 520); W[4] = *(const u32x4*)(p + 1024); W[5] = *(const u32x4*)(p + 1032); \
            W[6] = *(const u32x4*)(p + 1536); W[7] = *(const u32x4*)(p + 1544); W[8] = *(const u32x4*)q; W[9] = *(const u32x4*)(q + 8); W[10] = *(const u32x4*)(q + 1024); W[11] = *(const u32x4*)(q + 1032); } while (0)
        LOADRAW(sw);
        for (int bi = sw; bi < NBLK; bi += NSLOT) {
            if (bi >= NSLOT) { const unsigned need = (unsigned)(bi - NSLOT + 1); while (ctl[6] < need || ctl[7] < need) __builtin_amdgcn_s_sleep(1); }
            asm volatile("" ::: "memory");
            {
                *(LAS u32x4*)(sl + O_V + st * RS + cq * 32) = W[4]; *(LAS u32x4*)(sl + O_V + st * RS + cq * 32 + 16) = W[5];
                float kk[16], kx[16], rr[16], om[16], aa[16];
                unpack8(W[0], *(float(*)[8])&kk[0]); unpack8(W[1], *(float(*)[8])&kk[8]); unpack8(W[2], *(float(*)[8])&kx[0]); unpack8(W[3], *(float(*)[8])&kx[8]);
                unpack8(W[6], *(float(*)[8])&rr[0]); unpack8(W[7], *(float(*)[8])&rr[8]);
                unpack8(W[8], *(float(*)[8])&om[0]); unpack8(W[9], *(float(*)[8])&om[8]); unpack8(W[10], *(float(*)[8])&aa[0]); unpack8(W[11], *(float(*)[8])&aa[8]);
                { const int bn = bi + NSLOT < NBLK ? bi + NSLOT : NBLK - 1; LOADRAW(bn); }
                unsigned ktp[8], rtp[8], khp[8], bhp[8]; float G[16];
#pragma unroll
                for (int c = 0; c < 16; ++c) G[c] = 1.0f - om[c];
#define DPPL(S) "v_mul_f32_dpp %0, %0, %0 " S " row_mask:0xf bank_mask:0xf\n v_mul_f32_dpp %1, %1, %1 " S " row_mask:0xf bank_mask:0xf\n v_mul_f32_dpp %2, %2, %2 " S " row_mask:0xf bank_mask:0xf\n v_mul_f32_dpp %3, %3, %3 " S " row_mask:0xf bank_mask:0xf\n" \
                "v_mul_f32_dpp %4, %4, %4 " S " row_mask:0xf bank_mask:0xf\n v_mul_f32_dpp %5, %5, %5 " S " row_mask:0xf bank_mask:0xf\n v_mul_f32_dpp %6, %6, %6 " S " row_mask:0xf bank_mask:0xf\n v_mul_f32_dpp %7, %7, %7 " S " row_mask:0xf bank_mask:0xf\n" \
                "v_mul_f32_dpp %8, %8, %8 " S " row_mask:0xf bank_mask:0xf\n v_mul_f32_dpp %9, %9, %9 " S " row_mask:0xf bank_mask:0xf\n v_mul_f32_dpp %10, %10, %10 " S " row_mask:0xf bank_mask:0xf\n v_mul_f32_dpp %11, %11, %11 " S " row_mask:0xf bank_mask:0xf\n" \
                "v_mul_f32_dpp %12, %12, %12 " S " row_mask:0xf bank_mask:0xf\n v_mul_f32_dpp %13, %13, %13 " S " row_mask:0xf bank_mask:0xf\n v_mul_f32_dpp %14, %14, %14 " S " row_mask:0xf bank_mask:0xf\n v_mul_f32_dpp %15, %15, %15 " S " row_mask:0xf bank_mask:0xf\n"
                asm volatile("s_nop 1\n" DPPL("row_shr:1") DPPL("row_shr:2") DPPL("row_shr:4") DPPL("row_shr:8") "s_nop 1\n"
                    : "+v"(G[0]), "+v"(G[1]), "+v"(G[2]), "+v"(G[3]), "+v"(G[4]), "+v"(G[5]), "+v"(G[6]), "+v"(G[7]), "+v"(G[8]), "+v"(G[9]), "+v"(G[10]), "+v"(G[11]), "+v"(G[12]), "+v"(G[13]), "+v"(G[14]), "+v"(G[15]));
#undef DPPL
#pragma unroll
                for (int m = 0; m < 8; ++m) { float v4[8];
#pragma unroll
                    for (int e = 0; e < 2; ++e) { const int c = 2 * m + e; const float g = G[c];
                        const float gp = __builtin_bit_cast(float, __builtin_amdgcn_update_dpp(0x3f800000, __builtin_bit_cast(int, g), 0x111, 0xF, 0xF, false));
                        const float ig = __builtin_amdgcn_rcpf(g);
                        const float kac = c < 4 ? ka0[c & 3] : c < 8 ? ka1[c & 3] : c < 12 ? ka2[c & 3] : ka3[c & 3];
                        const float kd = kx[c] * (1.0f + (aa[c] - 1.0f) * kac), be = kk[c] * aa[c];
                        v4[e] = kk[c] * gp; v4[2 + e] = rr[c] * g; v4[4 + e] = kd * ig; v4[6 + e] = be * ig; }
                    ktp[m] = cvt_pk_bf16(v4[0], v4[1]); rtp[m] = cvt_pk_bf16(v4[2], v4[3]); khp[m] = cvt_pk_bf16(v4[4], v4[5]); bhp[m] = cvt_pk_bf16(v4[6], v4[7]); }
                *(LAS u32x4*)(sl + O_AK + st * RS + cq * 32) = (u32x4){ktp[0], ktp[1], ktp[4], ktp[5]}; *(LAS u32x4*)(sl + O_AK + st * RS + cq * 32 + 16) = (u32x4){ktp[2], ktp[3], ktp[6], ktp[7]};
                *(LAS u32x4*)(sl + O_AK + (16 + st) * RS + cq * 32) = (u32x4){rtp[0], rtp[1], rtp[4], rtp[5]}; *(LAS u32x4*)(sl + O_AK + (16 + st) * RS + cq * 32 + 16) = (u32x4){rtp[2], rtp[3], rtp[6], rtp[7]};
                *(LAS u32x4*)(sl + O_KHB + st * RS + cq * 32) = (u32x4){khp[0], khp[1], khp[2], khp[3]}; *(LAS u32x4*)(sl + O_KHB + st * RS + cq * 32 + 16) = (u32x4){khp[4], khp[5], khp[6], khp[7]};
                *(LAS u32x4*)(sl + O_KHB + (16 + st) * RS + cq * 32) = (u32x4){bhp[0] ^ 0x80008000u, bhp[1] ^ 0x80008000u, bhp[2] ^ 0x80008000u, bhp[3] ^ 0x80008000u};
                *(LAS u32x4*)(sl + O_KHB + (16 + st) * RS + cq * 32 + 16) = (u32x4){bhp[4] ^ 0x80008000u, bhp[5] ^ 0x80008000u, bhp[6] ^ 0x80008000u, bhp[7] ^ 0x80008000u};
                if (st == 15) {
                    *(LAS f32x4*)(sl + O_GC + cq * 64) = (f32x4){G[0], G[1], G[2], G[3]}; *(LAS f32x4*)(sl + O_GC + cq * 64 + 16) = (f32x4){G[4], G[5], G[6], G[7]};
                    *(LAS f32x4*)(sl + O_GC + cq * 64 + 32) = (f32x4){G[8], G[9], G[10], G[11]}; *(LAS f32x4*)(sl + O_GC + cq * 64 + 48) = (f32x4){G[12], G[13], G[14], G[15]}; }
            }
            asm volatile("s_waitcnt lgkmcnt(0)" ::: "memory");
            f32x16 gr = {};
            {   const LAS char* ga = sl + O_AK + r32 * RS + hig * 16; const LAS char* gb = sl + O_KHB + r32 * RS + hig * 8;
                bf16x8 fa[4]; u32x2 fl[4], fh[4];
#pragma unroll
                for (int q = 0; q < 4; ++q) { fa[q] = *(const LAS bf16x8*)(ga + q * 32); fl[q] = *(const LAS u32x2*)(gb + q * 32); fh[q] = *(const LAS u32x2*)(gb + q * 32 + 16); }
#pragma unroll
                for (int q = 0; q < 4; ++q) { const u32x4 fb = {fl[q][0], fl[q][1], fh[q][0], fh[q][1]};
                    gr = __builtin_amdgcn_mfma_f32_32x32x16_bf16(fa[q], __builtin_bit_cast(bf16x8, fb), gr, 0, 0, 0); } }
#pragma unroll
            for (int r = 0; r < 16; ++r) { const int cr = (r & 3) + 8 * (r >> 2);
                const bool keep = r < 8 ? (jj < cr) : (jj <= cr - 16); const float g = keep ? gr[r] : 0.f;
                if (r < 8) *(LAS float*)(sl + goff + cr * 128) = g;
                else *(LAS unsigned short*)(sl + boff + (cr - 16) * 32) = f2bf_s(g); }
            asm volatile("s_waitcnt lgkmcnt(0)" ::: "memory");
            if (lane < 32) { const LAS char* rhs = isT ? lds + O_ID + sc_ * 4 : sl + O_F + sc_ * 4; float t[CS];
#pragma unroll
                for (int i = 0; i < CS; ++i) t[i] = *(const LAS float*)(rhs + i * 128);
#define ABQ(i, q) (*(const LAS f32x4*)(sl + O_F + (i) * 128 + 64 + (q) * 16))
#define SROW(i, Q0, Q1, Q2, Q3) do { const f32x4 qq_[4] = {Q0, Q1, Q2, Q3}; f32x2 acc2 = {t[i], 0.f}; \
                    _Pragma("unroll") for (int j = 0; j + 1 < (i); j += 2) acc2 += (f32x2){qq_[j >> 2][j & 3], qq_[(j + 1) >> 2][(j + 1) & 3]} * (f32x2){t[j], t[j + 1]}; \
                    float acc = acc2[0] + acc2[1]; if ((i) & 1) acc += qq_[((i) - 1) >> 2][((i) - 1) & 3] * t[(i) - 1]; t[i] = acc; } while (0)
                {   const f32x4 a1 = ABQ(1, 0), a2 = ABQ(2, 0), a3 = ABQ(3, 0), a4 = ABQ(4, 0), a50 = ABQ(5, 0), a51 = ABQ(5, 1), a60 = ABQ(6, 0), a61 = ABQ(6, 1), a70 = ABQ(7, 0), a71 = ABQ(7, 1), a80 = ABQ(8, 0), a81 = ABQ(8, 1);
                    SBAR();
                    SROW(1, a1, a1, a1, a1); SROW(2, a2, a2, a2, a2); SROW(3, a3, a3, a3, a3); SROW(4, a4, a4, a4, a4);
                    SROW(5, a50, a51, a51, a51); SROW(6, a60, a61, a61, a61); SROW(7, a70, a71, a71, a71); SROW(8, a80, a81, a81, a81); }
                SBAR();
                {   const f32x4 a90 = ABQ(9, 0), a91 = ABQ(9, 1), a92 = ABQ(9, 2), aa0 = ABQ(10, 0), aa1 = ABQ(10, 1), aa2 = ABQ(10, 2), ab0 = ABQ(11, 0), ab1 = ABQ(11, 1), ab2 = ABQ(11, 2), ac0 = ABQ(12, 0), ac1 = ABQ(12, 1), ac2 = ABQ(12, 2);
                    SBAR();
                    SROW(9, a90, a91, a92, a92); SROW(10, aa0, aa1, aa2, aa2); SROW(11, ab0, ab1, ab2, ab2); SROW(12, ac0, ac1, ac2, ac2); }
                SBAR();
                {   const f32x4 ad0 = ABQ(13, 0), ad1 = ABQ(13, 1), ad2 = ABQ(13, 2), ad3 = ABQ(13, 3), ae0 = ABQ(14, 0), ae1 = ABQ(14, 1), ae2 = ABQ(14, 2), ae3 = ABQ(14, 3), af0 = ABQ(15, 0), af1 = ABQ(15, 1), af2 = ABQ(15, 2), af3 = ABQ(15, 3);
                    SBAR();
                    SROW(13, ad0, ad1, ad2, ad3); SROW(14, ae0, ae1, ae2, ae3); SROW(15, af0, af1, af2, af3); }
#undef SROW
#undef ABQ
#pragma unroll
                for (int i = 0; i < CS; ++i) *(LAS unsigned short*)(sl + ooff + i * 32) = f2bf_s(t[i]); }
            asm volatile("s_waitcnt lgkmcnt(0)" ::: "memory");
            if (lane == 0) ctl[sw] = (unsigned)(bi + 1);
        }
    } else {
        f32x16 Z0 = {}, Z1 = {};
        const int rho = wid * 32 + r32;
        const int trb = (int)(uintptr_t)lds + ((lane >> 2) & 3) * RS + (16 * ((lane >> 4) & 1) + 4 * (lane & 3)) * 2;
        const int trk = trb + 8 * hi * RS, trn = trb + 4 * hi * RS;
        const unsigned yoff = (unsigned)(((d ? 15 - 4 * hi : 4 * hi) * 512 + h * 64 + rho) * 2);
        for (int bi = 0; bi < NBLK; ++bi) {
            const int sw = bi % NSLOT; const LAS char* sl = lds + sw * SLOT;
            while (ctl[sw] != (unsigned)(bi + 1)) __builtin_amdgcn_s_sleep(1);
            asm volatile("" ::: "memory");
            const LAS char* ra = sl + r32 * RS + hi * 16; const LAS char* rb = sl + r32 * 32 + hi * 16;
            const bf16x8 ak0 = *(const LAS bf16x8*)(ra + O_AK), ak1 = *(const LAS bf16x8*)(ra + O_AK + 32), ak2 = *(const LAS bf16x8*)(ra + O_AK + 64), ak3 = *(const LAS bf16x8*)(ra + O_AK + 96);
            const bf16x8 tq = *(const LAS bf16x8*)(rb + O_T), xq = *(const LAS bf16x8*)(rb + O_X), bkq = *(const LAS bf16x8*)(rb + O_BK), nbbq = *(const LAS bf16x8*)(rb + O_NBB);
            const int tk = trk + sw * SLOT, tn = trn + sw * SLOT;
            const s16x4 kb0l = tr_read<O_KHB>(tk), kb0h = tr_read<O_KHB + 4 * RS>(tk), kb1l = tr_read<O_KHB + 64>(tk), kb1h = tr_read<O_KHB + 4 * RS + 64>(tk);
            const s16x4 nb0l = tr_read<O_KHB + 16 * RS>(tn), nb0h = tr_read<O_KHB + 24 * RS>(tn), nb1l = tr_read<O_KHB + 16 * RS + 64>(tn), nb1h = tr_read<O_KHB + 24 * RS + 64>(tn);
            const s16x4 vfl = tr_read<O_V>(tk + wid * 64), vfh = tr_read<O_V + 4 * RS>(tk + wid * 64);
            f32x4 gc0[4], gc1[4];
            {   const LAS float* gc = (const LAS float*)(sl + O_GC) + 4 * hi;
#pragma unroll
                for (int g4 = 0; g4 < 4; ++g4) { gc0[g4] = *(const LAS f32x4*)(gc + 8 * g4); gc1[g4] = *(const LAS f32x4*)(gc + 32 + 8 * g4); } }
            asm volatile("s_waitcnt lgkmcnt(0)" ::: "memory"); SBAR();
#define PK(L, H) (bf16x8){L[0], L[1], L[2], L[3], H[0], H[1], H[2], H[3]}
            const bf16x8 kb0 = PK(kb0l, kb0h), kb1 = PK(kb1l, kb1h), nb0 = PK(nb0l, nb0h), nb1 = PK(nb1l, nb1h), vf = PK(vfl, vfh);
#undef PK
            f32x16 a1 = {};
            a1 = __builtin_amdgcn_mfma_f32_32x32x16_bf16(ak0, pack_tile8(Z0, 0), a1, 0, 0, 0);
            a1 = __builtin_amdgcn_mfma_f32_32x32x16_bf16(ak1, pack_tile8(Z0, 8), a1, 0, 0, 0);
            a1 = __builtin_amdgcn_mfma_f32_32x32x16_bf16(ak2, pack_tile8(Z1, 0), a1, 0, 0, 0);
            a1 = __builtin_amdgcn_mfma_f32_32x32x16_bf16(ak3, pack_tile8(Z1, 8), a1, 0, 0, 0);
            f32x16 a2 = {};
            a2 = __builtin_amdgcn_mfma_f32_32x32x16_bf16(xq, vf, a2, 0, 0, 0);
            a2 = __builtin_amdgcn_mfma_f32_32x32x16_bf16(tq, pack_tile8(a1, 0), a2, 0, 0, 0);
            f32x16 a3 = {};
            a3 = __builtin_amdgcn_mfma_f32_32x32x16_bf16(bkq, vf, a3, 0, 0, 0);
            Z0 = __builtin_amdgcn_mfma_f32_32x32x16_bf16(kb0, vf, Z0, 0, 0, 0);
            Z1 = __builtin_amdgcn_mfma_f32_32x32x16_bf16(kb1, vf, Z1, 0, 0, 0);
            const bf16x8 sf = pack_tile8(a2, 0);
            Z0 = __builtin_amdgcn_mfma_f32_32x32x16_bf16(nb0, sf, Z0, 0, 0, 0);
            Z1 = __builtin_amdgcn_mfma_f32_32x32x16_bf16(nb1, sf, Z1, 0, 0, 0);
            a3 = __builtin_amdgcn_mfma_f32_32x32x16_bf16(nbbq, sf, a3, 0, 0, 0);
            if (lane == 0) ctl[6 + wid] = (unsigned)(bi + 1);
#pragma unroll
            for (int g4 = 0; g4 < 4; ++g4) {
#pragma unroll
                for (int e = 0; e < 4; ++e) { Z0[4 * g4 + e] *= gc0[g4][e]; Z1[4 * g4 + e] *= gc1[g4][e]; } }
            {   const int s0 = bi * CS; const int rlo = s0 < 256 ? ML + b * 256 + (d ? 240 - s0 : s0) : b * 4096 + (d ? 4080 - (s0 - 256) : s0 - 256);
                const char* yb = (const char*)YD + (size_t)rlo * 1024;
                if (bi < 16) {
#pragma unroll
                    for (int r = 0; r < 8; ++r) { const int cr = (r & 3) + 8 * (r >> 2);
                        __hip_atomic_store((unsigned short*)(yb + (d ? -cr : cr) * 1024 + yoff), f2bf_s(a3[r] + a1[8 + r]), __ATOMIC_RELAXED, __HIP_MEMORY_SCOPE_AGENT); }
                    if (bi == 15) { asm volatile("s_waitcnt vmcnt(0)" ::: "memory"); if (lane == 0) (void)__hip_atomic_fetch_add(ctxflag, 1u, __ATOMIC_RELAXED, __HIP_MEMORY_SCOPE_AGENT); }
                } else {
#pragma unroll
                    for (int r = 0; r < 8; ++r) { const int cr = (r & 3) + 8 * (r >> 2);
                        *(unsigned short*)(yb + (d ? -cr : cr) * 1024 + yoff) = f2bf_s(a3[r] + a1[8 + r]); } } }
        }
    }
#undef ROWOF
#undef LOADRAW
    __syncthreads();
}
}

__device__ __forceinline__ void phase_readout(ArgP a, int l, int lane, int m0, int m1, int gw, int NGW) {
    const bf16_t* YD = (const bf16_t*)(a->ws + WS_YD); const bf16_t* RWP = (const bf16_t*)(a->ws + WS_RWP); const bf16_t* Z = (const bf16_t*)(a->ws + WS_Z); bf16_t* Y = (bf16_t*)(a->ws + WS_RW);
    const float* lng = a->in[24] + l * 512 + lane * 8; const float* lnb = a->in[25] + l * 512 + lane * 8; const float* rk = a->in[23] + l * 512 + lane * 8;
    for (int m = m0 + gw; m < m1; m += NGW) {
        float y0[8], y1[8], k[8], v[8], r[8], zc[8];
        unpack8(*(const u32x4*)(YD + (size_t)m * 512 + lane * 8), y0); unpack8(*(const u32x4*)(YD + ((size_t)MT + m) * 512 + lane * 8), y1);
        const bf16_t* rp = RWP + (size_t)m * 2048 + lane * 8;
        unpack8(*(const u32x4*)(rp + 512), k); unpack8(*(const u32x4*)(rp + 1024), v); unpack8(*(const u32x4*)(rp + 1536), r);
        unpack8(*(const u32x4*)(Z + (size_t)m * 1536 + 1024 + lane * 8), zc);
        float s = 0.f, rks = 0.f; const f32x4 rka = *(const f32x4*)rk, rkb = *(const f32x4*)(rk + 4);
#pragma unroll
        for (int e = 0; e < 8; ++e) { y0[e] += y1[e]; s += y0[e]; rks += r[e] * k[e] * ((e < 4) ? rka[e & 3] : rkb[e & 3]); }
        s += __shfl_xor(s, 1); s += __shfl_xor(s, 2); s += __shfl_xor(s, 4);
        rks += __shfl_xor(rks, 1); rks += __shfl_xor(rks, 2); rks += __shfl_xor(rks, 4);
        const float mu = s * (1.0f / 64.0f); float q = 0.f;
#pragma unroll
        for (int e = 0; e < 8; ++e) { y0[e] -= mu; q += y0[e] * y0[e]; }
        q += __shfl_xor(q, 1); q += __shfl_xor(q, 2); q += __shfl_xor(q, 4);
        const float rstd = 1.0f / sqrtf(q * (1.0f / 64.0f) + GN_EPS);
        float o[8]; const f32x4 g0 = *(const f32x4*)lng, g1 = *(const f32x4*)(lng + 4), b0 = *(const f32x4*)lnb, b1 = *(const f32x4*)(lnb + 4);
#pragma unroll
        for (int e = 0; e < 4; ++e) { o[e] = (y0[e] * rstd * g0[e] + b0[e] + rks * v[e]) * zc[e]; o[4 + e] = (y0[4 + e] * rstd * g1[e] + b1[e] + rks * v[4 + e]) * zc[4 + e]; }
        *(u32x4*)(Y + (size_t)m * 1536 + 1024 + lane * 8) = pack8(o);
    }
}


#define XB_TMO      128
#define XB_XCNT(j)  (256  + 64 * (j))
#define XB_XSUB(j)  (1280 + 64 * (j))
#define XB_XGEN(j)  (2304 + 64 * (j))
#define XB_TOP      3328
#define XB_TOPGEN   3392
#define XCD_BAR_WORDS 3456
#define XB_SPIN_CAP (1u << 22)
__device__ __forceinline__ unsigned xb_ld(unsigned* p)              { return __hip_atomic_load(p, __ATOMIC_RELAXED, __HIP_MEMORY_SCOPE_AGENT); }
__device__ __forceinline__ unsigned xb_add(unsigned* p, unsigned v) { return __hip_atomic_fetch_add(p, v, __ATOMIC_RELAXED, __HIP_MEMORY_SCOPE_AGENT); }
__device__ __forceinline__ unsigned xb_xcc_id() { return (unsigned)__builtin_amdgcn_s_getreg((3 << 11) | 20) & 0xFu; }
#define XB_SPIN(cond, bar) do { unsigned _sp = 0; while (cond) { __builtin_amdgcn_s_sleep(1); \
    if ((++_sp & 255u) == 0u) { if (xb_ld(&(bar)[XB_TMO])) break; if (_sp > XB_SPIN_CAP) { atomicAdd(&(bar)[XB_TMO], 1u); break; } } } } while (0)
struct XcdBarrier { unsigned* bar; unsigned x; volatile LAS unsigned* st; };
__device__ __forceinline__ XcdBarrier xcd_barrier_post(unsigned* bar, volatile LAS unsigned* st) {
    XcdBarrier b; b.bar = bar; b.x = xb_xcc_id(); b.st = st;
    if (threadIdx.x == 0) (void)xb_add(&bar[XB_XCNT(b.x)], 1u);
    return b;
}
__device__ __forceinline__ void xcd_barrier_complete(unsigned* bar, unsigned x, unsigned& nloc, unsigned& nx) {
    const unsigned G = gridDim.x * gridDim.y * gridDim.z;
    unsigned sum, cnt, mine, sp = 0u;
    for (;;) {
        sum = 0u; cnt = 0u; mine = 0u;
#pragma unroll
        for (unsigned j = 0; j < 16; ++j) { const unsigned c = xb_ld(&bar[XB_XCNT(j)]); sum += c; cnt += (c > 0u) ? 1u : 0u; mine = (j == x) ? c : mine; }
        if (sum == G) break;
        __builtin_amdgcn_s_sleep(1);
        if ((++sp & 255u) == 0u) { if (xb_ld(&bar[XB_TMO])) break; if (sp > XB_SPIN_CAP) { atomicAdd(&bar[XB_TMO], 1u); break; } }
    }
    nloc = mine > 0u ? mine : 1u; nx = cnt > 0u ? cnt : 1u;
}
__device__ __forceinline__ void xcd_barrier(const XcdBarrier& b) {
    asm volatile("s_waitcnt vmcnt(0)" ::: "memory");
    __syncthreads();
    if (threadIdx.x == 0) {
        unsigned* bar = b.bar;
        __builtin_amdgcn_s_waitcnt(0);
        unsigned nloc = b.st[0], nx = b.st[1];
        if (nloc == 0u) { xcd_barrier_complete(bar, b.x, nloc, nx); b.st[0] = nloc; b.st[1] = nx; }
        const unsigned old = xb_add(&bar[XB_XSUB(b.x)], 1u);
        const unsigned gen = old / nloc;
        if (old + 1u == (gen + 1u) * nloc) {
            __builtin_amdgcn_fence(__ATOMIC_RELEASE, "agent");
            asm volatile("s_waitcnt vmcnt(0)" ::: "memory");
            const unsigned og = xb_add(&bar[XB_TOP], 1u);
            const unsigned tg = og / nx;
            if (og + 1u == (tg + 1u) * nx) xb_add(&bar[XB_TOPGEN], 1u);
            else XB_SPIN(xb_ld(&bar[XB_TOPGEN]) == tg, bar);
            __builtin_amdgcn_fence(__ATOMIC_ACQUIRE, "agent");
            xb_add(&bar[XB_XGEN(b.x)], 1u);
            asm volatile("s_waitcnt vmcnt(0)" ::: "memory");
        } else {
            XB_SPIN(xb_ld(&bar[XB_XGEN(b.x)]) == gen, bar);
            __builtin_amdgcn_fence(__ATOMIC_ACQUIRE, "agent");
            asm volatile("s_waitcnt vmcnt(0)" ::: "memory");
        }
    }
    __syncthreads();
}
constexpr int LDS_MISC = 139264;
constexpr size_t WS_BAR = 4096;
constexpr size_t CTL_ZERO_BYTES = 65536;

__device__ __forceinline__ void group_barrier(unsigned* ctr, unsigned nblk) {
    asm volatile("s_waitcnt vmcnt(0)" ::: "memory");
    __syncthreads();
    if (threadIdx.x == 0) {
        __builtin_amdgcn_fence(__ATOMIC_RELEASE, "agent");
        asm volatile("s_waitcnt vmcnt(0)" ::: "memory");
        (void)xb_add(ctr, 1u);
        unsigned sp = 0u;
        while (xb_ld(ctr) < nblk) { __builtin_amdgcn_s_sleep(1); if (++sp > XB_SPIN_CAP) break; }
        __builtin_amdgcn_fence(__ATOMIC_ACQUIRE, "agent");
        asm volatile("s_waitcnt vmcnt(0)" ::: "memory");
    }
    __syncthreads();
}
constexpr size_t WS_GBAR = 32768;

constexpr int NPH_L = 7;
constexpr int NPHASES = 1 + NL * NPH_L;

template <int ONLY>
__global__ void __launch_bounds__(512, 2) mk_fwd(Args args) {
    extern __shared__ __attribute__((aligned(16))) unsigned char lds_raw[];
    LAS unsigned char* lds = (LAS unsigned char*)lds_raw;
    const int G = gridDim.x;
#if MK_ONE_LAUNCH
    if (threadIdx.x < 2) ((volatile LAS unsigned*)(lds + LDS_MISC))[threadIdx.x] = 0u;
    __syncthreads();
    XcdBarrier xbar = xcd_barrier_post((unsigned*)(args.ws + WS_BAR), (volatile LAS unsigned*)(lds + LDS_MISC));
    if (args.ph_hi > 100000) cg::this_grid().sync();
#endif
    for (int ph = args.ph_lo; ph < args.ph_hi; ++ph) {
        int tid = threadIdx.x; asm volatile("" : "+v"(tid));
        int bid = blockIdx.x; asm volatile("" : "+s"(bid));
        ArgP A = (ArgP)__builtin_amdgcn_kernarg_segment_ptr(); asm volatile("" : "+s"(A));
        const int lane = tid & 63, wave = __builtin_amdgcn_readfirstlane(tid >> 6);
        unsigned char* ws = A->ws;
        if (ph == 0) { if (ONLY == -1 || ONLY == 100) { phase_A(A, lds, tid, wave, lane, bid, G); __syncthreads(); convert_weights(A, 0, lds, wave, lane, bid * 8 + wave, G * 8); } }
        else {
            const int l = (ph - 1) / NPH_L; int sp = (int)((0x9876210ull >> (4 * ((ph - 1) % NPH_L))) & 15ull);
            if (ONLY >= 0) { if (ONLY == 100 || sp != ONLY) continue; sp = ONLY; }
            if (sp == 0) phase_B(A, l, lds, tid, wave, lane, bid, G);
            else if (sp == 1) {
                pg8::Gemm g{(const bf16_t*)(ws + WS_H), (const bf16_t*)(ws + (size_t)(l & 1) * WS_WSET2 + WS_WIN), 1024, 1024, 1024, 0, 0};
                pg8::Sched S; if (l == NL - 1) S.init(ML / 256, INC / 256, 1, G, bid, MC / 256, 9); else S.init_gemm1_holes(G, bid);
                pg8::Epi1 E{(bf16_t*)(ws + WS_KB), (bf16_t*)(ws + WS_VB), (bf16_t*)(ws + WS_RW), (bf16_t*)(ws + WS_YD), (bf16_t*)(ws + WS_QB), (bf16_t*)(ws + WS_GU), (bf16_t*)(ws + WS_VA), (bf16_t*)(ws + WS_Z), (bf16_t*)(ws + WS_G)};
                pg8::gemm_phase<pg8::Epi1>(lds, g, S, E, tid);
            } else if (sp == 2) {
                pg8::Gemm g{(const bf16_t*)(ws + WS_YD), (const bf16_t*)(ws + (size_t)(l & 1) * WS_WSET2 + WS_WLORA), 256, 256, 256, 0, 0};
                pg8::Sched S; S.init(MT / 256, 2048 / 256, 1, G, bid);
                pg8::EpiLora E{(bf16_t*)(ws + WS_WA), A->in[17] + l * 1024, A->in[19] + l * 1024};
                pg8::gemm_phase<pg8::EpiLora>(lds, g, S, E, tid);
                phase_prep(A, l, tid, wave, lane, bid, G);
            }
            else if (sp == 5) { for (int u = bid; u < (MT / 128) * 4; u += G) gmlp_unit(A, l, u, (char*)lds_raw, tid); }
            else if (sp == 6) {
                {   const int nun = (l < NL - 1 && bid >= 64 && bid < 80) ? 2 : 1;
#pragma nounroll
                    for (int k = 0; k < nun; ++k) {
                        att::attn_unit(A, l, k == 0 ? bid : 256 + (bid - 64), (char*)lds_raw, tid);
                        asm volatile("s_waitcnt vmcnt(0)" ::: "memory"); __syncthreads();
                        if (tid == 0) (void)xb_add((unsigned*)(ws + WS_GBAR) + l * 512 + (k == 0 ? 5 : 6) * 64, 1u); } }
                unsigned* gb = (unsigned*)(ws + WS_GBAR) + l * 512;
                const bool crewl = l < NL - 1;
                const bf16_t* wbr = (const bf16_t*)(ws + (size_t)(l & 1) * WS_WSET2 + WS_WBR);
                if (bid < 64) scanc::scan_unit(A, l, bid, (LAS char*)lds, tid, gb + 4 * 64);
                else if (crewl && bid < 80) {
                    const int c = bid - 64;
                    gmlp_unit(A, l, 512 + 2 * c, (char*)lds_raw, tid); gmlp_unit(A, l, 513 + 2 * c, (char*)lds_raw, tid);
                    group_barrier(gb + 1 * 64, 16u);
                    pg8::Sched S; S.init(ML / 256, 0, 1, 16, c, MC / 256, 4);
                    {   pg8::Gemm g{(const bf16_t*)(ws + WS_RW) + 512, wbr + (size_t)1024 * 512, 1536, 512, 512, 0, 0};
                        pg8::EpiMerge E{(const bf16_t*)(ws + WS_G), (bf16_t*)(ws + WS_MB), 1, true};
                        pg8::gemm_phase<pg8::EpiMerge>(lds, g, S, E, tid); }
                    asm volatile("s_waitcnt vmcnt(0)" ::: "memory"); __syncthreads();
                    {   pg8::Gemm g{(const bf16_t*)(ws + WS_RW), wbr, 1536, 512, 512, 0, 0};
                        pg8::EpiMerge E{(const bf16_t*)(ws + WS_G), (bf16_t*)(ws + WS_MB), 0, false};
                        pg8::gemm_phase<pg8::EpiMerge>(lds, g, S, E, tid); }
                    if (tid == 0) { unsigned sp_ = 0u; while (xb_ld(gb + 4 * 64) < 128u) { __builtin_amdgcn_s_sleep(2); if (++sp_ > XB_SPIN_CAP) break; } __builtin_amdgcn_fence(__ATOMIC_ACQUIRE, "agent"); }
                    __syncthreads();
                    phase_readout(A, l, lane, ML, MT, c * 8 + wave, 16 * 8);
                    group_barrier(gb + 2 * 64, 16u);
                    {   pg8::Gemm g{(const bf16_t*)(ws + WS_RW) + 1024, wbr + (size_t)2 * 1024 * 512, 1536, 512, 512, 0, 0};
                        pg8::EpiMerge E{(const bf16_t*)(ws + WS_G), (bf16_t*)(ws + WS_MB), 2, false};
                        pg8::gemm_phase<pg8::EpiMerge>(lds, g, S, E, tid); }
                    group_barrier(gb + 3 * 64, 16u);
                    {   pg8::Gemm g{(const bf16_t*)(ws + WS_MB), (const bf16_t*)(ws + (size_t)(l & 1) * WS_WSET2 + WS_WOUT), 1024, 1024, 1024, 0, 0};
                        pg8::EpiOut E{l == 0 ? A->in[0] : A->out, A->out, l == 0 ? A->in[2] : (const float*)(ws + WS_XC), (float*)(ws + WS_XC), (const float*)(ws + WS_MODB) + (size_t)l * 5 * 3072};
                        pg8::gemm_phase<pg8::EpiOut>(lds, g, S, E, tid); }
                } else { const int b0 = crewl ? 80 : 64, nb = G - b0, ob = bid - b0;
                    if (crewl && ob >= 80 && ob < 156) {
                        const int dt = ob - 80;
                        pg8::Gemm g1{(const bf16_t*)(ws + WS_H), (const bf16_t*)(ws + (size_t)(l & 1) * WS_WSET2 + WS_WIN), 1024, 1024, 1024, 0, 0};
                        pg8::Sched S1; S1.init_single(dt < 64 ? dt : dt - 64, dt < 64 ? 23 : 24);
                        pg8::Epi1 E1{(bf16_t*)(ws + WS_KB), (bf16_t*)(ws + WS_VB), (bf16_t*)(ws + WS_RW), (bf16_t*)(ws + WS_YD), (bf16_t*)(ws + WS_QB), (bf16_t*)(ws + WS_GU), (bf16_t*)(ws + WS_VA), (bf16_t*)(ws + WS_Z), (bf16_t*)(ws + WS_G)};
                        pg8::gemm_phase<pg8::Epi1>(lds, g1, S1, E1, tid);
                        asm volatile("s_waitcnt vmcnt(0)" ::: "memory"); __syncthreads(); }
                    for (int u = ob; u < (ML / 128) * 4; u += nb) gmlp_unit(A, l, u, (char*)lds_raw, tid);
                    if (tid == 0) { unsigned sp_ = 0u; while (xb_ld(gb + 5 * 64) < (unsigned)G || (crewl && xb_ld(gb + 6 * 64) < 16u)) { __builtin_amdgcn_s_sleep(2); if (++sp_ > XB_SPIN_CAP) break; }
                        __builtin_amdgcn_fence(__ATOMIC_ACQUIRE, "agent"); }
                    if (false) { }
                    __syncthreads();
                    pg8::Sched S; S.init(ML / 256, 1024 / 256, 1, nb, ob);
                    {   pg8::Gemm g{(const bf16_t*)(ws + WS_RW) + 512, wbr + (size_t)1024 * 512, 1536, 512, 512, 0, 0};
                        pg8::EpiMerge E{(const bf16_t*)(ws + WS_G), (bf16_t*)(ws + WS_MB), 1, true};
                        pg8::gemm_phase<pg8::EpiMerge>(lds, g, S, E, tid); }
                    __syncthreads();
                    if (l + 1 < NL) convert_weights(A, l + 1, lds, wave, lane, ob * 8 + wave, nb * 8);
                    group_barrier(gb, (unsigned)nb);
                    {   pg8::Gemm g{(const bf16_t*)(ws + WS_RW), wbr, 1536, 512, 512, 0, 0};
                        pg8::EpiMerge E{(const bf16_t*)(ws + WS_G), (bf16_t*)(ws + WS_MB), 0, false};
                        pg8::gemm_phase<pg8::EpiMerge>(lds, g, S, E, tid); } }
            }
            else if (sp == 7) phase_readout(A, l, lane, 0, ML, bid * 8 + wave, G * 8);
            else if (sp == 8) {
                pg8::Gemm g{(const bf16_t*)(ws + WS_RW) + 1024, (const bf16_t*)(ws + (size_t)(l & 1) * WS_WSET2 + WS_WBR) + (size_t)2 * 1024 * 512, 1536, 512, 512, 0, 0};
                pg8::Sched S; S.init(ML / 256, 1024 / 256, 1, G, bid);
                pg8::EpiMerge E{(const bf16_t*)(ws + WS_G), (bf16_t*)(ws + WS_MB), 2, false};
                pg8::gemm_phase<pg8::EpiMerge>(lds, g, S, E, tid);
            } else {
                pg8::Gemm g{(const bf16_t*)(ws + WS_MB), (const bf16_t*)(ws + (size_t)(l & 1) * WS_WSET2 + WS_WOUT), 1024, 1024, 1024, 0, 0};
                pg8::Sched S; S.init(ML / 256, 1024 / 256, 1, G, bid);
                pg8::EpiOut E{l == 0 ? A->in[0] : A->out, A->out, l == 0 ? A->in[2] : (const float*)(ws + WS_XC), (float*)(ws + WS_XC), (const float*)(ws + WS_MODB) + (size_t)l * 5 * 3072};
                pg8::gemm_phase<pg8::EpiOut>(lds, g, S, E, tid);
            }
        }
#if MK_ONE_LAUNCH
        if (ph + 1 < args.ph_hi) xcd_barrier(xbar);
#endif
    }
}


extern "C" void kernel_launch(void* const* d_in, const int* in_sizes, int n_in, void* d_out, int out_size, void* d_ws, size_t ws_size, hipStream_t stream) {
    static int state = 0;
    if (state == 0) {
        if (n_in != 28 || out_size != ML * DM || ws_size < WS_END) { fprintf(stderr, "kernel_launch: unexpected shapes (n_in %d out %d ws %zu)\n", n_in, out_size, ws_size); state = -1; return; }
        state = 1;
    }
    if (state < 0) return;
    Args a{};
    for (int i = 0; i < 28; ++i) a.in[i] = (const float*)d_in[i];
    a.out = (float*)d_out; a.ws = (unsigned char*)d_ws;
#if MK_ONE_LAUNCH
    static int grid = 0;
    if (grid == 0) {
        if (hipFuncSetAttribute((const void*)mk_fwd<-1>, hipFuncAttributeMaxDynamicSharedMemorySize, LDS_BYTES) != hipSuccess) fprintf(stderr, "kernel_launch: hipFuncSetAttribute failed\n");
        int dev = 0, cus = 0, per_cu = 0;
        hipGetDevice(&dev); hipDeviceGetAttribute(&cus, hipDeviceAttributeMultiprocessorCount, dev);
        if (hipOccupancyMaxActiveBlocksPerMultiprocessor(&per_cu, (const void*)mk_fwd<-1>, 512, LDS_BYTES) != hipSuccess || per_cu < 1) { fprintf(stderr, "kernel_launch: occupancy query says %d blocks per CU\n", per_cu); per_cu = 1; }
        (void)hipGetLastError();
        grid = cus * (per_cu < 1 ? 1 : 1);
        if (grid > 256) grid = 256;
    }
    (void)hipMemsetAsync(d_ws, 0, CTL_ZERO_BYTES, stream);
    a.ph_lo = 0; a.ph_hi = NPHASES;
    void* kargs[] = {&a};
    hipError_t e = hipLaunchCooperativeKernel((const void*)mk_fwd<-1>, dim3(grid), dim3(512), kargs, LDS_BYTES, stream);
    if (e != hipSuccess) fprintf(stderr, "cooperative launch failed: %s\n", hipGetErrorString(e));
#endif
}
```
